# Optimizing an MI355X kernel written in HIP

```python
import jax
import jax.numpy as jnp
from jax import lax

D_MODEL = 1024
BATCH = 8
SEQ = 4096
DEPTH = 2

CTX_LEN = 256
GRID_W = 64
N_Q_HEADS = 8
N_KV_HEADS = 2
HEAD_DIM = 128
Q_GROUPS = N_Q_HEADS // N_KV_HEADS
ATTN_W = N_Q_HEADS * HEAD_DIM
KV_W = N_KV_HEADS * HEAD_DIM
Q_BLOCK = 128
ROPE_THETA = 10000.0
SCONV_W = D_MODEL
SCONV_K = 3
LRU_W = D_MODEL
LRU_BLOCKS = 8
LRU_BS = LRU_W // LRU_BLOCKS
LRU_CONV_K = 4
LRU_C = 8.0
N_BRANCH = 3
FFN_W = -(-8 * D_MODEL // (3 * 256)) * 256
COL_SIZES = (ATTN_W, KV_W, KV_W, SCONV_W, SCONV_W, SCONV_W, LRU_W, LRU_W, N_BRANCH * D_MODEL)
N_IN = sum(COL_SIZES)
EPS = 1e-6

kernel_name = "hybrid_gated_branch_dit_block"


def rmsnorm(x, g):
    xf = x.astype(jnp.float32)
    xf = xf * lax.rsqrt(jnp.mean(xf * xf, axis=-1, keepdims=True) + EPS)
    return xf.astype(x.dtype) * g


def modulate(x, g, shift, scale):
    return rmsnorm(x, g) * (1 + scale) + shift


def split_cols(z):
    out, start = [], 0
    for size in COL_SIZES:
        out.append(z[..., start:start + size])
        start += size
    return out


def dwconv(x, w, b, left):
    k_width, length = w.shape[0], x.shape[1]
    xp = jnp.pad(x, ((0, 0), (left, k_width - 1 - left), (0, 0)))
    y = b
    for k in range(k_width):
        y = y + xp[:, k:k + length] * w[k]
    return y


def axial_rope(x, row, col):
    half, quarter = HEAD_DIM // 2, HEAD_DIM // 4
    inv_freq = ROPE_THETA ** (-jnp.arange(quarter, dtype=jnp.float32) / quarter)

    def rot(xh, pos):
        ang = pos.astype(jnp.float32)[:, None] * inv_freq
        cos, sin = jnp.cos(ang)[None, :, None, :], jnp.sin(ang)[None, :, None, :]
        x1 = xh[..., :quarter].astype(jnp.float32)
        x2 = xh[..., quarter:].astype(jnp.float32)
        return jnp.concatenate([x1 * cos - x2 * sin, x2 * cos + x1 * sin], axis=-1)

    out = jnp.concatenate([rot(x[..., :half], row), rot(x[..., half:], col)], axis=-1)
    return out.astype(x.dtype)


def gqa(qg, k, v):
    s = jnp.einsum("bqhgd,bkhd->bhgqk", qg, k).astype(jnp.float32)
    p = jax.nn.softmax(s, axis=-1).astype(v.dtype)
    return jnp.einsum("bhgqk,bkhd->bqhgd", p, v)


def attend_full(q, k, v):
    b, length = q.shape[:2]
    qg = q.reshape(b, length, N_KV_HEADS, Q_GROUPS, HEAD_DIM) * (HEAD_DIM ** -0.5)
    return gqa(qg, k, v).reshape(b, length, ATTN_W)


def attend_blocked(q, k, v):
    b, length = q.shape[:2]
    nb = length // Q_BLOCK
    qb = q.reshape(b, nb, Q_BLOCK, N_KV_HEADS, Q_GROUPS, HEAD_DIM) * (HEAD_DIM ** -0.5)
    qb = jnp.moveaxis(qb, 1, 0)
    o = lax.map(lambda qblk: gqa(qblk, k, v), qb)
    return jnp.moveaxis(o, 0, 1).reshape(b, length, ATTN_W)


def rglru_coeffs(x, wa, ba, wx, bx, lam):
    b, length, _ = x.shape
    xf = x.astype(jnp.float32)
    xb = xf.reshape(b, length, LRU_BLOCKS, LRU_BS)
    r = jax.nn.sigmoid(jnp.einsum("btnd,nde->btne", xb, wa.astype(jnp.float32)).reshape(b, length, LRU_W) + ba)
    i = jax.nn.sigmoid(jnp.einsum("btnd,nde->btne", xb, wx.astype(jnp.float32)).reshape(b, length, LRU_W) + bx)
    log_a = -LRU_C * r * jax.nn.softplus(-lam.astype(jnp.float32))
    a = jnp.exp(log_a)
    drive = jnp.sqrt(-jnp.expm1(2.0 * log_a)) * (i * xf)
    return a, drive


def linear_scan(a, u, reverse):
    def combine(e1, e2):
        a1, b1 = e1
        a2, b2 = e2
        return a1 * a2, a2 * b1 + b2
    return lax.associative_scan(combine, (a, u), reverse=reverse, axis=1)


def rglru_bidir(xc, xl, wa, ba, wx, bx, lam):
    yc, yl = [], []
    for d, rev in enumerate((False, True)):
        ac, uc = rglru_coeffs(xc, wa[d], ba[d], wx[d], bx[d], lam[d])
        _, hc = linear_scan(ac, uc, rev)
        h0 = hc[:, 0] if rev else hc[:, -1]
        al, ul = rglru_coeffs(xl, wa[d], ba[d], wx[d], bx[d], lam[d])
        cum_a, hl = linear_scan(al, ul, rev)
        yc.append(hc)
        yl.append(cum_a * h0[:, None] + hl)
    return (yc[0] + yc[1]).astype(xc.dtype), (yl[0] + yl[1]).astype(xl.dtype)


def merge_branches(attn, sconv, lru, gates, w_attn_out, w_sconv_out, w_lru_out, w_merge_out):
    g = jax.nn.sigmoid(gates.astype(jnp.float32)).astype(attn.dtype)
    merged = (g[..., :D_MODEL] * (attn @ w_attn_out)
              + g[..., D_MODEL:2 * D_MODEL] * (sconv @ w_sconv_out)
              + g[..., 2 * D_MODEL:] * (lru @ w_lru_out))
    return merged @ w_merge_out


def swiglu(h, w_ffn_in, w_ffn_out):
    gu = h @ w_ffn_in
    return (jax.nn.silu(gu[..., :FFN_W]) * gu[..., FFN_W:]) @ w_ffn_out


def setup_inputs(seed: int = 0) -> dict:
    key = jax.random.key(seed)
    ks = jax.random.split(key, 28)
    f32 = jnp.float32

    def nrm(k, shape, scale):
        return jax.random.normal(k, shape, f32) * scale

    def gain(k, shape):
        return 1.0 + 0.01 * jax.random.normal(k, shape, f32)

    a0 = jax.random.uniform(ks[20], (DEPTH, 2, LRU_W), f32, minval=0.9, maxval=0.999)
    return {
        "x": nrm(ks[0], (BATCH, SEQ, D_MODEL), 1.0),
        "c": nrm(ks[1], (BATCH, D_MODEL), 1.0),
        "ctx": nrm(ks[2], (BATCH, CTX_LEN, D_MODEL), 1.0),
        "c_ctx": nrm(ks[3], (D_MODEL,), 1.0),
        "w_mod": nrm(ks[4], (DEPTH, D_MODEL, 6 * D_MODEL), D_MODEL ** -0.5),
        "b_mod": nrm(ks[5], (DEPTH, 6 * D_MODEL), 0.01),
        "norm1_g": gain(ks[6], (DEPTH, D_MODEL)),
        "norm2_g": gain(ks[7], (DEPTH, D_MODEL)),
        "w_in": nrm(ks[8], (DEPTH, D_MODEL, N_IN), D_MODEL ** -0.5),
        "q_norm_g": gain(ks[9], (DEPTH, HEAD_DIM)),
        "k_norm_g": gain(ks[10], (DEPTH, HEAD_DIM)),
        "w_attn_out": nrm(ks[11], (DEPTH, ATTN_W, D_MODEL), ATTN_W ** -0.5),
        "sconv_w": nrm(ks[12], (DEPTH, SCONV_K, SCONV_W), SCONV_K ** -0.5),
        "sconv_b": nrm(ks[13], (DEPTH, SCONV_W), 0.01),
        "w_sconv_out": nrm(ks[14], (DEPTH, SCONV_W, D_MODEL), SCONV_W ** -0.5),
        "lru_conv_w": nrm(ks[15], (DEPTH, LRU_CONV_K, LRU_W), LRU_CONV_K ** -0.5),
        "lru_conv_b": nrm(ks[16], (DEPTH, LRU_W), 0.01),
        "lru_wa": nrm(ks[17], (DEPTH, 2, LRU_BLOCKS, LRU_BS, LRU_BS), LRU_BS ** -0.5),
        "lru_ba": nrm(ks[18], (DEPTH, 2, LRU_W), 0.01),
        "lru_wx": nrm(ks[19], (DEPTH, 2, LRU_BLOCKS, LRU_BS, LRU_BS), LRU_BS ** -0.5),
        "lru_bx": nrm(ks[21], (DEPTH, 2, LRU_W), 0.01),
        "lru_lambda": jnp.log(a0) - jnp.log1p(-a0),
        "w_lru_out": nrm(ks[22], (DEPTH, LRU_W, D_MODEL), LRU_W ** -0.5),
        "w_merge_out": nrm(ks[23], (DEPTH, D_MODEL, D_MODEL), D_MODEL ** -0.5),
        "w_ffn_in": nrm(ks[24], (DEPTH, D_MODEL, 2 * FFN_W), D_MODEL ** -0.5),
        "w_ffn_out": nrm(ks[25], (DEPTH, FFN_W, D_MODEL), FFN_W ** -0.5),
        "final_g": gain(ks[26], (D_MODEL,)),
    }


def reference(x, c, ctx, c_ctx, w_mod, b_mod, norm1_g, norm2_g, w_in, q_norm_g, k_norm_g,
              w_attn_out, sconv_w, sconv_b, w_sconv_out, lru_conv_w, lru_conv_b, lru_wa, lru_ba,
              lru_wx, lru_bx, lru_lambda, w_lru_out, w_merge_out, w_ffn_in, w_ffn_out, final_g):
    b, n_lat, _ = x.shape
    n_ctx = ctx.shape[1]
    rows = n_lat // GRID_W
    row = jnp.repeat(jnp.arange(rows, dtype=jnp.int32), GRID_W)
    col = jnp.tile(jnp.arange(GRID_W, dtype=jnp.int32), rows)
    silu_c = jax.nn.silu(c)
    silu_cc = jax.nn.silu(c_ctx)
    xl, xc = x, ctx
    for l in range(DEPTH):
        last = l == DEPTH - 1
        mod_l = jnp.split((silu_c @ w_mod[l] + b_mod[l])[:, None, :], 6, axis=-1)
        mod_c = jnp.split(silu_cc @ w_mod[l] + b_mod[l], 6, axis=-1)

        hl = modulate(xl, norm1_g[l], mod_l[0], mod_l[1])
        hc = modulate(xc, norm1_g[l], mod_c[0], mod_c[1])
        ql, kl, vl, sbl, scl, sxl, rxl, rgl, gtl = split_cols(hl @ w_in[l])
        qc, kc, vc, sbc, scc, sxc, rxc, rgc, gtc = split_cols(hc @ w_in[l])

        ql = axial_rope(rmsnorm(ql.reshape(b, n_lat, N_Q_HEADS, HEAD_DIM), q_norm_g[l]), row, col)
        kl = axial_rope(rmsnorm(kl.reshape(b, n_lat, N_KV_HEADS, HEAD_DIM), k_norm_g[l]), row, col)
        kc = rmsnorm(kc.reshape(b, n_ctx, N_KV_HEADS, HEAD_DIM), k_norm_g[l])
        vl = vl.reshape(b, n_lat, N_KV_HEADS, HEAD_DIM)
        vc = vc.reshape(b, n_ctx, N_KV_HEADS, HEAD_DIM)
        k_all = jnp.concatenate([kc, kl], axis=1)
        v_all = jnp.concatenate([vc, vl], axis=1)
        attn_l = attend_blocked(ql, k_all, v_all)

        sconv_l = sbl * dwconv(scl * sxl, sconv_w[l], sconv_b[l], SCONV_K // 2)

        lru_xc = dwconv(rxc, lru_conv_w[l], lru_conv_b[l], LRU_CONV_K // 2)
        lru_xl = dwconv(rxl, lru_conv_w[l], lru_conv_b[l], LRU_CONV_K // 2)
        lru_c, lru_l = rglru_bidir(lru_xc, lru_xl, lru_wa[l], lru_ba[l], lru_wx[l], lru_bx[l], lru_lambda[l])
        lru_l = lru_l * jax.nn.gelu(rgl)

        xl = xl + mod_l[2] * merge_branches(attn_l, sconv_l, lru_l, gtl, w_attn_out[l],
                                            w_sconv_out[l], w_lru_out[l], w_merge_out[l])

        if not last:
            qc = rmsnorm(qc.reshape(b, n_ctx, N_Q_HEADS, HEAD_DIM), q_norm_g[l])
            attn_c = attend_full(qc, kc, vc)
            sconv_c = sbc * dwconv(scc * sxc, sconv_w[l], sconv_b[l], SCONV_K // 2)
            lru_c = lru_c * jax.nn.gelu(rgc)
            xc = xc + mod_c[2] * merge_branches(attn_c, sconv_c, lru_c, gtc, w_attn_out[l],
                                                w_sconv_out[l], w_lru_out[l], w_merge_out[l])
            xc = xc + mod_c[5] * swiglu(modulate(xc, norm2_g[l], mod_c[3], mod_c[4]),
                                        w_ffn_in[l], w_ffn_out[l])

        xl = xl + mod_l[5] * swiglu(modulate(xl, norm2_g[l], mod_l[3], mod_l[4]),
                                    w_ffn_in[l], w_ffn_out[l])
    return rmsnorm(xl, final_g)
```

```cpp
#include <hip/hip_runtime.h>
#include <hip/hip_bf16.h>
#include <hip/hip_cooperative_groups.h>
#include <cstdio>
#include <cstdint>
namespace cg = cooperative_groups;

#ifndef REP_KIND
#define REP_KIND -1
#endif
#ifndef REP_LRU1
#define REP_LRU1 1
#endif
#ifndef REP_A1
#define REP_A1 1
#endif
#ifndef REP_ATT
#define REP_ATT 1
#endif
#ifndef MK_PER_PHASE
#define MK_PER_PHASE 0
#endif

#define LAS __attribute__((address_space(3)))
typedef unsigned short bf16_t;
typedef short bf16x8 __attribute__((ext_vector_type(8)));
typedef short s16x4 __attribute__((ext_vector_type(4)));
typedef float f32x2 __attribute__((ext_vector_type(2)));
typedef float f32x4 __attribute__((ext_vector_type(4)));
typedef float f32x16 __attribute__((ext_vector_type(16)));
typedef unsigned u32x4 __attribute__((ext_vector_type(4)));
typedef unsigned u32x2 __attribute__((ext_vector_type(2)));

constexpr int DM = 1024, NBATCH = 8, SEQ = 4096, CTXL = 256, NIN = 9728, FFW = 2816;
constexpr int LROWS = NBATCH * SEQ, CROWS = NBATCH * CTXL, ROWS = LROWS + CROWS;
constexpr int CHB = 4, CH_L = CHB * SEQ, CH_C = CHB * CTXL, CH_ROWS = CH_L + CH_C;
constexpr int ZP = NIN;
constexpr int CQ = 0, CK = 1024, CV = 1280, CSB = 1536, CSC = 2560, CSX = 3584, CRX = 4608, CRG = 5632, CGT = 6656;
constexpr int KVLEN = CTXL + SEQ;
constexpr float EPS = 1e-6f;
constexpr int NTHREADS = 512, NWAVES = 8;
constexpr int MISC_OFF = 143360, LDS_BYTES = MISC_OFF + 1024;

constexpr size_t MiB = 1u << 20;
constexpr size_t WS_MOD = 0, WS_ROPE = 512 * 1024, WS_CTL = 768 * 1024, CTL_BYTES = 16384, WS_LSUM = 1 * MiB, WS_XC = 6 * MiB, WS_W = 14 * MiB;
constexpr size_t W_IN = 0, W_AO = 19 * MiB, W_SO = 21 * MiB, W_LO = 23 * MiB, W_MO = 25 * MiB, W_F1 = 27 * MiB, W_F2 = 38 * MiB, W_LRU = 43 * MiB + 512 * 1024;
constexpr size_t W_LAYER = 44 * MiB + 512 * 1024;
constexpr size_t WS_H = 103 * MiB, WS_K = 171 * MiB, WS_V = WS_K + (size_t)CHB * KVLEN * 256 * 2, WS_Z = 188 * MiB, WS_END = 511 * MiB;
static_assert(WS_W + 2 * W_LAYER <= WS_H, "weights");
static_assert(WS_H + (size_t)ROWS * DM * 2 <= WS_K, "H");
static_assert(WS_V + (size_t)CHB * KVLEN * 256 * 2 <= WS_Z, "KV");
static_assert(WS_Z + (size_t)CH_ROWS * ZP * 2 <= WS_END, "Z");
static_assert((size_t)ROWS * FFW * 2 <= (size_t)CH_ROWS * ZP * 2, "HID in Z");
static_assert(W_F2 + (size_t)DM * FFW * 2 <= W_LRU && W_IN + (size_t)NIN * DM * 2 <= W_AO && W_F1 + (size_t)2 * FFW * DM * 2 <= W_F2, "w map");

struct Args { const float* in[27]; float* out; unsigned char* ws; int ph_lo, ph_hi; };
typedef const __attribute__((address_space(4))) Args* CArgs;

__device__ __forceinline__ unsigned cvt_pk_bf16(float lo, float hi) { unsigned r; asm volatile("v_cvt_pk_bf16_f32 %0, %1, %2" : "=v"(r) : "v"(lo), "v"(hi)); return r; }
__device__ __forceinline__ float bf_lo(unsigned u) { return __uint_as_float(u << 16); }
__device__ __forceinline__ float bf_hi(unsigned u) { return __uint_as_float(u & 0xffff0000u); }
__device__ __forceinline__ float bf1(bf16_t b) { return __uint_as_float((unsigned)b << 16); }
__device__ __forceinline__ int tid_opaque(int wave_s) { int t = wave_s * 64 + (int)__builtin_amdgcn_mbcnt_hi(~0u, __builtin_amdgcn_mbcnt_lo(~0u, 0u)); asm volatile("" : "+v"(t)); return t; }
__device__ __forceinline__ int bid_opaque() { int b = blockIdx.x; asm volatile("" : "+s"(b)); return b; }
__device__ __forceinline__ float wave_sum(float v) {
#pragma unroll
    for (int o = 1; o < 64; o <<= 1) v += __shfl_xor(v, o);
    return v;
}
__device__ __forceinline__ float fast_sigmoid(float y) { return __builtin_amdgcn_rcpf(1.0f + __builtin_amdgcn_exp2f(-1.4426950408889634f * y)); }
__device__ __forceinline__ float gelu_tanh(float x) { const float y = 1.5957691216057308f * (x + 0.044715f * x * x * x); return x * fast_sigmoid(y); }
__device__ __forceinline__ float silu_f(float x) { return x * fast_sigmoid(x); }

#define XB_TMO      128
#define XB_XCNT(j)  (256  + 64 * (j))
#define XB_XSUB(j)  (1280 + 64 * (j))
#define XB_XGEN(j)  (2304 + 64 * (j))
#define XB_TOP      3328
#define XB_TOPGEN   3392
#define XCD_BAR_WORDS 3456
#define XB_SPIN_CAP (1u << 18)

__device__ __forceinline__ unsigned xb_ld(unsigned* p)              { return __hip_atomic_load(p, __ATOMIC_RELAXED, __HIP_MEMORY_SCOPE_AGENT); }
__device__ __forceinline__ unsigned xb_add(unsigned* p, unsigned v) { return __hip_atomic_fetch_add(p, v, __ATOMIC_RELAXED, __HIP_MEMORY_SCOPE_AGENT); }
__device__ __forceinline__ unsigned xb_xcc_id() { return (unsigned)__builtin_amdgcn_s_getreg((3 << 11) | 20) & 0xFu; }
#define XB_SPIN(cond, bar) do { unsigned _sp = 0; while (cond) { __builtin_amdgcn_s_sleep(1); \
    if ((++_sp & 255u) == 0u) { if (xb_ld(&(bar)[XB_TMO])) break; if (_sp > XB_SPIN_CAP) { atomicAdd(&(bar)[XB_TMO], 1u); break; } } } } while (0)

struct XcdBarrier {
    unsigned* bar; unsigned x;
    volatile LAS unsigned* st;
};

__device__ __forceinline__ XcdBarrier xcd_barrier_post(unsigned* bar, volatile LAS unsigned* st) {
    XcdBarrier b; b.bar = bar; b.x = xb_xcc_id(); b.st = st;
    if (threadIdx.x == 0) (void)xb_add(&bar[XB_XCNT(b.x)], 1u);
    return b;
}
__device__ __forceinline__ void xcd_barrier_complete(unsigned* bar, unsigned x, unsigned& nloc, unsigned& nx) {
    const unsigned G = gridDim.x * gridDim.y * gridDim.z;
    unsigned sum, cnt, mine, sp = 0u;
    for (;;) {
        sum = 0u; cnt = 0u; mine = 0u;
#pragma unroll
        for (unsigned j = 0; j < 16; ++j) { const unsigned c = xb_ld(&bar[XB_XCNT(j)]); sum += c; cnt += (c > 0u) ? 1u : 0u; mine = (j == x) ? c : mine; }
        if (sum == G) break;
        __builtin_amdgcn_s_sleep(1);
        if ((++sp & 255u) == 0u) { if (xb_ld(&bar[XB_TMO])) break; if (sp > XB_SPIN_CAP) { atomicAdd(&bar[XB_TMO], 1u); break; } }
    }
    nloc = mine > 0u ? mine : 1u; nx = cnt > 0u ? cnt : 1u;
}

__device__ __forceinline__ void xcd_barrier(const XcdBarrier& b, const bool leader_thread) {
    asm volatile("s_waitcnt vmcnt(0)" ::: "memory");
    __syncthreads();
    if (leader_thread) {
        unsigned* bar = b.bar;
        __builtin_amdgcn_s_waitcnt(0);
        unsigned nloc = b.st[0], nx = b.st[1];
        if (nloc == 0u) { xcd_barrier_complete(bar, b.x, nloc, nx); b.st[0] = nloc; b.st[1] = nx; }
        const unsigned old = xb_add(&bar[XB_XSUB(b.x)], 1u);
        const unsigned gen = old / nloc;
        if (old + 1u == (gen + 1u) * nloc) {
            __builtin_amdgcn_fence(__ATOMIC_RELEASE, "agent");
            asm volatile("s_waitcnt vmcnt(0)" ::: "memory");
            const unsigned og = xb_add(&bar[XB_TOP], 1u);
            const unsigned tg = og / nx;
            if (og + 1u == (tg + 1u) * nx) xb_add(&bar[XB_TOPGEN], 1u);
            else XB_SPIN(xb_ld(&bar[XB_TOPGEN]) == tg, bar);
            __builtin_amdgcn_fence(__ATOMIC_ACQUIRE, "agent");
            xb_add(&bar[XB_XGEN(b.x)], 1u);
            asm volatile("s_waitcnt vmcnt(0)" ::: "memory");
        } else {
            XB_SPIN(xb_ld(&bar[XB_XGEN(b.x)]) == gen, bar);
            __builtin_amdgcn_fence(__ATOMIC_ACQUIRE, "agent");
            asm volatile("s_waitcnt vmcnt(0)" ::: "memory");
        }
    }
    __syncthreads();
}


namespace pg8 {
constexpr int BM = 256, BK = 64, HALF = 128, HTB = HALF * BK * 2, STAGE_BYTES = 8 * HTB;
__host__ __device__ __forceinline__ int lds_byte(int r, int c) { const int st = (r >> 4) * 2 + (c >> 5), rr = r & 15, cc = c & 31, ob = rr * 64 + cc * 2; return st * 1024 + (ob ^ (((ob >> 9) & 1) << 5)); }
__host__ __device__ __forceinline__ void stage_rc(int b, int& R, int& C) { const int st = b / 1024, sb = b % 1024, swz = sb ^ (((sb >> 9) & 1) << 5); R = (st >> 1) * 16 + swz / 64; C = (st & 1) * 32 + (swz % 64) / 2; }
__host__ __device__ __forceinline__ int perm32(int rho) { const int n = rho >> 4, i = rho & 15; return 8 * (i >> 2) + 4 * n + (i & 3); }

struct Unit { const char* A; const char* B; int pm, pn, seg; };

template <class Epi, class Sched>
__device__ __forceinline__ void gemm_phase(LAS unsigned char* lds, const int K, const int lda, const Sched& S, const Epi& E) {
    const int tid = tid_opaque(S.F.wave_s), wid = __builtin_amdgcn_readfirstlane(tid >> 6), lane = tid & 63, wr = wid >> 2, wc = wid & 3, fr = lane & 15, fq = lane >> 4;
    const int nt = K / BK;
    unsigned voffA[2], voffB[2];
#pragma unroll
    for (int i = 0; i < 2; ++i) { int R, C; stage_rc(tid * 16 + i * 8192, R, C); const int Rb = (R & ~31) + perm32(R & 31);
        voffA[i] = (unsigned)(R * lda + C) * 2u; voffB[i] = (unsigned)(Rb * K + C) * 2u; }
    const size_t kstep = (size_t)(BK * 2);
    const size_t hstepA = (size_t)HALF * lda * 2, hstepB = (size_t)HALF * K * 2;
    const unsigned ldsw = (unsigned)wid * 1024u;
    const int aoff = lds_byte(wr * 64 + fr, fq * 8), boff = lds_byte(wc * 32 + fr, fq * 8);
#define PG8_SA(b, h) (((b) * 2 + (h)) * HTB)
#define PG8_SB(b, h) ((4 + (b) * 2 + (h)) * HTB)
#define PG8_STAGE(bufoff, gbase, voff) do { _Pragma("unroll") for (int _i = 0; _i < 2; ++_i) \
        __builtin_amdgcn_global_load_lds((const unsigned*)((const char*)(gbase) + (voff)[_i]), (LAS unsigned*)(lds + (bufoff) + ldsw + _i * 8192), 16, 0, 0); } while (0)
#define PG8_LDA(dst, b, h) do { _Pragma("unroll") for (int m = 0; m < 4; ++m) _Pragma("unroll") for (int k = 0; k < 2; ++k) dst[m][k] = *(const LAS bf16x8*)(lds + PG8_SA(b, h) + aoff + m * 2048 + k * 1024); } while (0)
#define PG8_LDB(dst, b, h) do { _Pragma("unroll") for (int n = 0; n < 2; ++n) _Pragma("unroll") for (int k = 0; k < 2; ++k) dst[n][k] = *(const LAS bf16x8*)(lds + PG8_SB(b, h) + boff + n * 2048 + k * 1024); } while (0)
#define PG8_MMA(ai, bj, At, Bt) do { __builtin_amdgcn_s_setprio(1); _Pragma("unroll") for (int m = 0; m < 4; ++m) _Pragma("unroll") for (int n = 0; n < 2; ++n) _Pragma("unroll") for (int k = 0; k < 2; ++k) \
        acc[ai][bj][m][n] = __builtin_amdgcn_mfma_f32_16x16x32_bf16(Bt[n][k], At[m][k], acc[ai][bj][m][n], 0, 0, 0); __builtin_amdgcn_s_setprio(0); } while (0)
#define PG8_WAIT_V(n) asm volatile("s_waitcnt vmcnt(" #n ")" ::: "memory")
#define PG8_WAIT_L(n) asm volatile("s_waitcnt lgkmcnt(" #n ")" ::: "memory")
#define PG8_BAR __builtin_amdgcn_s_barrier()
#define PG8_SCHED __builtin_amdgcn_sched_barrier(0)
    Unit cur, nxt; int ui = 0;
    if (!S.next(0, cur)) return;
    f32x4 acc[2][2][4][2];
#pragma unroll
    for (int a = 0; a < 2; ++a)
#pragma unroll
        for (int b = 0; b < 2; ++b)
#pragma unroll
            for (int m = 0; m < 4; ++m)
#pragma unroll
                for (int n = 0; n < 2; ++n) acc[a][b][m][n] = (f32x4){0.f, 0.f, 0.f, 0.f};
    bf16x8 At[4][2], B0[2][2], B1[2][2];
    const char* cA = cur.A; const char* cB = cur.B;
    PG8_STAGE(PG8_SB(0, 0), cB, voffB); PG8_STAGE(PG8_SB(0, 1), cB + hstepB, voffB); PG8_STAGE(PG8_SA(0, 0), cA, voffA); PG8_STAGE(PG8_SA(0, 1), cA + hstepA, voffA);
    if (wr == 1) PG8_BAR;
    PG8_WAIT_V(2); PG8_BAR;
    PG8_STAGE(PG8_SB(1, 0), cB + kstep, voffB); PG8_STAGE(PG8_SA(1, 0), cA + kstep, voffA); PG8_STAGE(PG8_SB(1, 1), cB + hstepB + kstep, voffB);
    PG8_WAIT_V(6); PG8_BAR;
    for (;;) {
        const bool has_next = S.next(ui + 1, nxt);
        const char* nA = has_next ? nxt.A : cA; const char* nB = has_next ? nxt.B : cB;
        for (int t = 0; t < nt; t += 2) {
            const bool last = (t == nt - 2);
            const char* a1 = cA + (size_t)(t + 1) * kstep;
            const char* a2 = last ? nA : cA + (size_t)(t + 2) * kstep; const char* b2 = last ? nB : cB + (size_t)(t + 2) * kstep;
            const char* a3 = a2 + kstep; const char* b3 = b2 + kstep;
            PG8_LDB(B0, 0, 0); PG8_LDB(B1, 0, 1); PG8_SCHED; PG8_LDA(At, 0, 0); PG8_STAGE(PG8_SA(1, 1), a1 + hstepA, voffA);
            PG8_WAIT_V(8); PG8_WAIT_L(0); PG8_BAR; PG8_MMA(0, 0, At, B0); PG8_MMA(0, 1, At, B1); PG8_BAR; PG8_SCHED;
            PG8_LDA(At, 0, 1); PG8_STAGE(PG8_SB(0, 0), b2, voffB); PG8_STAGE(PG8_SB(0, 1), b2 + hstepB, voffB); PG8_STAGE(PG8_SA(0, 0), a2, voffA);
            PG8_WAIT_V(8); PG8_WAIT_L(0); PG8_BAR; PG8_MMA(1, 0, At, B0); PG8_MMA(1, 1, At, B1); PG8_BAR; PG8_SCHED;
            PG8_LDB(B0, 1, 0); PG8_LDB(B1, 1, 1); PG8_SCHED; PG8_LDA(At, 1, 0); PG8_STAGE(PG8_SA(0, 1), a2 + hstepA, voffA);
            PG8_WAIT_V(8); PG8_WAIT_L(0); PG8_BAR; PG8_MMA(0, 0, At, B0); PG8_MMA(0, 1, At, B1); PG8_BAR; PG8_SCHED;
            PG8_LDA(At, 1, 1); PG8_STAGE(PG8_SB(1, 0), b3, voffB); PG8_STAGE(PG8_SB(1, 1), b3 + hstepB, voffB); PG8_STAGE(PG8_SA(1, 0), a3, voffA);
            PG8_WAIT_V(8); PG8_WAIT_L(0); PG8_BAR; PG8_MMA(1, 0, At, B0); PG8_MMA(1, 1, At, B1); PG8_BAR; PG8_SCHED;
        }
        if (wr == 0) PG8_BAR;
        E(acc, cur, wr, wc, fr, fq);
        if (!has_next) break;
#pragma unroll
        for (int a = 0; a < 2; ++a)
#pragma unroll
            for (int b = 0; b < 2; ++b)
#pragma unroll
                for (int m = 0; m < 4; ++m)
#pragma unroll
                    for (int n = 0; n < 2; ++n) acc[a][b][m][n] = (f32x4){0.f, 0.f, 0.f, 0.f};
        cur = nxt; cA = nA; cB = nB; ++ui;
        if (wr == 1) PG8_BAR;
    }
    PG8_WAIT_V(0);
    PG8_BAR;
#undef PG8_SA
#undef PG8_SB
#undef PG8_STAGE
#undef PG8_LDA
#undef PG8_LDB
#undef PG8_MMA
#undef PG8_WAIT_V
#undef PG8_WAIT_L
#undef PG8_BAR
#undef PG8_SCHED
}
}

enum PhaseKind { K_P0 = 0, K_N1, K_G1, K_M1, K_A1, K_G2, K_G3, K_N2, K_G4, K_G5, K_FN };

struct Frame {
    const float* x; const float* cvec; const float* ctx; const float* cctx;
    float* out; unsigned char* ws;
    int vcu, G, l, c, kind, wave_s;
    __device__ __forceinline__ const bf16_t* W(size_t off) const { return (const bf16_t*)(ws + WS_W + (size_t)l * W_LAYER + off); }
    __device__ __forceinline__ bf16_t* Z() const { return (bf16_t*)(ws + WS_Z); }
    __device__ __forceinline__ bf16_t* H() const { return (bf16_t*)(ws + WS_H); }
    __device__ __forceinline__ bf16_t* Kb() const { return (bf16_t*)(ws + WS_K); }
    __device__ __forceinline__ bf16_t* Vb() const { return (bf16_t*)(ws + WS_V); }
    __device__ __forceinline__ float* XC() const { return (float*)(ws + WS_XC); }
    __device__ __forceinline__ const float* MOD(int b) const { return (const float*)(ws + WS_MOD) + (size_t)(l * 9 + b) * 6144; }
};

struct GSched {
    Frame F;
    __device__ __forceinline__ static void tile_map(int T, int nM, int nN, int& pm, int& pn) {
        const int nig = 8 * nN, gid = T / nig, fm = gid * 8, gsz = (nM - fm) < 8 ? (nM - fm) : 8, w = T % nig; pm = fm + w % gsz; pn = w / gsz;
    }
    __device__ __forceinline__ bool next(int i, pg8::Unit& u) const {
        const int kind = F.kind, l = F.l, c = F.c;
        if (kind == K_G1) {
            const int L = i * F.G + F.vcu, NL = 64 * 38, ncc = (l == 0) ? 38 : 6;
            if (L >= NL + 4 * ncc) return false;
            int lt, pn;
            if (L < NL) { tile_map(L, 64, 38, lt, pn); }
            else { const int q = L - NL; lt = 64 + (q & 3); const int ci = q >> 2; pn = (l == 0) ? ci : (ci < 2 ? 4 + ci : 16 + ci); }
            const size_t grow0 = lt < 64 ? (size_t)(64 * c + lt) * 256 : (size_t)LROWS + (size_t)(4 * c + lt - 64) * 256;
            u.A = (const char*)(F.H() + grow0 * DM); u.B = (const char*)(F.W(W_IN) + (size_t)pn * 256 * DM); u.pm = lt; u.pn = pn; u.seg = 0; return true;
        } else if (kind == K_G2) {
            const int T = (i / 3) * F.G + F.vcu, seg = i % 3, nM = 64;
            if (T >= nM * 4) return false;
            int lt, pn; tile_map(T, nM, 4, lt, pn);
            const int colA = seg == 0 ? CSX : (seg == 1 ? CSB : CSC);
            u.A = (const char*)(F.Z() + (size_t)lt * 256 * ZP + colA);
            u.B = (const char*)(F.W(seg == 0 ? W_AO : (seg == 1 ? W_SO : W_LO)) + (size_t)pn * 256 * DM); u.pm = lt; u.pn = pn; u.seg = seg; return true;
        } else if (kind == K_G3) {
            const int T = i * F.G + F.vcu, nM = 64;
            if (T >= nM * 4) return false;
            int lt, pn; tile_map(T, nM, 4, lt, pn);
            u.A = (const char*)(F.Z() + (size_t)lt * 256 * ZP + CQ); u.B = (const char*)(F.W(W_MO) + (size_t)pn * 256 * DM); u.pm = lt; u.pn = pn; u.seg = 0; return true;
        } else if (kind == K_G4) {
            const int T = i * F.G + F.vcu, nM = (l == 0) ? 136 : 128;
            if (T >= nM * 22) return false;
            int pm, pn; tile_map(T, nM, 22, pm, pn);
            u.A = (const char*)(F.H() + (size_t)pm * 256 * DM); u.B = (const char*)(F.W(W_F1) + (size_t)pn * 256 * DM); u.pm = pm; u.pn = pn; u.seg = 0; return true;
        } else {
            const int T = i * F.G + F.vcu, nM = 128;
            if (T >= nM * 4) return false;
            int pm, pn; tile_map(T, nM, 4, pm, pn);
            u.A = (const char*)(F.Z() + (size_t)pm * 256 * FFW); u.B = (const char*)(F.W(W_F2) + (size_t)pn * 256 * FFW); u.pm = pm; u.pn = pn; u.seg = 0; return true;
        }
    }
};

#ifndef EPI_MASK
#define EPI_MASK 30
#endif
#define EPI_EN(k) ((EPI_MASK >> (k)) & 1)
struct GEpi {
    Frame F;
    __device__ __forceinline__ void operator()(const f32x4 (&acc)[2][2][4][2], const pg8::Unit& u, int wr, int wc, int fr, int fq) const {
        const int kind = F.kind, l = F.l, c = F.c;
        asm volatile("" : "+v"(fr), "+v"(fq));
        const int row0 = wr * 64 + fr, col0 = wc * 32 + 8 * fq;
        if (EPI_EN(1) && kind == K_G1) {
            const int lt = u.pm, pn = u.pn;
            bf16_t* dst; int ldo;
            if (pn == 4 || pn == 5) { const int kvrow0 = lt < 64 ? (lt >> 4) * KVLEN + CTXL + (lt & 15) * 256 : (lt - 64) * KVLEN; dst = (pn == 4 ? F.Kb() : F.Vb()) + (size_t)kvrow0 * 256; ldo = 256; }
            else { dst = F.Z() + (size_t)lt * 256 * ZP + pn * 256; ldo = ZP; }
            const int act = pn >= 26 ? 2 : (pn >= 22 ? 1 : 0);
#pragma unroll
            for (int ai = 0; ai < 2; ++ai)
#pragma unroll
                for (int m = 0; m < 4; ++m) { bf16_t* rowp = dst + (size_t)(row0 + ai * 128 + m * 16) * ldo + col0;
#pragma unroll
                    for (int bj = 0; bj < 2; ++bj) { f32x4 v0 = acc[ai][bj][m][0], v1 = acc[ai][bj][m][1];
                        if (act == 1) { _Pragma("unroll") for (int e = 0; e < 4; ++e) { v0[e] = gelu_tanh(v0[e]); v1[e] = gelu_tanh(v1[e]); } }
                        else if (act == 2) { _Pragma("unroll") for (int e = 0; e < 4; ++e) { v0[e] = fast_sigmoid(v0[e]); v1[e] = fast_sigmoid(v1[e]); } }
                        u32x4 w; w.x = cvt_pk_bf16(v0[0], v0[1]); w.y = cvt_pk_bf16(v0[2], v0[3]); w.z = cvt_pk_bf16(v1[0], v1[1]); w.w = cvt_pk_bf16(v1[2], v1[3]);
                        *(u32x4*)(rowp + bj * 128) = w; } }
        } else if (EPI_EN(2) && kind == K_G2) {
            const int lt = u.pm, pn = u.pn, seg = u.seg;
            const bf16_t* gate = F.Z() + (size_t)lt * 256 * ZP + CGT + seg * 1024 + pn * 256;
            bf16_t* mg = F.Z() + (size_t)lt * 256 * ZP + CQ + pn * 256;
#pragma unroll
            for (int ai = 0; ai < 2; ++ai) {
                u32x4 gq[4][2], pq[4][2];
#pragma unroll
                for (int m = 0; m < 4; ++m)
#pragma unroll
                    for (int bj = 0; bj < 2; ++bj) { const size_t off = (size_t)(row0 + ai * 128 + m * 16) * ZP + col0 + bj * 128;
                        gq[m][bj] = *(const u32x4*)(gate + off); if (seg > 0) pq[m][bj] = *(const u32x4*)(mg + off); }
#pragma unroll
                for (int m = 0; m < 4; ++m)
#pragma unroll
                    for (int bj = 0; bj < 2; ++bj) { const size_t off = (size_t)(row0 + ai * 128 + m * 16) * ZP + col0 + bj * 128;
                        const u32x4 g = gq[m][bj]; const f32x4 a0 = acc[ai][bj][m][0], a1 = acc[ai][bj][m][1];
                        float v[8] = {a0[0] * bf_lo(g.x), a0[1] * bf_hi(g.x), a0[2] * bf_lo(g.y), a0[3] * bf_hi(g.y), a1[0] * bf_lo(g.z), a1[1] * bf_hi(g.z), a1[2] * bf_lo(g.w), a1[3] * bf_hi(g.w)};
                        if (seg > 0) { const u32x4 p = pq[m][bj];
                            v[0] += bf_lo(p.x); v[1] += bf_hi(p.x); v[2] += bf_lo(p.y); v[3] += bf_hi(p.y); v[4] += bf_lo(p.z); v[5] += bf_hi(p.z); v[6] += bf_lo(p.w); v[7] += bf_hi(p.w); }
                        u32x4 w; w.x = cvt_pk_bf16(v[0], v[1]); w.y = cvt_pk_bf16(v[2], v[3]); w.z = cvt_pk_bf16(v[4], v[5]); w.w = cvt_pk_bf16(v[6], v[7]);
                        *(u32x4*)(mg + off) = w; }
                asm volatile("" ::: "memory");
            }
        } else if (EPI_EN(3) && (kind == K_G3 || kind == K_G5)) {
            const int pn = u.pn; const bool g3 = (kind == K_G3);
            bool lat; size_t r0; int b;
            if (g3) { const int lt = u.pm; lat = lt < 64; r0 = lat ? (size_t)(64 * c + lt) * 256 : (size_t)(4 * c + lt - 64) * 256; b = lat ? 4 * c + (lt >> 4) : 8; }
            else { const int pm = u.pm; lat = pm < 128; r0 = lat ? (size_t)pm * 256 : (size_t)(pm - 128) * 256; b = lat ? (pm >> 4) : 8; }
            const float* base = lat ? ((g3 && l == 0) ? F.x : F.out) : ((g3 && l == 0) ? F.ctx : F.XC());
            float* fout = lat ? F.out : F.XC();
            base += r0 * DM + pn * 256; fout += r0 * DM + pn * 256;
            const float* vec = F.MOD(b) + (g3 ? 2048 : 5120) + pn * 256 + col0;
            f32x4 vv[2][2];
#pragma unroll
            for (int bj = 0; bj < 2; ++bj) { vv[bj][0] = *(const f32x4*)(vec + bj * 128); vv[bj][1] = *(const f32x4*)(vec + bj * 128 + 4); }
#pragma unroll
            for (int ai = 0; ai < 2; ++ai) {
                f32x4 bq0[4][2], bq1[4][2];
#pragma unroll
                for (int m = 0; m < 4; ++m)
#pragma unroll
                    for (int bj = 0; bj < 2; ++bj) { const size_t off = (size_t)(row0 + ai * 128 + m * 16) * DM + col0 + bj * 128;
                        bq0[m][bj] = *(const f32x4*)(base + off); bq1[m][bj] = *(const f32x4*)(base + off + 4); }
#pragma unroll
                for (int m = 0; m < 4; ++m)
#pragma unroll
                    for (int bj = 0; bj < 2; ++bj) { const size_t off = (size_t)(row0 + ai * 128 + m * 16) * DM + col0 + bj * 128;
                        *(f32x4*)(fout + off) = bq0[m][bj] + vv[bj][0] * acc[ai][bj][m][0]; *(f32x4*)(fout + off + 4) = bq1[m][bj] + vv[bj][1] * acc[ai][bj][m][1]; }
                asm volatile("" ::: "memory");
            }
        } else if (EPI_EN(4)) {
            bf16_t* dst = F.Z() + (size_t)u.pm * 256 * FFW + u.pn * 128;
#pragma unroll
            for (int ai = 0; ai < 2; ++ai)
#pragma unroll
                for (int m = 0; m < 4; ++m) { bf16_t* rowp = dst + (size_t)(row0 + ai * 128 + m * 16) * FFW + col0;
                    const f32x4 g0 = acc[ai][0][m][0], g1 = acc[ai][0][m][1], u0 = acc[ai][1][m][0], u1 = acc[ai][1][m][1];
                    u32x4 w; w.x = cvt_pk_bf16(silu_f(g0[0]) * u0[0], silu_f(g0[1]) * u0[1]); w.y = cvt_pk_bf16(silu_f(g0[2]) * u0[2], silu_f(g0[3]) * u0[3]);
                    w.z = cvt_pk_bf16(silu_f(g1[0]) * u1[0], silu_f(g1[1]) * u1[1]); w.w = cvt_pk_bf16(silu_f(g1[2]) * u1[2], silu_f(g1[3]) * u1[3]);
                    *(u32x4*)rowp = w; }
        }
    }
};

namespace att {
constexpr int D = 128, NW = 8, QBLK = 32, KVBLK = 64;
constexpr float SCALE = 0.088388347648318440f;
constexpr float THR = 8.f;
constexpr int LDQ = ZP, LDK = 256, LDO = ZP;
constexpr size_t SHM_V = KVBLK * D * 2, SHM_K = KVBLK * D * 2, SHM_ATTN = 2 * SHM_V + 2 * SHM_K + NW * 64 * 4;
#define KSWZ(row, colB) ((row) * 256 + ((colB) ^ (((row) & 7) << 4)))
#define SBAR() __builtin_amdgcn_sched_barrier(0)
__device__ __forceinline__ int crow(int r, int hi) { return (r & 3) + 8 * (r >> 2) + 4 * hi; }
__device__ __forceinline__ void partialSM(f32x16& p0, f32x16& p1, float& m_reg, float& mn, float& alpha) {
  constexpr float C = SCALE * 1.4426950408889634f;
  float pmax = p0[0]; for (int r = 1; r < 16; ++r) pmax = fmaxf(pmax, p0[r]); for (int r = 0; r < 16; ++r) pmax = fmaxf(pmax, p1[r]);
  { auto rr = __builtin_amdgcn_permlane32_swap(__float_as_uint(pmax), __float_as_uint(pmax), false, false);
    pmax = fmaxf(__uint_as_float(rr[0]), __uint_as_float(rr[1])); }
  if (__builtin_expect(__all(pmax - m_reg <= THR / SCALE), 1)) { mn = m_reg; alpha = 1.f; }
  else { mn = fmaxf(m_reg, pmax); alpha = __builtin_amdgcn_exp2f((m_reg - mn) * C); m_reg = mn; }
  float mnC = -mn * C;
  for (int r = 0; r < 16; ++r) p0[r] = fmaf(p0[r], C, mnC); for (int r = 0; r < 16; ++r) p1[r] = fmaf(p1[r], C, mnC);
  for (int r = 0; r < 16; ++r) p0[r] = __builtin_amdgcn_exp2f(p0[r]);
}
__device__ __forceinline__ void finishSM(f32x16& p0, f32x16& p1, float alpha, float& l_reg, bf16x8& pa0, bf16x8& pa1, bf16x8& pa2, bf16x8& pa3) {
  for (int r = 0; r < 16; ++r) p1[r] = __builtin_amdgcn_exp2f(p1[r]);
  float ps = 0; for (int r = 0; r < 16; ++r) ps += p0[r]; for (int r = 0; r < 16; ++r) ps += p1[r];
  { auto rr = __builtin_amdgcn_permlane32_swap(__float_as_uint(ps), __float_as_uint(ps), false, false);
    ps = __uint_as_float(rr[0]) + __uint_as_float(rr[1]); }
  l_reg = l_reg * alpha + ps;
#define PK4(P, BASE, OUT) do { unsigned a0 = cvt_pk_bf16(P[BASE + 0], P[BASE + 1]), a1 = cvt_pk_bf16(P[BASE + 2], P[BASE + 3]);   \
    unsigned b0 = cvt_pk_bf16(P[BASE + 4], P[BASE + 5]), b1 = cvt_pk_bf16(P[BASE + 6], P[BASE + 7]);                              \
    auto r0 = __builtin_amdgcn_permlane32_swap(a0, b0, false, false); auto r1 = __builtin_amdgcn_permlane32_swap(a1, b1, false, false); \
    u32x4 w = {r0[0], r1[0], r0[1], r1[1]}; OUT = *reinterpret_cast<bf16x8*>(&w); } while (0)
  PK4(p0, 0, pa0); PK4(p0, 8, pa1); PK4(p1, 0, pa2); PK4(p1, 8, pa3);
#undef PK4
}
__device__ __forceinline__ void qkt(f32x16& p0, f32x16& p1, const bf16_t* Ks, const bf16x8* qr, int r32, int hi) {
  p0 = f32x16{}; p1 = f32x16{};
#pragma unroll
  for (int d0 = 0; d0 < 8; ++d0) { int cb = (d0 * 16 + hi * 8) * 2;
    bf16x8 b0 = *reinterpret_cast<const bf16x8*>((const char*)Ks + KSWZ(r32, cb));
    bf16x8 b1 = *reinterpret_cast<const bf16x8*>((const char*)Ks + KSWZ(32 + r32, cb));
    p0 = __builtin_amdgcn_mfma_f32_32x32x16_bf16(b0, qr[d0], p0, 0, 0, 0);
    p1 = __builtin_amdgcn_mfma_f32_32x32x16_bf16(b1, qr[d0], p1, 0, 0, 0); }
}
__device__ __forceinline__ int v_st(int k, int c) { const int kk = (k & ~0xC) | ((k & 4) << 1) | ((k & 8) >> 1); return ((kk >> 3) * 4 + (c >> 5)) * 512 + ((kk & 7) * 32 + (c & 31)) * 2; }
__device__ __forceinline__ int v_rd_base(int lane) { return ((lane & 3) << 3) | (((lane >> 2) & 3) << 6) | (((lane >> 4) & 1) << 5) | (((lane >> 5) & 1) << 8); }
constexpr int v_rd_off(int d0, int ks, int half) { return d0 * 512 + ks * 4096 + half * 2048; }
template <int OFF> __device__ __forceinline__ s16x4 tr_read(int vb) {
  s16x4 r; asm volatile("ds_read_b64_tr_b16 %0, %1 offset:%2" : "=&v"(r) : "v"(vb), "i"(OFF) : "memory"); return r;
}
template <int D0> __device__ __forceinline__ void pv_one(f32x16& od, int vb, bf16x8 pa0, bf16x8 pa1, bf16x8 pa2, bf16x8 pa3) {
  const s16x4 l0 = tr_read<v_rd_off(D0, 0, 0)>(vb), h0 = tr_read<v_rd_off(D0, 0, 1)>(vb), l1 = tr_read<v_rd_off(D0, 1, 0)>(vb), h1 = tr_read<v_rd_off(D0, 1, 1)>(vb);
  const s16x4 l2 = tr_read<v_rd_off(D0, 2, 0)>(vb), h2 = tr_read<v_rd_off(D0, 2, 1)>(vb), l3 = tr_read<v_rd_off(D0, 3, 0)>(vb), h3 = tr_read<v_rd_off(D0, 3, 1)>(vb);
  asm volatile("s_waitcnt lgkmcnt(0)" ::: "memory"); SBAR();
#define PK(L, H) (bf16x8){L[0], L[1], L[2], L[3], H[0], H[1], H[2], H[3]}
  od = __builtin_amdgcn_mfma_f32_32x32x16_bf16(pa0, PK(l0, h0), od, 0, 0, 0);
  od = __builtin_amdgcn_mfma_f32_32x32x16_bf16(pa1, PK(l1, h1), od, 0, 0, 0);
  od = __builtin_amdgcn_mfma_f32_32x32x16_bf16(pa2, PK(l2, h2), od, 0, 0, 0);
  od = __builtin_amdgcn_mfma_f32_32x32x16_bf16(pa3, PK(l3, h3), od, 0, 0, 0);
#undef PK
}
__device__ __forceinline__ void pv_d0(f32x16* o, int vb, bf16x8 pa0, bf16x8 pa1, bf16x8 pa2, bf16x8 pa3) {
  pv_one<0>(o[0], vb, pa0, pa1, pa2, pa3); pv_one<1>(o[1], vb, pa0, pa1, pa2, pa3); pv_one<2>(o[2], vb, pa0, pa1, pa2, pa3); pv_one<3>(o[3], vb, pa0, pa1, pa2, pa3);
}
__device__ __forceinline__ void attn_dense_body(const bf16_t* Qb, const bf16_t* __restrict__ Kh, const bf16_t* __restrict__ Vh, bf16_t* Ob, int seq, char* lds, int wave_s) {
  const int tid = tid_opaque(wave_s), wid = __builtin_amdgcn_readfirstlane(tid >> 6), lane = tid & 63, r32 = lane & 31, hi = lane >> 5;
  bf16_t* V_lds = (bf16_t*)lds; bf16_t* K_lds = (bf16_t*)(lds + 2 * SHM_V);
  float* ws = (float*)(lds + 2 * SHM_V + 2 * SHM_K) + wid * 64; float* li_l = ws; float* al_l = ws + 32;
  float m_reg = -1e30f, l_reg = 0; f32x16 o[4] = {}; bf16x8 qr[8];
  const bf16_t* Qw = Qb + (long)(wid * QBLK + r32) * LDQ + hi * 8;
#pragma unroll
  for (int d0 = 0; d0 < 8; ++d0) qr[d0] = *reinterpret_cast<const bf16x8*>(Qw + d0 * 16);
  const int sr = tid >> 4, sc = (tid & 15) * 8, vst0 = v_st(sr, sc), vst1 = v_st(32 + sr, sc);
  const int vb0 = (int)(uintptr_t)V_lds + v_rd_base(lane);
  struct { bf16x8 vs0, vs1, ks0, ks1; } sr_[2];
#define SLOAD(i, k0) do { sr_[i].vs0 = *reinterpret_cast<const bf16x8*>(&Vh[(long)((k0) + sr) * LDK + sc]); sr_[i].vs1 = *reinterpret_cast<const bf16x8*>(&Vh[(long)((k0) + 32 + sr) * LDK + sc]); \
    sr_[i].ks0 = *reinterpret_cast<const bf16x8*>(&Kh[(long)((k0) + sr) * LDK + sc]); sr_[i].ks1 = *reinterpret_cast<const bf16x8*>(&Kh[(long)((k0) + 32 + sr) * LDK + sc]); } while (0)
#define SWRITE(b, i) do { *(bf16x8*)((char*)V_lds + (b) * SHM_V + vst0) = sr_[i].vs0;          \
    *(bf16x8*)((char*)V_lds + (b) * SHM_V + vst1) = sr_[i].vs1; int kc = sc * 2;               \
    *(bf16x8*)((char*)K_lds + (b) * SHM_K + KSWZ(sr, kc)) = sr_[i].ks0;                       \
    *(bf16x8*)((char*)K_lds + (b) * SHM_K + KSWZ(32 + sr, kc)) = sr_[i].ks1; } while (0)
#define SWAIT() asm volatile("s_waitcnt vmcnt(4)" ::: "memory")
#define RESC(a) do { if (__any((a) < 1.f)) { if (hi == 0) al_l[r32] = (a); asm volatile("s_waitcnt lgkmcnt(0)" ::: "memory"); \
    for (int d = 0; d < 4; ++d) for (int r = 0; r < 16; ++r) o[d][r] *= al_l[crow(r, hi)]; } } while (0)
  f32x16 pA0, pA1, pB0, pB1; float mnA, mnB, alA, alB; bf16x8 pa0, pa1, pa2, pa3; const int NT = seq / KVBLK;
  constexpr int SE = 0, SO = 1;
  SLOAD(SE, 0); asm volatile("s_waitcnt vmcnt(0)" ::: "memory"); SWRITE(0, SE); __syncthreads();
  qkt(pA0, pA1, K_lds, qr, r32, hi); partialSM(pA0, pA1, m_reg, mnA, alA);
  SLOAD(SO, KVBLK); if (2 < NT) SLOAD(SE, 2 * KVBLK);
  SWAIT(); SWRITE(1, SO); __syncthreads();
  for (int j = 1; j + 1 < NT; j += 2) {
    SBAR(); qkt(pB0, pB1, (bf16_t*)((char*)K_lds + SHM_K), qr, r32, hi);
    finishSM(pA0, pA1, alA, l_reg, pa0, pa1, pa2, pa3); SBAR();
    SLOAD(SO, (j + 2) * KVBLK); SBAR();
    pv_d0(o, vb0, pa0, pa1, pa2, pa3); partialSM(pB0, pB1, m_reg, mnB, alB);
    __syncthreads(); SWAIT(); SWRITE(0, SE);
    RESC(alB); __syncthreads();
    SBAR(); qkt(pA0, pA1, K_lds, qr, r32, hi);
    finishSM(pB0, pB1, alB, l_reg, pa0, pa1, pa2, pa3); SBAR();
    if (j + 3 < NT) SLOAD(SE, (j + 3) * KVBLK); SBAR();
    pv_d0(o, vb0 + (int)SHM_V, pa0, pa1, pa2, pa3); partialSM(pA0, pA1, m_reg, mnA, alA);
    __syncthreads(); SWAIT(); SWRITE(1, SO);
    RESC(alA); __syncthreads();
  }
  SBAR(); qkt(pB0, pB1, (bf16_t*)((char*)K_lds + SHM_K), qr, r32, hi);
  finishSM(pA0, pA1, alA, l_reg, pa0, pa1, pa2, pa3); SBAR();
  pv_d0(o, vb0, pa0, pa1, pa2, pa3); partialSM(pB0, pB1, m_reg, mnB, alB);
  __syncthreads(); RESC(alB);
  finishSM(pB0, pB1, alB, l_reg, pa0, pa1, pa2, pa3); SBAR();
  pv_d0(o, vb0 + (int)SHM_V, pa0, pa1, pa2, pa3);
  if (hi == 0) li_l[r32] = l_reg; asm volatile("s_waitcnt lgkmcnt(0)" ::: "memory");
  float rli[16];
#pragma unroll
  for (int r = 0; r < 16; ++r) rli[r] = __builtin_amdgcn_rcpf(li_l[crow(r, hi)]);
  bf16_t* Ow = Ob + (long)(wid * QBLK) * LDO;
#pragma unroll
  for (int r = 0; r < 16; ++r) { int orow = crow(r, hi);
#pragma unroll
    for (int d0 = 0; d0 < 4; ++d0) { const float v = o[d0][r] * rli[r]; Ow[(long)orow * LDO + d0 * 32 + r32] = (bf16_t)(cvt_pk_bf16(v, v) & 0xffffu); } }
  __syncthreads();
#undef SLOAD
#undef SWRITE
#undef SWAIT
#undef RESC
}
#undef KSWZ
#undef SBAR
}

__device__ __forceinline__ void p0_transpose_item(const float* W, int K, int N, bf16_t* WT, int mode, LAS float* scr, int item, int lane) {
    const int nblk = N / 32, kb = item / nblk, nb = item % nblk, k0 = 64 * kb, n0 = 32 * nb;
#pragma unroll 8
    for (int i = 0; i < 32; ++i) { const int kk = 2 * i + (lane >> 5); scr[kk * 33 + (lane & 31)] = W[(size_t)(k0 + kk) * N + n0 + (lane & 31)]; }
    asm volatile("s_waitcnt lgkmcnt(0)" ::: "memory");
    int r0 = n0;
    if (mode == 1) r0 = n0 < FFW ? 256 * (n0 / 128) + (n0 % 128) : 256 * ((n0 - FFW) / 128) + 128 + ((n0 - FFW) % 128);
    const int c = lane & 7;
#pragma unroll
    for (int j = 0; j < 4; ++j) { const int n = (lane >> 3) + 8 * j; const LAS float* s = scr + (8 * c) * 33 + n;
        u32x4 o; o.x = cvt_pk_bf16(s[0 * 33], s[1 * 33]); o.y = cvt_pk_bf16(s[2 * 33], s[3 * 33]); o.z = cvt_pk_bf16(s[4 * 33], s[5 * 33]); o.w = cvt_pk_bf16(s[6 * 33], s[7 * 33]);
        *(u32x4*)(WT + (size_t)(r0 + n) * K + k0 + 8 * c) = o; }
    asm volatile("s_waitcnt lgkmcnt(0)" ::: "memory");
}

__device__ __forceinline__ void phase_p0(CArgs a, const Frame& F, LAS unsigned char* lds) {
    const int tid = tid_opaque(F.wave_s), lane = tid & 63, wave = __builtin_amdgcn_readfirstlane(tid >> 6);
    for (int it = bid_opaque(); it < 96; it += gridDim.x) {
        const int l = it / 48, cg0 = (it % 48) * 128;
        LAS float* sv = (LAS float*)lds;
        LAS float* red = (LAS float*)(lds + 9 * 1024 * 4);
        for (int e = tid; e < 9 * 1024; e += NTHREADS) { const int b = e >> 10, k = e & 1023; const float v = b < 8 ? a->in[1][b * 1024 + k] : a->in[3][k]; sv[e] = v * fast_sigmoid(v); }
        __syncthreads();
        const int kq = tid >> 7, col = tid & 127;
        float accv[9];
#pragma unroll
        for (int b = 0; b < 9; ++b) accv[b] = 0.f;
        const float* wp = a->in[4] + ((size_t)l * 1024 + kq * 256) * 6144 + cg0 + col;
#pragma unroll 4
        for (int k = 0; k < 256; ++k) { const float w = wp[(size_t)k * 6144];
#pragma unroll
            for (int b = 0; b < 9; ++b) accv[b] += sv[b * 1024 + kq * 256 + k] * w; }
#pragma unroll
        for (int b = 0; b < 9; ++b) red[(kq * 9 + b) * 128 + col] = accv[b];
        __syncthreads();
        if (tid < 128) {
#pragma unroll
            for (int b = 0; b < 9; ++b) { const float s = red[(0 * 9 + b) * 128 + tid] + red[(1 * 9 + b) * 128 + tid] + red[(2 * 9 + b) * 128 + tid] + red[(3 * 9 + b) * 128 + tid];
                ((float*)(a->ws + WS_MOD))[(size_t)(l * 9 + b) * 6144 + cg0 + tid] = s + a->in[5][l * 6144 + cg0 + tid]; }
        }
        __syncthreads();
    }
    if (bid_opaque() == gridDim.x - 1) {
        for (int e = tid; e < 2048; e += NTHREADS) { const int pos = e >> 5, f = e & 31; const float inv = __builtin_amdgcn_exp2f(-(float)f * (13.287712379549449f / 32.0f)); const float rev = (float)pos * inv * 0.15915494309189535f;
            const float fr_ = rev - floorf(rev);
            ((f32x2*)(a->ws + WS_ROPE))[e] = (f32x2){__builtin_amdgcn_cosf(fr_), __builtin_amdgcn_sinf(fr_)}; }
    }
    LAS float* scr = (LAS float*)(lds + 57344 + wave * 8704);
    const int gw = bid_opaque() * NWAVES + wave, NGW = gridDim.x * NWAVES;
    constexpr int I_IN = 16 * 304, I_SQ = 16 * 32, I_F1 = 16 * 176, I_F2 = 44 * 32, I_LRU = 256, I_LAYER = I_IN + 4 * I_SQ + I_F1 + I_F2 + I_LRU;
    for (int it = gw; it < 2 * I_LAYER; it += NGW) {
        const int l = it / I_LAYER; int r = it % I_LAYER;
        unsigned char* wl = a->ws + WS_W + (size_t)l * W_LAYER;
        if (r < I_IN) { p0_transpose_item(a->in[8] + (size_t)l * DM * NIN, DM, NIN, (bf16_t*)(wl + W_IN), 0, scr, r, lane); continue; } r -= I_IN;
        if (r < I_SQ) { p0_transpose_item(a->in[11] + (size_t)l * DM * DM, DM, DM, (bf16_t*)(wl + W_AO), 0, scr, r, lane); continue; } r -= I_SQ;
        if (r < I_SQ) { p0_transpose_item(a->in[14] + (size_t)l * DM * DM, DM, DM, (bf16_t*)(wl + W_SO), 0, scr, r, lane); continue; } r -= I_SQ;
        if (r < I_SQ) { p0_transpose_item(a->in[22] + (size_t)l * DM * DM, DM, DM, (bf16_t*)(wl + W_LO), 0, scr, r, lane); continue; } r -= I_SQ;
        if (r < I_SQ) { p0_transpose_item(a->in[23] + (size_t)l * DM * DM, DM, DM, (bf16_t*)(wl + W_MO), 0, scr, r, lane); continue; } r -= I_SQ;
        if (r < I_F1) { p0_transpose_item(a->in[24] + (size_t)l * DM * 2 * FFW, DM, 2 * FFW, (bf16_t*)(wl + W_F1), 1, scr, r, lane); continue; } r -= I_F1;
        if (r < I_F2) { p0_transpose_item(a->in[25] + (size_t)l * FFW * DM, FFW, DM, (bf16_t*)(wl + W_F2), 0, scr, r, lane); continue; } r -= I_F2;
        { const int mat = r >> 3, d = mat >> 4, g = (mat >> 3) & 1, n = mat & 7;
          const float* src = (g == 0 ? a->in[17] : a->in[19]) + (size_t)((l * 2 + d) * 8 + n) * 16384;
          p0_transpose_item(src, 128, 128, (bf16_t*)(wl + W_LRU) + (size_t)((d * 2 + g) * 8 + n) * 16384, 0, scr, r & 7, lane); }
    }
}

__device__ __forceinline__ void phase_norm(CArgs a, const Frame& F, int which) {
    const int tid_ = tid_opaque(F.wave_s); const int lane = tid_ & 63, wave = __builtin_amdgcn_readfirstlane(tid_ >> 6);
    const int gw = bid_opaque() * NWAVES + wave, NGW = gridDim.x * NWAVES;
    const bool first = (which == 0 && F.l == 0);
    const int nrows = (which == 1 && F.l == 1) ? LROWS : ROWS;
    const float* g = (which == 0 ? a->in[6] : a->in[7]) + F.l * DM;
    for (int m = gw; m < nrows; m += NGW) {
        const bool lat = m < LROWS;
        const float* src = lat ? (first ? F.x : F.out) + (size_t)m * DM : (first ? F.ctx : F.XC()) + (size_t)(m - LROWS) * DM;
        const int b = lat ? (m >> 12) : 8;
        const float* md = F.MOD(b) + (which == 0 ? 0 : 3072);
        f32x4 v[4]; float s = 0.f;
#pragma unroll
        for (int j = 0; j < 4; ++j) { v[j] = *(const f32x4*)(src + 4 * lane + 256 * j); s += (v[j].x * v[j].x + v[j].y * v[j].y) + (v[j].z * v[j].z + v[j].w * v[j].w); }
        const float rstd = rsqrtf(wave_sum(s) * (1.f / DM) + EPS);
        bf16_t* dst = F.H() + (size_t)m * DM;
#pragma unroll
        for (int j = 0; j < 4; ++j) { const int col = 4 * lane + 256 * j;
            const f32x4 gg = *(const f32x4*)(g + col), sh = *(const f32x4*)(md + col), sc = *(const f32x4*)(md + 1024 + col);
            const f32x4 h = (v[j] * rstd * gg) * (sc + 1.0f) + sh;
            u32x2 w; w.x = cvt_pk_bf16(h.x, h.y); w.y = cvt_pk_bf16(h.z, h.w); *(u32x2*)(dst + col) = w; }
    }
}
__device__ __forceinline__ void phase_final(CArgs a, const Frame& F) {
    const int tid_ = tid_opaque(F.wave_s); const int lane = tid_ & 63, wave = __builtin_amdgcn_readfirstlane(tid_ >> 6);
    const int gw = bid_opaque() * NWAVES + wave, NGW = gridDim.x * NWAVES;
    const float* g = a->in[26];
    for (int m = gw; m < LROWS; m += NGW) {
        float* p = F.out + (size_t)m * DM;
        f32x4 v[4]; float s = 0.f;
#pragma unroll
        for (int j = 0; j < 4; ++j) { v[j] = *(const f32x4*)(p + 4 * lane + 256 * j); s += (v[j].x * v[j].x + v[j].y * v[j].y) + (v[j].z * v[j].z + v[j].w * v[j].w); }
        const float rstd = rsqrtf(wave_sum(s) * (1.f / DM) + EPS);
#pragma unroll
        for (int j = 0; j < 4; ++j) { const int col = 4 * lane + 256 * j; *(f32x4*)(p + col) = v[j] * rstd * *(const f32x4*)(g + col); }
    }
}

struct QkRow { u32x4 raw[3]; bf16_t* p[3]; bool act[3]; bool lat; int pos; };
__device__ __forceinline__ void qk_load(const Frame& F, int lr, int s, int i, int qd, QkRow& R) {
    const bool lat = lr < CH_L; R.lat = lat;
    int kvrow, prow = 0, pcol = 0;
    if (lat) { const int bl = lr >> 12, t = lr & 4095; kvrow = bl * KVLEN + CTXL + t; prow = t >> 6; pcol = t & 63; }
    else { const int lc = lr - CH_L; kvrow = (lc >> 8) * KVLEN + (lc & 255); }
    R.pos = qd < 2 ? prow : pcol;
#pragma unroll
    for (int it = 0; it < 3; ++it) { const int hs = 4 * it + s;
        R.act[it] = hs < 10 && (lat || F.l == 0 || it == 2) && lr < CH_ROWS;
        R.p[it] = hs < 8 ? F.Z() + (size_t)lr * ZP + hs * 128 + 8 * i : F.Kb() + (size_t)kvrow * 256 + (hs - 8) * 128 + 8 * i;
        if (R.act[it]) R.raw[it] = *(const u32x4*)R.p[it]; }
}
__device__ __forceinline__ void qk_finish(const Frame& F, const float* qg, const float* kg, const f32x2* rope, int s, int i, int qd, const QkRow& R) {
#pragma unroll
    for (int it = 0; it < 3; ++it) {
        if (R.act[it]) {
            const int hs = 4 * it + s; const float* gp = hs < 8 ? qg : kg; const u32x4 raw = R.raw[it];
            float v[8] = {bf_lo(raw.x), bf_hi(raw.x), bf_lo(raw.y), bf_hi(raw.y), bf_lo(raw.z), bf_hi(raw.z), bf_lo(raw.w), bf_hi(raw.w)};
            float ss = 0.f;
#pragma unroll
            for (int e = 0; e < 8; ++e) ss += v[e] * v[e];
            ss += __shfl_xor(ss, 1); ss += __shfl_xor(ss, 2); ss += __shfl_xor(ss, 4); ss += __shfl_xor(ss, 8);
            const float rstd = rsqrtf(ss * (1.f / 128.f) + EPS);
            const f32x4 g0 = *(const f32x4*)gp, g1 = *(const f32x4*)(gp + 4);
            v[0] *= rstd * g0.x; v[1] *= rstd * g0.y; v[2] *= rstd * g0.z; v[3] *= rstd * g0.w; v[4] *= rstd * g1.x; v[5] *= rstd * g1.y; v[6] *= rstd * g1.z; v[7] *= rstd * g1.w;
            if (R.lat) {
                const f32x2* rp = rope + R.pos * 32 + 8 * (i & 3);
#pragma unroll
                for (int e = 0; e < 8; ++e) { const float pv = __shfl_xor(v[e], 4); const f32x2 cs = rp[e]; v[e] = (qd & 1) ? v[e] * cs.x + pv * cs.y : v[e] * cs.x - pv * cs.y; }
            }
            u32x4 w; w.x = cvt_pk_bf16(v[0], v[1]); w.y = cvt_pk_bf16(v[2], v[3]); w.z = cvt_pk_bf16(v[4], v[5]); w.w = cvt_pk_bf16(v[6], v[7]);
            *(u32x4*)R.p[it] = w;
        }
    }
}
__device__ __forceinline__ void phase_qknorm(CArgs a, const Frame& F) {
    const int tid_ = tid_opaque(F.wave_s); const int lane = tid_ & 63, wave = __builtin_amdgcn_readfirstlane(tid_ >> 6);
    const int gw = bid_opaque() * NWAVES + wave, NGW = gridDim.x * NWAVES;
    const int s = lane >> 4, i = lane & 15, qd = i >> 2;
    const float* qg = a->in[9] + F.l * 128 + 8 * i; const float* kg = a->in[10] + F.l * 128 + 8 * i;
    const f32x2* rope = (const f32x2*)(F.ws + WS_ROPE);
    for (int lr = gw; lr < CH_ROWS; lr += 2 * NGW) {
        QkRow R0, R1;
        qk_load(F, lr, s, i, qd, R0); qk_load(F, lr + NGW, s, i, qd, R1);
        qk_finish(F, qg, kg, rope, s, i, qd, R0); qk_finish(F, qg, kg, rope, s, i, qd, R1);
    }
}

__device__ __forceinline__ void phase_sconv(CArgs a, const Frame& F) {
    const int tid_ = tid_opaque(F.wave_s); const int lane = tid_ & 63, wave = __builtin_amdgcn_readfirstlane(tid_ >> 6);
    const int gw = bid_opaque() * NWAVES + wave, NGW = gridDim.x * NWAVES;
    const int nrows = (F.l == 0) ? CH_ROWS : CH_L;
    const float* wsc = a->in[12] + (size_t)F.l * 3 * DM; const float* bsc = a->in[13] + (size_t)F.l * DM;
    for (int it = gw; it < (nrows / 16) * 2; it += NGW) {
        const int run = it >> 1, ch0 = (it & 1) * 512 + lane * 8, lr0 = run * 16;
        int t0, slen;
        if (lr0 < CH_L) { t0 = lr0 & 4095; slen = SEQ; } else { t0 = (lr0 - CH_L) & 255; slen = CTXL; }
        float w0[8], w1[8], w2[8], bb[8];
#pragma unroll
        for (int e = 0; e < 8; ++e) { w0[e] = wsc[ch0 + e]; w1[e] = wsc[DM + ch0 + e]; w2[e] = wsc[2 * DM + ch0 + e]; bb[e] = bsc[ch0 + e]; }
        bf16_t* zr = F.Z() + (size_t)lr0 * ZP + ch0;
        float up[8], uc[8], un[8];
        auto loadu = [&](int dt, float* u, bool valid) {
            if (valid) { const u32x4 cc = *(const u32x4*)(zr + (long)dt * ZP + CSC), xx = *(const u32x4*)(zr + (long)dt * ZP + CSX);
                u[0] = bf_lo(cc.x) * bf_lo(xx.x); u[1] = bf_hi(cc.x) * bf_hi(xx.x); u[2] = bf_lo(cc.y) * bf_lo(xx.y); u[3] = bf_hi(cc.y) * bf_hi(xx.y);
                u[4] = bf_lo(cc.z) * bf_lo(xx.z); u[5] = bf_hi(cc.z) * bf_hi(xx.z); u[6] = bf_lo(cc.w) * bf_lo(xx.w); u[7] = bf_hi(cc.w) * bf_hi(xx.w); }
            else {
#pragma unroll
                for (int e = 0; e < 8; ++e) u[e] = 0.f; } };
        loadu(-1, up, t0 > 0); loadu(0, uc, true);
#pragma unroll 8
        for (int tt = 0; tt < 16; ++tt) {
            loadu(tt + 1, un, t0 + tt + 1 < slen);
            const u32x4 bq = *(const u32x4*)(zr + (long)tt * ZP + CSB);
            const float bv[8] = {bf_lo(bq.x), bf_hi(bq.x), bf_lo(bq.y), bf_hi(bq.y), bf_lo(bq.z), bf_hi(bq.z), bf_lo(bq.w), bf_hi(bq.w)};
            float o[8];
#pragma unroll
            for (int e = 0; e < 8; ++e) { o[e] = bv[e] * (bb[e] + w0[e] * up[e] + w1[e] * uc[e] + w2[e] * un[e]); up[e] = uc[e]; uc[e] = un[e]; }
            u32x4 w; w.x = cvt_pk_bf16(o[0], o[1]); w.y = cvt_pk_bf16(o[2], o[3]); w.z = cvt_pk_bf16(o[4], o[5]); w.w = cvt_pk_bf16(o[6], o[7]);
            *(u32x4*)(zr + (long)tt * ZP + CSB) = w;
        }
    }
}

constexpr int L_XS = 0, L_XS_STRIDE = 136, L_YT = 17408, L_YT_STRIDE = 132, L_WV = L_YT + 64 * L_YT_STRIDE * 4, L_WV_BYTES = 2 * 16 * 68 * 4, L_CW = L_WV + 8 * L_WV_BYTES;
constexpr int L_XS2 = L_CW + 5 * 128 * 4;
static_assert(L_XS2 + 64 * L_XS_STRIDE * 2 <= MISC_OFF, "lru lds");
struct LruCtx { bf16x8 wf[2][2][4]; float pba[2], pbx[2], spl[2]; };
__device__ __forceinline__ void lru_setup(CArgs a, const Frame& F, int n, LruCtx& C) {
    const int tid = tid_opaque(F.wave_s), lane = tid & 63, wave = __builtin_amdgcn_readfirstlane(tid >> 6), fr = lane & 15, fq = lane >> 4;
    const int l = F.l, ech = wave * 16 + fr, chg = n * 128 + ech;
    const bf16_t* wt = F.W(W_LRU) + (size_t)n * 16384 + (size_t)ech * 128 + fq * 8;
#pragma unroll
    for (int d = 0; d < 2; ++d)
#pragma unroll
        for (int g = 0; g < 2; ++g)
#pragma unroll
            for (int ks = 0; ks < 4; ++ks) C.wf[d][g][ks] = *(const bf16x8*)(wt + (size_t)((d * 2 + g) * 8) * 16384 + ks * 32);
#pragma unroll
    for (int d = 0; d < 2; ++d) { C.pba[d] = a->in[18][(l * 2 + d) * DM + chg]; C.pbx[d] = a->in[20][(l * 2 + d) * DM + chg]; const float lam = a->in[21][(l * 2 + d) * DM + chg];
        const float ey = __builtin_amdgcn_exp2f(-lam * 1.4426950408889634f);
        const float sp_small = ey * (1.0f + ey * (-0.5f + ey * (0.33333334f + ey * (-0.25f + ey * 0.2f))));
        const float sp_big = (lam < -15.f) ? -lam : __builtin_amdgcn_logf(1.0f + ey) * 0.6931471805599453f;
        C.spl[d] = (ey < 0.125f ? sp_small : sp_big) * (8.0f * 1.4426950408889634f); }
}
struct XRows { u32x4 r[4][2]; };
__device__ __forceinline__ void lru_load_rows(const Frame& F, int tile, int n, XRows& X) {
    const int tid = tid_opaque(F.wave_s), t = tid >> 3, c0 = (tid & 7) * 16;
    const int lrow0 = tile < 256 ? tile * 64 : CH_L + (tile - 256) * 64;
#pragma unroll
    for (int k = 0; k < 4; ++k) { int row = lrow0 + t + k - 2; row = row < 0 ? 0 : (row > CH_ROWS - 1 ? CH_ROWS - 1 : row);
        const bf16_t* zr = F.Z() + (size_t)row * ZP + CRX + n * 128 + c0; X.r[k][0] = *(const u32x4*)zr; X.r[k][1] = *(const u32x4*)(zr + 8); }
}
__device__ __forceinline__ void lru_item(CArgs a, const Frame& F, LAS unsigned char* lds, int pass, int tile, int n, const LruCtx& C, const float cy, const XRows& X, const int xbuf) {
    const int tid = tid_opaque(F.wave_s), lane = tid & 63, wave = __builtin_amdgcn_readfirstlane(tid >> 6), fr = lane & 15, fq = lane >> 4;
    const int l = F.l;
    LAS bf16_t* xs = (LAS bf16_t*)(lds + (xbuf ? L_XS2 : L_XS)); LAS float* yt = (LAS float*)(lds + L_YT);
    LAS float* wa = (LAS float*)(lds + L_WV + wave * L_WV_BYTES); LAS float* wu = wa + 16 * 68;
    int lrow0, t0, slen;
    if (tile < 256) { lrow0 = tile * 64; t0 = (tile & 63) * 64; slen = SEQ; }
    else { const int jj = tile - 256; lrow0 = CH_L + jj * 64; t0 = (jj & 3) * 64; slen = CTXL; }
    float* lsum = (float*)(F.ws + WS_LSUM);
    const int ech = wave * 16 + fr, chg = n * 128 + ech;
    u32x4 g0 = {0u, 0u, 0u, 0u}, g1 = {0u, 0u, 0u, 0u};
    if (pass == 2) { const bf16_t* zg = F.Z() + (size_t)(lrow0 + (tid >> 3)) * ZP + CRG + n * 128 + (tid & 7) * 16; g0 = *(const u32x4*)zg; g1 = *(const u32x4*)(zg + 8); }
    {
        const int t = tid >> 3, c0 = (tid & 7) * 16;
        const LAS float* cw = (const LAS float*)(lds + L_CW) + c0;
        float accv[16];
#pragma unroll
        for (int i = 0; i < 4; ++i) { const f32x4 b4 = *(const LAS f32x4*)(cw + 4 * 128 + 4 * i); accv[4 * i] = b4[0]; accv[4 * i + 1] = b4[1]; accv[4 * i + 2] = b4[2]; accv[4 * i + 3] = b4[3]; }
#pragma unroll
        for (int k = 0; k < 4; ++k) { const int ts = t0 + t + k - 2;
            if (ts >= 0 && ts < slen) { const u32x4 r0 = X.r[k][0], r1 = X.r[k][1];
                const float xv[16] = {bf_lo(r0.x), bf_hi(r0.x), bf_lo(r0.y), bf_hi(r0.y), bf_lo(r0.z), bf_hi(r0.z), bf_lo(r0.w), bf_hi(r0.w), bf_lo(r1.x), bf_hi(r1.x), bf_lo(r1.y), bf_hi(r1.y), bf_lo(r1.z), bf_hi(r1.z), bf_lo(r1.w), bf_hi(r1.w)};
#pragma unroll
                for (int i = 0; i < 4; ++i) { const f32x4 w4 = *(const LAS f32x4*)(cw + k * 128 + 4 * i);
                    accv[4 * i] += xv[4 * i] * w4[0]; accv[4 * i + 1] += xv[4 * i + 1] * w4[1]; accv[4 * i + 2] += xv[4 * i + 2] * w4[2]; accv[4 * i + 3] += xv[4 * i + 3] * w4[3]; } } }
        u32x4 w0, w1; w0.x = cvt_pk_bf16(accv[0], accv[1]); w0.y = cvt_pk_bf16(accv[2], accv[3]); w0.z = cvt_pk_bf16(accv[4], accv[5]); w0.w = cvt_pk_bf16(accv[6], accv[7]);
        w1.x = cvt_pk_bf16(accv[8], accv[9]); w1.y = cvt_pk_bf16(accv[10], accv[11]); w1.z = cvt_pk_bf16(accv[12], accv[13]); w1.w = cvt_pk_bf16(accv[14], accv[15]);
        *(LAS u32x4*)(xs + t * L_XS_STRIDE + c0) = w0; *(LAS u32x4*)(xs + t * L_XS_STRIDE + c0 + 8) = w1;
    }
    __syncthreads();
    f32x4 accg[2][2][4];
#pragma unroll
    for (int d = 0; d < 2; ++d)
#pragma unroll
        for (int g = 0; g < 2; ++g)
#pragma unroll
            for (int m = 0; m < 4; ++m) accg[d][g][m] = (f32x4){0.f, 0.f, 0.f, 0.f};
#pragma unroll
    for (int ks = 0; ks < 4; ++ks)
#pragma unroll
        for (int m = 0; m < 4; ++m) { const bf16x8 af = *(const LAS bf16x8*)(xs + (16 * m + fr) * L_XS_STRIDE + ks * 32 + fq * 8);
#pragma unroll
            for (int d = 0; d < 2; ++d)
#pragma unroll
                for (int g = 0; g < 2; ++g) accg[d][g][m] = __builtin_amdgcn_mfma_f32_16x16x32_bf16(af, C.wf[d][g][ks], accg[d][g][m], 0, 0, 0); }
    float xv[4][4];
#pragma unroll
    for (int m = 0; m < 4; ++m)
#pragma unroll
        for (int jj = 0; jj < 4; ++jj) xv[m][jj] = bf1(xs[(16 * m + 4 * fq + jj) * L_XS_STRIDE + ech]);
    float y[16];
#pragma unroll
    for (int d = 0; d < 2; ++d) {
#pragma unroll
        for (int m = 0; m < 4; ++m) { f32x4 av, uv;
#pragma unroll
            for (int jj = 0; jj < 4; ++jj) {
                const float r = fast_sigmoid(accg[d][0][m][jj] + C.pba[d]), ig = fast_sigmoid(accg[d][1][m][jj] + C.pbx[d]);
                const float av1 = __builtin_amdgcn_exp2f(-r * C.spl[d]);
                const float om = __builtin_fmaf(-av1, av1, 1.0f);
                av[jj] = av1; uv[jj] = __builtin_amdgcn_sqrtf(om) * (ig * xv[m][jj]); }
            *(LAS f32x4*)(wa + fr * 68 + 16 * m + 4 * fq) = av; *(LAS f32x4*)(wu + fr * 68 + 16 * m + 4 * fq) = uv; }
        asm volatile("s_waitcnt lgkmcnt(0)" ::: "memory");
        f32x4 A4[4], U4[4];
#pragma unroll
        for (int i = 0; i < 4; ++i) { A4[i] = *(const LAS f32x4*)(wa + fr * 68 + 16 * fq + 4 * i); U4[i] = *(const LAS f32x4*)(wu + fr * 68 + 16 * fq + 4 * i); }
        asm volatile("s_waitcnt lgkmcnt(0)" ::: "memory");
        float hl[16], Pl[16]; float h = 0.f, P = 1.f;
        if (d == 0) {
#pragma unroll
            for (int s = 0; s < 16; ++s) { const float av = A4[s >> 2][s & 3], uv = U4[s >> 2][s & 3]; h = av * h + uv; P *= av; hl[s] = h; Pl[s] = P; }
        } else {
#pragma unroll
            for (int s = 15; s >= 0; --s) { const float av = A4[s >> 2][s & 3], uv = U4[s >> 2][s & 3]; h = av * h + uv; P *= av; hl[s] = h; Pl[s] = P; }
        }
        float Pk[4], Hk[4];
#pragma unroll
        for (int k = 0; k < 4; ++k) { Pk[k] = __shfl(P, k * 16 + fr); Hk[k] = __shfl(h, k * 16 + fr); }
        float c = (pass == 2) ? __shfl(cy, d * 16 + fr) : 0.f, cin = 0.f, Pt = 1.f;
#pragma unroll
        for (int kk = 0; kk < 4; ++kk) { const int k = d == 0 ? kk : 3 - kk; if (k == fq) cin = c; c = Pk[k] * c + Hk[k]; Pt *= Pk[k]; }
        if (pass == 1) { if (fq == 0) ((f32x2*)lsum)[(size_t)tile * 2048 + d * 1024 + chg] = (f32x2){Pt, c}; }
        else {
#pragma unroll
            for (int s = 0; s < 16; ++s) { const float hv = hl[s] + Pl[s] * cin; if (d == 0) y[s] = hv; else y[s] += hv; }
        }
    }
    if (pass == 2) {
#pragma unroll
        for (int s = 0; s < 16; ++s) yt[(16 * fq + s) * L_YT_STRIDE + ech] = y[s];
        __syncthreads();
        const int t = tid >> 3, c0 = (tid & 7) * 16;
        bf16_t* zr = F.Z() + (size_t)(lrow0 + t) * ZP + CRG + n * 128 + c0;
        const float gv[16] = {bf_lo(g0.x), bf_hi(g0.x), bf_lo(g0.y), bf_hi(g0.y), bf_lo(g0.z), bf_hi(g0.z), bf_lo(g0.w), bf_hi(g0.w), bf_lo(g1.x), bf_hi(g1.x), bf_lo(g1.y), bf_hi(g1.y), bf_lo(g1.z), bf_hi(g1.z), bf_lo(g1.w), bf_hi(g1.w)};
        float o[16];
#pragma unroll
        for (int i = 0; i < 4; ++i) { const f32x4 yv = *(const LAS f32x4*)(yt + t * L_YT_STRIDE + c0 + 4 * i); o[4 * i] = yv[0] * gv[4 * i]; o[4 * i + 1] = yv[1] * gv[4 * i + 1]; o[4 * i + 2] = yv[2] * gv[4 * i + 2]; o[4 * i + 3] = yv[3] * gv[4 * i + 3]; }
        u32x4 w0, w1; w0.x = cvt_pk_bf16(o[0], o[1]); w0.y = cvt_pk_bf16(o[2], o[3]); w0.z = cvt_pk_bf16(o[4], o[5]); w0.w = cvt_pk_bf16(o[6], o[7]);
        w1.x = cvt_pk_bf16(o[8], o[9]); w1.y = cvt_pk_bf16(o[10], o[11]); w1.z = cvt_pk_bf16(o[12], o[13]); w1.w = cvt_pk_bf16(o[14], o[15]);
        *(u32x4*)(zr + (CSC - CRG)) = w0; *(u32x4*)(zr + (CSC - CRG) + 8) = w1;
    }
}

__device__ __forceinline__ void lru_phase(CArgs a, const Frame& F, LAS unsigned char* lds, int pass) {
    const int tid = tid_opaque(F.wave_s), lane = tid & 63, wave = __builtin_amdgcn_readfirstlane(tid >> 6), fr = lane & 15;
    const int d = (lane >> 4) & 1; const bool cl = (pass == 2) && lane < 32;
    for (int w = bid_opaque(); w < 256; w += gridDim.x) {
        const int bl = w >> 6, n = (w >> 3) & 7, sg = w & 7;
        LruCtx C; lru_setup(a, F, n, C);
        { LAS float* cwl = (LAS float*)(lds + L_CW);
          for (int e = tid; e < 640; e += NTHREADS) cwl[e] = e < 512 ? a->in[15][(size_t)F.l * 4 * DM + (e >> 7) * DM + n * 128 + (e & 127)] : a->in[16][(size_t)F.l * DM + n * 128 + (e - 512)];
          __syncthreads(); }
        XRows xc, xn; lru_load_rows(F, bl * 64 + sg * 8, n, xc);
        const f32x2* sp = (const f32x2*)(F.ws + WS_LSUM) + (size_t)d * 1024 + n * 128 + wave * 16 + fr;
        const int cf = 256 + bl * 4, lf = bl * 64;
        float cb = 0.f;
        if (cl) {
#pragma unroll
            for (int q = 0; q < 4; ++q) { const f32x2 s = sp[(size_t)(d == 0 ? cf + q : cf + 3 - q) * 2048]; cb = s.x * cb + s.y; }
            const int cnt = d == 0 ? sg * 8 : 56 - sg * 8, start = d == 0 ? lf : lf + 63, step = d == 0 ? 1 : -1;
#pragma unroll 8
            for (int q = 0; q < cnt; ++q) { const f32x2 s = sp[(size_t)(start + q * step) * 2048]; cb = s.x * cb + s.y; }
        }
        float cys[8];
#pragma unroll
        for (int q = 0; q < 8; ++q) cys[q] = 0.f;
        if (cl) { f32x2 ss[8];
#pragma unroll
            for (int q = 0; q < 8; ++q) ss[q] = sp[(size_t)(lf + sg * 8 + q) * 2048];
            float c = cb;
#pragma unroll
            for (int q = 0; q < 8; ++q) { const int qq = d == 0 ? q : 7 - q; const f32x2 sv = d == 0 ? ss[q] : ss[7 - q];
                if (d == 0) { cys[q] = c; } else { cys[7 - q] = c; } c = sv.x * c + sv.y; (void)qq; } }
        for (int jj = 0; jj < 8; ++jj) {
            const int tl = sg * 8 + jj; float cy = cys[0];
#pragma unroll
            for (int q = 1; q < 8; ++q) cy = (jj == q) ? cys[q] : cy;
            const bool has_ctx = sg < 4 && (pass == 1 || F.l == 0);
            if (jj < 7) lru_load_rows(F, lf + tl + 1, n, xn); else if (has_ctx) lru_load_rows(F, cf + sg, n, xn);
            lru_item(a, F, lds, pass, lf + tl, n, C, cy, xc, jj & 1);
            xc = xn;
        }
        if (sg < 4 && (pass == 1 || F.l == 0)) {
            float cy = 0.f;
            if (cl) { if (d == 0) { for (int q = 0; q < sg; ++q) { const f32x2 s = sp[(size_t)(cf + q) * 2048]; cy = s.x * cy + s.y; } }
                      else { for (int q = 3; q > sg; --q) { const f32x2 s = sp[(size_t)(cf + q) * 2048]; cy = s.x * cy + s.y; } } }
            lru_item(a, F, lds, pass, cf + sg, n, C, cy, xc, 0);
        }
        __syncthreads();
    }
}

constexpr int SG_KC = 512, SG_PITCH = SG_KC * 2 + 16, SG_B_OFF = 64 * SG_PITCH;
__device__ __forceinline__ void sg_accum(LAS unsigned char* lds, const bf16_t* A, int lda, const bf16_t* Bt, int K, int tid, int wave, int lane, f32x4 (&acc)[2]) {
    const int fr = lane & 15, fq = lane >> 4, rt = wave & 3, ch = wave >> 2;
    u32x4 ra[8], rb[8];
#define SG_LOADS(k0_) do { _Pragma("unroll") for (int i_ = 0; i_ < 8; ++i_) { const int p_ = tid + 512 * i_, row_ = p_ >> 6, kc_ = (p_ & 63) * 8; \
        if ((k0_) + kc_ < K) { ra[i_] = *(const u32x4*)(A + (size_t)row_ * lda + (k0_) + kc_); rb[i_] = *(const u32x4*)(Bt + (size_t)row_ * K + (k0_) + kc_); } \
        else { ra[i_] = (u32x4){0u, 0u, 0u, 0u}; rb[i_] = (u32x4){0u, 0u, 0u, 0u}; } } } while (0)
    SG_LOADS(0);
    for (int k0 = 0; k0 < K; k0 += SG_KC) {
        __syncthreads();
#pragma unroll
        for (int i = 0; i < 8; ++i) { const int p = tid + 512 * i, row = p >> 6, kc = (p & 63) * 8;
            *(LAS u32x4*)(lds + row * SG_PITCH + kc * 2) = ra[i]; *(LAS u32x4*)(lds + SG_B_OFF + row * SG_PITCH + kc * 2) = rb[i]; }
        if (k0 + SG_KC < K) SG_LOADS(k0 + SG_KC);
        __syncthreads();
        const int nks = (K - k0) >= SG_KC ? 16 : (K - k0) / 32;
        const LAS unsigned char* ap = lds + (16 * rt + fr) * SG_PITCH + fq * 16;
        const LAS unsigned char* bp = lds + SG_B_OFF + (32 * ch + fr) * SG_PITCH + fq * 16;
#pragma unroll 4
        for (int ks = 0; ks < nks; ++ks) { const bf16x8 af = *(const LAS bf16x8*)(ap + ks * 64), b0 = *(const LAS bf16x8*)(bp + ks * 64), b1 = *(const LAS bf16x8*)(bp + 16 * SG_PITCH + ks * 64);
            acc[0] = __builtin_amdgcn_mfma_f32_16x16x32_bf16(af, b0, acc[0], 0, 0, 0); acc[1] = __builtin_amdgcn_mfma_f32_16x16x32_bf16(af, b1, acc[1], 0, 0, 0); }
    }
    __syncthreads();
#undef SG_LOADS
}
__device__ __forceinline__ void ctx_g2_block(const Frame& F, LAS unsigned char* lds, int id) {
    const int tid = tid_opaque(F.wave_s), lane = tid & 63, wave = __builtin_amdgcn_readfirstlane(tid >> 6), fr = lane & 15, fq = lane >> 4, rt = wave & 3, ch = wave >> 2;
    const int rb = id >> 4, cb = id & 15;
    bf16_t* zrow = F.Z() + (size_t)(CH_L + rb * 64) * ZP;
    f32x4 total[2] = {(f32x4){0.f, 0.f, 0.f, 0.f}, (f32x4){0.f, 0.f, 0.f, 0.f}};
#pragma unroll
    for (int seg = 0; seg < 3; ++seg) {
        f32x4 acc[2] = {(f32x4){0.f, 0.f, 0.f, 0.f}, (f32x4){0.f, 0.f, 0.f, 0.f}};
        const int colA = seg == 0 ? CSX : (seg == 1 ? CSB : CSC);
        bf16_t gq[2][4];
#pragma unroll
        for (int ct = 0; ct < 2; ++ct)
#pragma unroll
            for (int j = 0; j < 4; ++j) gq[ct][j] = zrow[(size_t)(16 * rt + 4 * fq + j) * ZP + CGT + seg * 1024 + cb * 64 + 32 * ch + 16 * ct + fr];
        sg_accum(lds, zrow + colA, ZP, F.W(seg == 0 ? W_AO : (seg == 1 ? W_SO : W_LO)) + (size_t)(cb * 64) * DM, DM, tid, wave, lane, acc);
#pragma unroll
        for (int ct = 0; ct < 2; ++ct)
#pragma unroll
            for (int j = 0; j < 4; ++j) total[ct][j] += bf1(gq[ct][j]) * acc[ct][j];
    }
#pragma unroll
    for (int ct = 0; ct < 2; ++ct)
#pragma unroll
        for (int j = 0; j < 4; ++j) zrow[(size_t)(16 * rt + 4 * fq + j) * ZP + CQ + cb * 64 + 32 * ch + 16 * ct + fr] = (bf16_t)(cvt_pk_bf16(total[ct][j], total[ct][j]) & 0xffffu);
}
__device__ __forceinline__ void ctx_res_block(const Frame& F, LAS unsigned char* lds, int id, int which) {
    const int tid = tid_opaque(F.wave_s), lane = tid & 63, wave = __builtin_amdgcn_readfirstlane(tid >> 6), fr = lane & 15, fq = lane >> 4, rt = wave & 3, ch = wave >> 2;
    const int rb = id >> 4, cb = id & 15;
    f32x4 acc[2] = {(f32x4){0.f, 0.f, 0.f, 0.f}, (f32x4){0.f, 0.f, 0.f, 0.f}};
    const size_t xrow0 = which == 0 ? (size_t)F.c * CH_C + rb * 64 : (size_t)rb * 64;
    const float* base = (which == 0 && F.l == 0) ? F.ctx : F.XC();
    const float* vec = F.MOD(8) + (which == 0 ? 2048 : 5120) + cb * 64 + 32 * ch + fr;
    float bq[2][4], gv[2];
#pragma unroll
    for (int ct = 0; ct < 2; ++ct) { gv[ct] = vec[16 * ct];
#pragma unroll
        for (int j = 0; j < 4; ++j) bq[ct][j] = base[(xrow0 + 16 * rt + 4 * fq + j) * DM + cb * 64 + 32 * ch + 16 * ct + fr]; }
    if (which == 0) sg_accum(lds, F.Z() + (size_t)(CH_L + rb * 64) * ZP + CQ, ZP, F.W(W_MO) + (size_t)(cb * 64) * DM, DM, tid, wave, lane, acc);
    else sg_accum(lds, F.Z() + (size_t)(LROWS + rb * 64) * FFW, FFW, F.W(W_F2) + (size_t)(cb * 64) * FFW, FFW, tid, wave, lane, acc);
#pragma unroll
    for (int ct = 0; ct < 2; ++ct)
#pragma unroll
        for (int j = 0; j < 4; ++j) F.XC()[(xrow0 + 16 * rt + 4 * fq + j) * DM + cb * 64 + 32 * ch + 16 * ct + fr] = bq[ct][j] + gv[ct] * acc[ct][j];
}

constexpr int N_PHASES = 30;
__device__ __forceinline__ void decode_phase(int ph, int& kind, int& l, int& c) {
    if (ph == 0) { kind = K_P0; l = 0; c = 0; return; }
    if (ph == N_PHASES - 1) { kind = K_FN; l = 1; c = 0; return; }
    const int q = ph - 1; l = q / 14; const int r = q % 14; c = 0;
    if (r == 0) { kind = K_N1; }
    else if (r <= 10) { c = (r - 1) / 5; const int s = (r - 1) % 5; kind = s == 0 ? K_G1 : s == 1 ? K_M1 : s == 2 ? K_A1 : s == 3 ? K_G2 : K_G3; }
    else { kind = r == 11 ? K_N2 : (r == 12 ? K_G4 : K_G5); }
}

__global__ void __launch_bounds__(NTHREADS, 2) mk_fwd(Args a_) {
    extern __shared__ __attribute__((aligned(16))) unsigned char lds_raw[];
    LAS unsigned char* lds = (LAS unsigned char*)lds_raw;
    cg::grid_group grid = cg::this_grid();
    const int ph_lo = a_.ph_lo, ph_hi = a_.ph_hi;
    const int wave_s = __builtin_amdgcn_readfirstlane(threadIdx.x >> 6);
    volatile LAS unsigned* MISC = (volatile LAS unsigned*)(lds + MISC_OFF);
    if (threadIdx.x < 4) MISC[threadIdx.x] = 0u;
    __syncthreads();
    (void)xcd_barrier_post((unsigned*)(a_.ws + WS_CTL), MISC);
    for (int ph = ph_lo; ph < ph_hi; ++ph) {
        CArgs a; { unsigned long long kp = (unsigned long long)__builtin_amdgcn_kernarg_segment_ptr(); asm volatile("" : "+s"(kp)); a = (CArgs)kp; }
        if (ph > ph_lo) {
            if (ph_hi < 0) grid.sync();
            else { XcdBarrier bar; bar.bar = (unsigned*)(a->ws + WS_CTL); bar.x = xb_xcc_id(); bar.st = (volatile LAS unsigned*)(lds + MISC_OFF); xcd_barrier(bar, tid_opaque(wave_s) == 0); } }
        Frame F;
        F.x = a->in[0]; F.cvec = a->in[1]; F.ctx = a->in[2]; F.cctx = a->in[3]; F.out = a->out; F.ws = a->ws;
        F.G = gridDim.x; { const int bx = bid_opaque(); F.vcu = (F.G % 8 == 0) ? (bx % 8) * (F.G / 8) + bx / 8 : bx; }
        int kind, l, c; decode_phase(ph, kind, l, c);
        F.kind = kind; F.l = l; F.c = c; F.wave_s = wave_s;
        if (kind == K_P0) { phase_p0(a, F, lds); }
        else if (kind == K_N1) { for (int rep = 0; rep < ((kind == REP_KIND) ? 2 : 1); ++rep) phase_norm(a, F, 0); }
        else if (kind == K_N2) { for (int rep = 0; rep < ((kind == REP_KIND) ? 2 : 1); ++rep) phase_norm(a, F, 1); }
        else if (kind == K_FN) { phase_final(a, F); }
        else if (kind == K_M1) {
            for (int rep = 0; rep < REP_LRU1; ++rep) lru_phase(a, F, lds, 1);
            phase_qknorm(a, F);
            phase_sconv(a, F);
        } else if (kind == K_A1) {
            for (int rep = 0; rep < REP_A1; ++rep) lru_phase(a, F, lds, 2);
            const int nlat = CHB * 8 * 16, ntot = nlat + ((l == 0) ? CHB * 8 : 0);
            for (int rep = 0; rep < REP_ATT; ++rep)
            for (int i = 0;; ++i) {
                int U;
                if (F.G == 256) { if (i < 2) U = (F.vcu >> 5) * 64 + i * 32 + (F.vcu & 31); else { const int v2 = F.vcu - 128; U = (i == 2 && v2 >= 0 && v2 < 32) ? nlat + v2 : ntot; } }
                else U = i * F.G + F.vcu;
                if (U >= ntot) break;
                if (U < nlat) {
                    const int bk = U >> 6, bl = bk >> 1, kvh = bk & 1, r = U & 63, h = kvh * 4 + (r >> 4), qb = r & 15;
                    bf16_t* q = F.Z() + (size_t)(bl * SEQ + qb * 256) * ZP + CQ + h * 128;
                    att::attn_dense_body(q, F.Kb() + (size_t)bl * KVLEN * 256 + kvh * 128, F.Vb() + (size_t)bl * KVLEN * 256 + kvh * 128, q + (CSX - CQ), KVLEN, (char*)lds_raw, F.wave_s);
                } else {
                    const int V = U - nlat, bl = V >> 3, h = V & 7, kvh = h >> 2;
                    bf16_t* q = F.Z() + (size_t)(CH_L + bl * CTXL) * ZP + CQ + h * 128;
                    att::attn_dense_body(q, F.Kb() + (size_t)bl * KVLEN * 256 + kvh * 128, F.Vb() + (size_t)bl * KVLEN * 256 + kvh * 128, q + (CSX - CQ), CTXL, (char*)lds_raw, F.wave_s);
                }
            }
        } else {
            GSched S; S.F = F; GEpi E; E.F = F;
            const int K = (kind == K_G5) ? FFW : DM;
            const int lda = (kind == K_G1 || kind == K_G4) ? DM : (kind == K_G5 ? FFW : ZP);
            for (int rep = 0; rep < ((kind == REP_KIND) ? 2 : 1); ++rep)
            pg8::gemm_phase<GEpi, GSched>(lds, K, lda, S, E);
            if (l == 0) {
                if (kind == K_G2) { for (int id = F.vcu; id < 256; id += F.G) ctx_g2_block(F, lds, id); }
                else if (kind == K_G3) { for (int id = F.vcu; id < 256; id += F.G) ctx_res_block(F, lds, id, 0); }
                else if (kind == K_G5) { for (int id = F.vcu; id < 512; id += F.G) ctx_res_block(F, lds, id, 1); }
            }
        }
    }
}

extern "C" void kernel_launch(void* const* d_in, const int* in_sizes, int n_in, void* d_out, int out_size, void* d_ws, size_t ws_size, hipStream_t stream) {
    static int grid = 0;
    if (grid == 0) {
        if (n_in != 27 || out_size != LROWS * DM || ws_size < WS_END) { fprintf(stderr, "kernel_launch: bad shapes n_in %d out %d ws %zu (need %zu)\n", n_in, out_size, ws_size, (size_t)WS_END); grid = -1; return; }
        int dev = 0, cus = 0, per_cu = 0;
        hipGetDevice(&dev); hipDeviceGetAttribute(&cus, hipDeviceAttributeMultiprocessorCount, dev);
        if (hipFuncSetAttribute((const void*)mk_fwd, hipFuncAttributeMaxDynamicSharedMemorySize, LDS_BYTES) != hipSuccess) { fprintf(stderr, "kernel_launch: hipFuncSetAttribute failed\n"); grid = -1; return; }
        if (hipOccupancyMaxActiveBlocksPerMultiprocessor(&per_cu, (const void*)mk_fwd, NTHREADS, LDS_BYTES) != hipSuccess || per_cu < 1) { fprintf(stderr, "kernel_launch: occupancy query failed (%d)\n", per_cu); per_cu = 1; }
        (void)hipGetLastError();
        grid = cus * per_cu;
        fprintf(stderr, "kernel_launch: grid %d (cus %d x %d)\n", grid, cus, per_cu);
    }
    if (grid < 0) return;
    if (hipMemsetAsync((char*)d_ws + WS_CTL, 0, CTL_BYTES, stream) != hipSuccess) { fprintf(stderr, "kernel_launch: memset failed\n"); return; }
    Args a{};
    for (int i = 0; i < 27; ++i) a.in[i] = (const float*)d_in[i];
    a.out = (float*)d_out; a.ws = (unsigned char*)d_ws;
#if MK_PER_PHASE
    for (int ph = 0; ph < N_PHASES; ++ph) {
        a.ph_lo = ph; a.ph_hi = ph + 1;
        void* args[] = {&a};
        hipError_t e = hipLaunchCooperativeKernel((const void*)mk_fwd, dim3(grid), dim3(NTHREADS), args, LDS_BYTES, stream);
        if (e != hipSuccess) { fprintf(stderr, "launch %d failed: %s\n", ph, hipGetErrorString(e)); break; }
    }
#else
    a.ph_lo = 0; a.ph_hi = N_PHASES;
    void* args[] = {&a};
    hipError_t e = hipLaunchCooperativeKernel((const void*)mk_fwd, dim3(grid), dim3(NTHREADS), args, LDS_BYTES, stream);
    if (e != hipSuccess) fprintf(stderr, "cooperative launch failed: %s (grid %d)\n", hipGetErrorString(e), grid);
#endif
}
```

```cpp
#include <hip/hip_runtime.h>
#include <hip/hip_bf16.h>
#include <hip/hip_cooperative_groups.h>
#include <cstdio>
#include <cstdint>
namespace cg = cooperative_groups;

#ifndef REP_KIND
#define REP_KIND -1
#endif
#ifndef REP_LRU1
#define REP_LRU1 1
#endif
#ifndef REP_A1
#define REP_A1 1
#endif
#ifndef REP_ATT
#define REP_ATT 1
#endif
#ifndef MK_PER_PHASE
#define MK_PER_PHASE 0
#endif

#define LAS __attribute__((address_space(3)))
typedef unsigned short bf16_t;
typedef short bf16x8 __attribute__((ext_vector_type(8)));
typedef short s16x4 __attribute__((ext_vector_type(4)));
typedef float f32x2 __attribute__((ext_vector_type(2)));
typedef float f32x4 __attribute__((ext_vector_type(4)));
typedef float f32x16 __attribute__((ext_vector_type(16)));
typedef unsigned u32x4 __attribute__((ext_vector_type(4)));
typedef unsigned u32x2 __attribute__((ext_vector_type(2)));

constexpr int DM = 1024, NBATCH = 8, SEQ = 4096, CTXL = 256, NIN = 9728, FFW = 2816;
constexpr int LROWS = NBATCH * SEQ, CROWS = NBATCH * CTXL, ROWS = LROWS + CROWS;
constexpr int CHB = 4, CH_L = CHB * SEQ, CH_C = CHB * CTXL, CH_ROWS = CH_L + CH_C;
constexpr int ZP = NIN;
constexpr int CQ = 0, CK = 1024, CV = 1280, CSB = 1536, CSC = 2560, CSX = 3584, CRX = 4608, CRG = 5632, CGT = 6656;
constexpr int KVLEN = CTXL + SEQ;
constexpr float EPS = 1e-6f;
constexpr int NTHREADS = 512, NWAVES = 8;
constexpr int MISC_OFF = 143360, LDS_BYTES = MISC_OFF + 1024;

constexpr size_t MiB = 1u << 20;
constexpr size_t WS_MOD = 0, WS_ROPE = 512 * 1024, WS_CTL = 768 * 1024, CTL_BYTES = 16384, WS_LSUM = 1 * MiB, WS_XC = 6 * MiB, WS_W = 14 * MiB;
constexpr size_t W_IN = 0, W_AO = 19 * MiB, W_SO = 21 * MiB, W_LO = 23 * MiB, W_MO = 25 * MiB, W_F1 = 27 * MiB, W_F2 = 38 * MiB, W_LRU = 43 * MiB + 512 * 1024;
constexpr size_t W_LAYER = 44 * MiB + 512 * 1024;
constexpr size_t WS_H = 103 * MiB, WS_K = 171 * MiB, WS_V = WS_K + (size_t)CHB * KVLEN * 256 * 2, WS_Z = 188 * MiB, WS_END = 511 * MiB;
static_assert(WS_W + 2 * W_LAYER <= WS_H, "weights");
static_assert(WS_H + (size_t)ROWS * DM * 2 <= WS_K, "H");
static_assert(WS_V + (size_t)CHB * KVLEN * 256 * 2 <= WS_Z, "KV");
static_assert(WS_Z + (size_t)CH_ROWS * ZP * 2 <= WS_END, "Z");
static_assert((size_t)ROWS * FFW * 2 <= (size_t)CH_ROWS * ZP * 2, "HID in Z");
static_assert(W_F2 + (size_t)DM * FFW * 2 <= W_LRU && W_IN + (size_t)NIN * DM * 2 <= W_AO && W_F1 + (size_t)2 * FFW * DM * 2 <= W_F2, "w map");

struct Args { const float* in[27]; float* out; unsigned char* ws; int ph_lo, ph_hi; };
typedef const __attribute__((address_space(4))) Args* CArgs;

__device__ __forceinline__ unsigned cvt_pk_bf16(float lo, float hi) { unsigned r; asm volatile("v_cvt_pk_bf16_f32 %0, %1, %2" : "=v"(r) : "v"(lo), "v"(hi)); return r; }
typedef __bf16 bf16x2_t __attribute__((ext_vector_type(2)));
__device__ __forceinline__ unsigned cvtpk_nv(float lo, float hi) { f32x2 v = {lo, hi}; bf16x2_t b = __builtin_convertvector(v, bf16x2_t); return __builtin_bit_cast(unsigned, b); }
__device__ __forceinline__ float bf_lo(unsigned u) { return __uint_as_float(u << 16); }
__device__ __forceinline__ float bf_hi(unsigned u) { return __uint_as_float(u & 0xffff0000u); }
__device__ __forceinline__ float bf1(bf16_t b) { return __uint_as_float((unsigned)b << 16); }
__device__ __forceinline__ int tid_opaque(int wave_s) { int t = wave_s * 64 + (int)__builtin_amdgcn_mbcnt_hi(~0u, __builtin_amdgcn_mbcnt_lo(~0u, 0u)); asm volatile("" : "+v"(t)); return t; }
__device__ __forceinline__ int bid_opaque() { int b = blockIdx.x; asm volatile("" : "+s"(b)); return b; }
__device__ __forceinline__ float wave_sum(float v) {
#pragma unroll
    for (int o = 1; o < 64; o <<= 1) v += __shfl_xor(v, o);
    return v;
}
__device__ __forceinline__ float fast_sigmoid(float y) { return __builtin_amdgcn_rcpf(1.0f + __builtin_amdgcn_exp2f(-1.4426950408889634f * y)); }
__device__ __forceinline__ float gelu_tanh(float x) { const float y = 1.5957691216057308f * (x + 0.044715f * x * x * x); return x * fast_sigmoid(y); }
__device__ __forceinline__ float silu_f(float x) { return x * fast_sigmoid(x); }

#define XB_TMO      128
#define XB_XCNT(j)  (256  + 64 * (j))
#define XB_XSUB(j)  (1280 + 64 * (j))
#define XB_XGEN(j)  (2304 + 64 * (j))
#define XB_TOP      3328
#define XB_TOPGEN   3392
#define XCD_BAR_WORDS 3456
#define XB_SPIN_CAP (1u << 18)

__device__ __forceinline__ unsigned xb_ld(unsigned* p)              { return __hip_atomic_load(p, __ATOMIC_RELAXED, __HIP_MEMORY_SCOPE_AGENT); }
__device__ __forceinline__ unsigned xb_add(unsigned* p, unsigned v) { return __hip_atomic_fetch_add(p, v, __ATOMIC_RELAXED, __HIP_MEMORY_SCOPE_AGENT); }
__device__ __forceinline__ unsigned xb_xcc_id() { return (unsigned)__builtin_amdgcn_s_getreg((3 << 11) | 20) & 0xFu; }
#define XB_SPIN(cond, bar) do { unsigned _sp = 0; while (cond) { __builtin_amdgcn_s_sleep(1); \
    if ((++_sp & 255u) == 0u) { if (xb_ld(&(bar)[XB_TMO])) break; if (_sp > XB_SPIN_CAP) { atomicAdd(&(bar)[XB_TMO], 1u); break; } } } } while (0)

struct XcdBarrier {
    unsigned* bar; unsigned x;
    volatile LAS unsigned* st;
};

__device__ __forceinline__ XcdBarrier xcd_barrier_post(unsigned* bar, volatile LAS unsigned* st) {
    XcdBarrier b; b.bar = bar; b.x = xb_xcc_id(); b.st = st;
    if (threadIdx.x == 0) (void)xb_add(&bar[XB_XCNT(b.x)], 1u);
    return b;
}
__device__ __forceinline__ void xcd_barrier_complete(unsigned* bar, unsigned x, unsigned& nloc, unsigned& nx) {
    const unsigned G = gridDim.x * gridDim.y * gridDim.z;
    unsigned sum, cnt, mine, sp = 0u;
    for (;;) {
        sum = 0u; cnt = 0u; mine = 0u;
#pragma unroll
        for (unsigned j = 0; j < 16; ++j) { const unsigned c = xb_ld(&bar[XB_XCNT(j)]); sum += c; cnt += (c > 0u) ? 1u : 0u; mine = (j == x) ? c : mine; }
        if (sum == G) break;
        __builtin_amdgcn_s_sleep(1);
        if ((++sp & 255u) == 0u) { if (xb_ld(&bar[XB_TMO])) break; if (sp > XB_SPIN_CAP) { atomicAdd(&bar[XB_TMO], 1u); break; } }
    }
    nloc = mine > 0u ? mine : 1u; nx = cnt > 0u ? cnt : 1u;
}

__device__ __forceinline__ void xcd_barrier(const XcdBarrier& b, const bool leader_thread) {
    asm volatile("s_waitcnt vmcnt(0)" ::: "memory");
    __syncthreads();
    if (leader_thread) {
        unsigned* bar = b.bar;
        __builtin_amdgcn_s_waitcnt(0);
        unsigned nloc = b.st[0], nx = b.st[1];
        if (nloc == 0u) { xcd_barrier_complete(bar, b.x, nloc, nx); b.st[0] = nloc; b.st[1] = nx; }
        const unsigned old = xb_add(&bar[XB_XSUB(b.x)], 1u);
        const unsigned gen = old / nloc;
        if (old + 1u == (gen + 1u) * nloc) {
            __builtin_amdgcn_fence(__ATOMIC_RELEASE, "agent");
            asm volatile("s_waitcnt vmcnt(0)" ::: "memory");
            const unsigned og = xb_add(&bar[XB_TOP], 1u);
            const unsigned tg = og / nx;
            if (og + 1u == (tg + 1u) * nx) xb_add(&bar[XB_TOPGEN], 1u);
            else XB_SPIN(xb_ld(&bar[XB_TOPGEN]) == tg, bar);
            __builtin_amdgcn_fence(__ATOMIC_ACQUIRE, "agent");
            xb_add(&bar[XB_XGEN(b.x)], 1u);
            asm volatile("s_waitcnt vmcnt(0)" ::: "memory");
        } else {
            XB_SPIN(xb_ld(&bar[XB_XGEN(b.x)]) == gen, bar);
            __builtin_amdgcn_fence(__ATOMIC_ACQUIRE, "agent");
            asm volatile("s_waitcnt vmcnt(0)" ::: "memory");
        }
    }
    __syncthreads();
}


namespace pg8 {
constexpr int BM = 256, BK = 64, HALF = 128, HTB = HALF * BK * 2, STAGE_BYTES = 8 * HTB;
__host__ __device__ __forceinline__ int lds_byte(int r, int c) { const int st = (r >> 4) * 2 + (c >> 5), rr = r & 15, cc = c & 31, ob = rr * 64 + cc * 2; return st * 1024 + (ob ^ (((ob >> 9) & 1) << 5)); }
__host__ __device__ __forceinline__ void stage_rc(int b, int& R, int& C) { const int st = b / 1024, sb = b % 1024, swz = sb ^ (((sb >> 9) & 1) << 5); R = (st >> 1) * 16 + swz / 64; C = (st & 1) * 32 + (swz % 64) / 2; }
__host__ __device__ __forceinline__ int perm32(int rho) { const int n = rho >> 4, i = rho & 15; return 8 * (i >> 2) + 4 * n + (i & 3); }

struct Unit { const char* A; const char* B; int pm, pn, seg; };

template <class Epi, class Sched>
__device__ __forceinline__ void gemm_phase(LAS unsigned char* lds, const int K, const int lda, const Sched& S, const Epi& E) {
    const int tid = tid_opaque(S.F.wave_s), wid = __builtin_amdgcn_readfirstlane(tid >> 6), lane = tid & 63, wr = wid >> 2, wc = wid & 3, fr = lane & 15, fq = lane >> 4;
    const int nt = K / BK;
    unsigned voffA[2], voffB[2];
#pragma unroll
    for (int i = 0; i < 2; ++i) { int R, C; stage_rc(tid * 16 + i * 8192, R, C); const int Rb = (R & ~31) + perm32(R & 31);
        voffA[i] = (unsigned)(R * lda + C) * 2u; voffB[i] = (unsigned)(Rb * K + C) * 2u; }
    const size_t kstep = (size_t)(BK * 2);
    const size_t hstepA = (size_t)HALF * lda * 2, hstepB = (size_t)HALF * K * 2;
    const unsigned ldsw = (unsigned)wid * 1024u;
    const int aoff = lds_byte(wr * 64 + fr, fq * 8), boff = lds_byte(wc * 32 + fr, fq * 8);
#define PG8_SA(b, h) (((b) * 2 + (h)) * HTB)
#define PG8_SB(b, h) ((4 + (b) * 2 + (h)) * HTB)
#define PG8_STAGE(bufoff, gbase, voff) do { _Pragma("unroll") for (int _i = 0; _i < 2; ++_i) \
        __builtin_amdgcn_global_load_lds((const unsigned*)((const char*)(gbase) + (voff)[_i]), (LAS unsigned*)(lds + (bufoff) + ldsw + _i * 8192), 16, 0, 0); } while (0)
#define PG8_LDA(dst, b, h) do { _Pragma("unroll") for (int m = 0; m < 4; ++m) _Pragma("unroll") for (int k = 0; k < 2; ++k) dst[m][k] = *(const LAS bf16x8*)(lds + PG8_SA(b, h) + aoff + m * 2048 + k * 1024); } while (0)
#define PG8_LDB(dst, b, h) do { _Pragma("unroll") for (int n = 0; n < 2; ++n) _Pragma("unroll") for (int k = 0; k < 2; ++k) dst[n][k] = *(const LAS bf16x8*)(lds + PG8_SB(b, h) + boff + n * 2048 + k * 1024); } while (0)
#define PG8_MMA(ai, bj, At, Bt) do { __builtin_amdgcn_s_setprio(1); _Pragma("unroll") for (int m = 0; m < 4; ++m) _Pragma("unroll") for (int n = 0; n < 2; ++n) _Pragma("unroll") for (int k = 0; k < 2; ++k) \
        acc[ai][bj][m][n] = __builtin_amdgcn_mfma_f32_16x16x32_bf16(Bt[n][k], At[m][k], acc[ai][bj][m][n], 0, 0, 0); __builtin_amdgcn_s_setprio(0); } while (0)
#define PG8_WAIT_V(n) asm volatile("s_waitcnt vmcnt(" #n ")" ::: "memory")
#define PG8_WAIT_L(n) asm volatile("s_waitcnt lgkmcnt(" #n ")" ::: "memory")
#define PG8_BAR __builtin_amdgcn_s_barrier()
#define PG8_SCHED __builtin_amdgcn_sched_barrier(0)
    Unit cur, nxt; int ui = 0;
    if (!S.next(0, cur)) return;
    f32x4 acc[2][2][4][2];
#pragma unroll
    for (int a = 0; a < 2; ++a)
#pragma unroll
        for (int b = 0; b < 2; ++b)
#pragma unroll
            for (int m = 0; m < 4; ++m)
#pragma unroll
                for (int n = 0; n < 2; ++n) acc[a][b][m][n] = (f32x4){0.f, 0.f, 0.f, 0.f};
    bf16x8 At[4][2], B0[2][2], B1[2][2];
    const char* cA = cur.A; const char* cB = cur.B;
    PG8_STAGE(PG8_SB(0, 0), cB, voffB); PG8_STAGE(PG8_SB(0, 1), cB + hstepB, voffB); PG8_STAGE(PG8_SA(0, 0), cA, voffA); PG8_STAGE(PG8_SA(0, 1), cA + hstepA, voffA);
    if (wr == 1) PG8_BAR;
    PG8_WAIT_V(2); PG8_BAR;
    PG8_STAGE(PG8_SB(1, 0), cB + kstep, voffB); PG8_STAGE(PG8_SA(1, 0), cA + kstep, voffA); PG8_STAGE(PG8_SB(1, 1), cB + hstepB + kstep, voffB);
    PG8_WAIT_V(6); PG8_BAR;
    for (;;) {
        const bool has_next = S.next(ui + 1, nxt);
        const char* nA = has_next ? nxt.A : cA; const char* nB = has_next ? nxt.B : cB;
        for (int t = 0; t < nt; t += 2) {
            const bool last = (t == nt - 2);
            const char* a1 = cA + (size_t)(t + 1) * kstep;
            const char* a2 = last ? nA : cA + (size_t)(t + 2) * kstep; const char* b2 = last ? nB : cB + (size_t)(t + 2) * kstep;
            const char* a3 = a2 + kstep; const char* b3 = b2 + kstep;
            PG8_LDB(B0, 0, 0); PG8_LDB(B1, 0, 1); PG8_SCHED; PG8_LDA(At, 0, 0); PG8_STAGE(PG8_SA(1, 1), a1 + hstepA, voffA);
            PG8_WAIT_V(8); PG8_WAIT_L(0); PG8_BAR; PG8_MMA(0, 0, At, B0); PG8_MMA(0, 1, At, B1); PG8_BAR; PG8_SCHED;
            PG8_LDA(At, 0, 1); PG8_STAGE(PG8_SB(0, 0), b2, voffB); PG8_STAGE(PG8_SB(0, 1), b2 + hstepB, voffB); PG8_STAGE(PG8_SA(0, 0), a2, voffA);
            PG8_WAIT_V(8); PG8_WAIT_L(0); PG8_BAR; PG8_MMA(1, 0, At, B0); PG8_MMA(1, 1, At, B1); PG8_BAR; PG8_SCHED;
            PG8_LDB(B0, 1, 0); PG8_LDB(B1, 1, 1); PG8_SCHED; PG8_LDA(At, 1, 0); PG8_STAGE(PG8_SA(0, 1), a2 + hstepA, voffA);
            PG8_WAIT_V(8); PG8_WAIT_L(0); PG8_BAR; PG8_MMA(0, 0, At, B0); PG8_MMA(0, 1, At, B1); PG8_BAR; PG8_SCHED;
            PG8_LDA(At, 1, 1); PG8_STAGE(PG8_SB(1, 0), b3, voffB); PG8_STAGE(PG8_SB(1, 1), b3 + hstepB, voffB); PG8_STAGE(PG8_SA(1, 0), a3, voffA);
            PG8_WAIT_V(8); PG8_WAIT_L(0); PG8_BAR; PG8_MMA(1, 0, At, B0); PG8_MMA(1, 1, At, B1); PG8_BAR; PG8_SCHED;
        }
        if (wr == 0) PG8_BAR;
        E(acc, cur, wr, wc, fr, fq);
        if (!has_next) break;
#pragma unroll
        for (int a = 0; a < 2; ++a)
#pragma unroll
            for (int b = 0; b < 2; ++b)
#pragma unroll
                for (int m = 0; m < 4; ++m)
#pragma unroll
                    for (int n = 0; n < 2; ++n) acc[a][b][m][n] = (f32x4){0.f, 0.f, 0.f, 0.f};
        cur = nxt; cA = nA; cB = nB; ++ui;
        if (wr == 1) PG8_BAR;
    }
    PG8_WAIT_V(0);
    PG8_BAR;
#undef PG8_SA
#undef PG8_SB
#undef PG8_STAGE
#undef PG8_LDA
#undef PG8_LDB
#undef PG8_MMA
#undef PG8_WAIT_V
#undef PG8_WAIT_L
#undef PG8_BAR
#undef PG8_SCHED
}
}

enum PhaseKind { K_P0 = 0, K_N1, K_G1, K_M1, K_A1, K_G2, K_G3, K_N2, K_G4, K_G5, K_FN };

struct Frame {
    const float* x; const float* cvec; const float* ctx; const float* cctx;
    float* out; unsigned char* ws;
    int vcu, G, l, c, kind, wave_s;
    __device__ __forceinline__ const bf16_t* W(size_t off) const { return (const bf16_t*)(ws + WS_W + (size_t)l * W_LAYER + off); }
    __device__ __forceinline__ bf16_t* Z() const { return (bf16_t*)(ws + WS_Z); }
    __device__ __forceinline__ bf16_t* H() const { return (bf16_t*)(ws + WS_H); }
    __device__ __forceinline__ bf16_t* Kb() const { return (bf16_t*)(ws + WS_K); }
    __device__ __forceinline__ bf16_t* Vb() const { return (bf16_t*)(ws + WS_V); }
    __device__ __forceinline__ float* XC() const { return (float*)(ws + WS_XC); }
    __device__ __forceinline__ const float* MOD(int b) const { return (const float*)(ws + WS_MOD) + (size_t)(l * 9 + b) * 6144; }
};

struct GSched {
    Frame F;
    __device__ __forceinline__ static void tile_map(int T, int nM, int nN, int& pm, int& pn) {
        const int nig = 8 * nN, gid = T / nig, fm = gid * 8, gsz = (nM - fm) < 8 ? (nM - fm) : 8, w = T % nig; pm = fm + w % gsz; pn = w / gsz;
    }
    __device__ __forceinline__ bool next(int i, pg8::Unit& u) const {
        const int kind = F.kind, l = F.l, c = F.c;
        if (kind == K_G1) {
            const int L = i * F.G + F.vcu, NL = 64 * 38, ncc = (l == 0) ? 38 : 6;
            if (L >= NL + 4 * ncc) return false;
            int lt, pn;
            if (L < NL) { tile_map(L, 64, 38, lt, pn); }
            else { const int q = L - NL; lt = 64 + (q & 3); const int ci = q >> 2; pn = (l == 0) ? ci : (ci < 2 ? 4 + ci : 16 + ci); }
            const size_t grow0 = lt < 64 ? (size_t)(64 * c + lt) * 256 : (size_t)LROWS + (size_t)(4 * c + lt - 64) * 256;
            u.A = (const char*)(F.H() + grow0 * DM); u.B = (const char*)(F.W(W_IN) + (size_t)pn * 256 * DM); u.pm = lt; u.pn = pn; u.seg = 0; return true;
        } else if (kind == K_G2) {
            const int T = (i / 3) * F.G + F.vcu, seg = i % 3, nM = 64;
            if (T >= nM * 4) return false;
            int lt, pn; tile_map(T, nM, 4, lt, pn);
            const int colA = seg == 0 ? CSX : (seg == 1 ? CSB : CSC);
            u.A = (const char*)(F.Z() + (size_t)lt * 256 * ZP + colA);
            u.B = (const char*)(F.W(seg == 0 ? W_AO : (seg == 1 ? W_SO : W_LO)) + (size_t)pn * 256 * DM); u.pm = lt; u.pn = pn; u.seg = seg; return true;
        } else if (kind == K_G3) {
            const int T = i * F.G + F.vcu, nM = 64;
            if (T >= nM * 4) return false;
            int lt, pn; tile_map(T, nM, 4, lt, pn);
            u.A = (const char*)(F.Z() + (size_t)lt * 256 * ZP + CQ); u.B = (const char*)(F.W(W_MO) + (size_t)pn * 256 * DM); u.pm = lt; u.pn = pn; u.seg = 0; return true;
        } else if (kind == K_G4) {
            const int T = i * F.G + F.vcu, nM = (l == 0) ? 136 : 128;
            if (T >= nM * 22) return false;
            int pm, pn; tile_map(T, nM, 22, pm, pn);
            u.A = (const char*)(F.H() + (size_t)pm * 256 * DM); u.B = (const char*)(F.W(W_F1) + (size_t)pn * 256 * DM); u.pm = pm; u.pn = pn; u.seg = 0; return true;
        } else {
            const int T = i * F.G + F.vcu, nM = 128;
            if (T >= nM * 4) return false;
            int pm, pn; tile_map(T, nM, 4, pm, pn);
            u.A = (const char*)(F.Z() + (size_t)pm * 256 * FFW); u.B = (const char*)(F.W(W_F2) + (size_t)pn * 256 * FFW); u.pm = pm; u.pn = pn; u.seg = 0; return true;
        }
    }
};

#ifndef EPI_MASK
#define EPI_MASK 30
#endif
#define EPI_EN(k) ((EPI_MASK >> (k)) & 1)
struct GEpi {
    Frame F;
    __device__ __forceinline__ void operator()(const f32x4 (&acc)[2][2][4][2], const pg8::Unit& u, int wr, int wc, int fr, int fq) const {
        const int kind = F.kind, l = F.l, c = F.c;
        asm volatile("" : "+v"(fr), "+v"(fq));
        const int row0 = wr * 64 + fr, col0 = wc * 32 + 8 * fq;
        if (EPI_EN(1) && kind == K_G1) {
            const int lt = u.pm, pn = u.pn;
            bf16_t* dst; int ldo;
            if (pn == 4 || pn == 5) { const int kvrow0 = lt < 64 ? (lt >> 4) * KVLEN + CTXL + (lt & 15) * 256 : (lt - 64) * KVLEN; dst = (pn == 4 ? F.Kb() : F.Vb()) + (size_t)kvrow0 * 256; ldo = 256; }
            else { dst = F.Z() + (size_t)lt * 256 * ZP + pn * 256; ldo = ZP; }
            const int act = pn >= 26 ? 2 : (pn >= 22 ? 1 : 0);
#pragma unroll
            for (int ai = 0; ai < 2; ++ai)
#pragma unroll
                for (int m = 0; m < 4; ++m) { bf16_t* rowp = dst + (size_t)(row0 + ai * 128 + m * 16) * ldo + col0;
#pragma unroll
                    for (int bj = 0; bj < 2; ++bj) { f32x4 v0 = acc[ai][bj][m][0], v1 = acc[ai][bj][m][1];
                        if (act == 1) { _Pragma("unroll") for (int e = 0; e < 4; ++e) { v0[e] = gelu_tanh(v0[e]); v1[e] = gelu_tanh(v1[e]); } }
                        else if (act == 2) { _Pragma("unroll") for (int e = 0; e < 4; ++e) { v0[e] = fast_sigmoid(v0[e]); v1[e] = fast_sigmoid(v1[e]); } }
                        u32x4 w; w.x = cvt_pk_bf16(v0[0], v0[1]); w.y = cvt_pk_bf16(v0[2], v0[3]); w.z = cvt_pk_bf16(v1[0], v1[1]); w.w = cvt_pk_bf16(v1[2], v1[3]);
                        *(u32x4*)(rowp + bj * 128) = w; } }
        } else if (EPI_EN(2) && kind == K_G2) {
            const int lt = u.pm, pn = u.pn, seg = u.seg;
            const bf16_t* gate = F.Z() + (size_t)lt * 256 * ZP + CGT + seg * 1024 + pn * 256;
            bf16_t* mg = F.Z() + (size_t)lt * 256 * ZP + CQ + pn * 256;
#pragma unroll
            for (int ai = 0; ai < 2; ++ai) {
                u32x4 gq[4][2], pq[4][2];
#pragma unroll
                for (int m = 0; m < 4; ++m)
#pragma unroll
                    for (int bj = 0; bj < 2; ++bj) { const size_t off = (size_t)(row0 + ai * 128 + m * 16) * ZP + col0 + bj * 128;
                        gq[m][bj] = *(const u32x4*)(gate + off); if (seg > 0) pq[m][bj] = *(const u32x4*)(mg + off); }
#pragma unroll
                for (int m = 0; m < 4; ++m)
#pragma unroll
                    for (int bj = 0; bj < 2; ++bj) { const size_t off = (size_t)(row0 + ai * 128 + m * 16) * ZP + col0 + bj * 128;
                        const u32x4 g = gq[m][bj]; const f32x4 a0 = acc[ai][bj][m][0], a1 = acc[ai][bj][m][1];
                        float v[8] = {a0[0] * bf_lo(g.x), a0[1] * bf_hi(g.x), a0[2] * bf_lo(g.y), a0[3] * bf_hi(g.y), a1[0] * bf_lo(g.z), a1[1] * bf_hi(g.z), a1[2] * bf_lo(g.w), a1[3] * bf_hi(g.w)};
                        if (seg > 0) { const u32x4 p = pq[m][bj];
                            v[0] += bf_lo(p.x); v[1] += bf_hi(p.x); v[2] += bf_lo(p.y); v[3] += bf_hi(p.y); v[4] += bf_lo(p.z); v[5] += bf_hi(p.z); v[6] += bf_lo(p.w); v[7] += bf_hi(p.w); }
                        u32x4 w; w.x = cvt_pk_bf16(v[0], v[1]); w.y = cvt_pk_bf16(v[2], v[3]); w.z = cvt_pk_bf16(v[4], v[5]); w.w = cvt_pk_bf16(v[6], v[7]);
                        *(u32x4*)(mg + off) = w; }
                asm volatile("" ::: "memory");
            }
        } else if (EPI_EN(3) && (kind == K_G3 || kind == K_G5)) {
            const int pn = u.pn; const bool g3 = (kind == K_G3);
            bool lat; size_t r0; int b;
            if (g3) { const int lt = u.pm; lat = lt < 64; r0 = lat ? (size_t)(64 * c + lt) * 256 : (size_t)(4 * c + lt - 64) * 256; b = lat ? 4 * c + (lt >> 4) : 8; }
            else { const int pm = u.pm; lat = pm < 128; r0 = lat ? (size_t)pm * 256 : (size_t)(pm - 128) * 256; b = lat ? (pm >> 4) : 8; }
            const float* base = lat ? ((g3 && l == 0) ? F.x : F.out) : ((g3 && l == 0) ? F.ctx : F.XC());
            float* fout = lat ? F.out : F.XC();
            base += r0 * DM + pn * 256; fout += r0 * DM + pn * 256;
            const float* vec = F.MOD(b) + (g3 ? 2048 : 5120) + pn * 256 + col0;
            f32x4 vv[2][2];
#pragma unroll
            for (int bj = 0; bj < 2; ++bj) { vv[bj][0] = *(const f32x4*)(vec + bj * 128); vv[bj][1] = *(const f32x4*)(vec + bj * 128 + 4); }
#pragma unroll
            for (int ai = 0; ai < 2; ++ai) {
                f32x4 bq0[4][2], bq1[4][2];
#pragma unroll
                for (int m = 0; m < 4; ++m)
#pragma unroll
                    for (int bj = 0; bj < 2; ++bj) { const size_t off = (size_t)(row0 + ai * 128 + m * 16) * DM + col0 + bj * 128;
                        bq0[m][bj] = *(const f32x4*)(base + off); bq1[m][bj] = *(const f32x4*)(base + off + 4); }
#pragma unroll
                for (int m = 0; m < 4; ++m)
#pragma unroll
                    for (int bj = 0; bj < 2; ++bj) { const size_t off = (size_t)(row0 + ai * 128 + m * 16) * DM + col0 + bj * 128;
                        *(f32x4*)(fout + off) = bq0[m][bj] + vv[bj][0] * acc[ai][bj][m][0]; *(f32x4*)(fout + off + 4) = bq1[m][bj] + vv[bj][1] * acc[ai][bj][m][1]; }
                asm volatile("" ::: "memory");
            }
        } else if (EPI_EN(4)) {
            bf16_t* dst = F.Z() + (size_t)u.pm * 256 * FFW + u.pn * 128;
#pragma unroll
            for (int ai = 0; ai < 2; ++ai)
#pragma unroll
                for (int m = 0; m < 4; ++m) { bf16_t* rowp = dst + (size_t)(row0 + ai * 128 + m * 16) * FFW + col0;
                    const f32x4 g0 = acc[ai][0][m][0], g1 = acc[ai][0][m][1], u0 = acc[ai][1][m][0], u1 = acc[ai][1][m][1];
                    u32x4 w; w.x = cvt_pk_bf16(silu_f(g0[0]) * u0[0], silu_f(g0[1]) * u0[1]); w.y = cvt_pk_bf16(silu_f(g0[2]) * u0[2], silu_f(g0[3]) * u0[3]);
                    w.z = cvt_pk_bf16(silu_f(g1[0]) * u1[0], silu_f(g1[1]) * u1[1]); w.w = cvt_pk_bf16(silu_f(g1[2]) * u1[2], silu_f(g1[3]) * u1[3]);
                    *(u32x4*)rowp = w; }
        }
    }
};

namespace att {
constexpr int D = 128, NW = 8, QBLK = 32, KVBLK = 64;
constexpr float SCALE = 0.088388347648318440f;
constexpr float THR = 8.f;
constexpr int LDQ = ZP, LDK = 256, LDO = ZP;
constexpr size_t SHM_V = KVBLK * D * 2, SHM_K = KVBLK * D * 2, SHM_ATTN = 2 * SHM_V + 2 * SHM_K + NW * 64 * 4;
constexpr int OST_OFF = (int)SHM_ATTN;
static_assert(SHM_ATTN + NW * 32 * 272 <= MISC_OFF, "attention lds");
#define KSWZ(row, colB) ((row) * 256 + ((colB) ^ (((row) & 7) << 4)))
#define SBAR() __builtin_amdgcn_sched_barrier(0)
__device__ __forceinline__ int crow(int r, int hi) { return (r & 3) + 8 * (r >> 2) + 4 * hi; }
__device__ __forceinline__ void partialSM(f32x16& p0, f32x16& p1, float& m_reg, float& mn, float& alpha) {
  constexpr float C = SCALE * 1.4426950408889634f;
  float pmax = p0[0]; for (int r = 1; r < 16; ++r) pmax = fmaxf(pmax, p0[r]); for (int r = 0; r < 16; ++r) pmax = fmaxf(pmax, p1[r]);
  { auto rr = __builtin_amdgcn_permlane32_swap(__float_as_uint(pmax), __float_as_uint(pmax), false, false);
    pmax = fmaxf(__uint_as_float(rr[0]), __uint_as_float(rr[1])); }
  if (__builtin_expect(__all(pmax - m_reg <= THR / SCALE), 1)) { mn = m_reg; alpha = 1.f; }
  else { mn = fmaxf(m_reg, pmax); alpha = __builtin_amdgcn_exp2f((m_reg - mn) * C); m_reg = mn; }
  float mnC = -mn * C;
  for (int r = 0; r < 16; ++r) p0[r] = fmaf(p0[r], C, mnC); for (int r = 0; r < 16; ++r) p1[r] = fmaf(p1[r], C, mnC);
  for (int r = 0; r < 16; ++r) p0[r] = __builtin_amdgcn_exp2f(p0[r]);
}
__device__ __forceinline__ void finishSM(f32x16& p0, f32x16& p1, float alpha, float& l_reg, bf16x8& pa0, bf16x8& pa1, bf16x8& pa2, bf16x8& pa3) {
  for (int r = 0; r < 16; ++r) p1[r] = __builtin_amdgcn_exp2f(p1[r]);
  float ps = 0; for (int r = 0; r < 16; ++r) ps += p0[r]; for (int r = 0; r < 16; ++r) ps += p1[r];
  { auto rr = __builtin_amdgcn_permlane32_swap(__float_as_uint(ps), __float_as_uint(ps), false, false);
    ps = __uint_as_float(rr[0]) + __uint_as_float(rr[1]); }
  l_reg = l_reg * alpha + ps;
#define PK4(P, BASE, OUT) do { unsigned a0 = cvt_pk_bf16(P[BASE + 0], P[BASE + 1]), a1 = cvt_pk_bf16(P[BASE + 2], P[BASE + 3]);   \
    unsigned b0 = cvt_pk_bf16(P[BASE + 4], P[BASE + 5]), b1 = cvt_pk_bf16(P[BASE + 6], P[BASE + 7]);                              \
    auto r0 = __builtin_amdgcn_permlane32_swap(a0, b0, false, false); auto r1 = __builtin_amdgcn_permlane32_swap(a1, b1, false, false); \
    u32x4 w = {r0[0], r1[0], r0[1], r1[1]}; OUT = *reinterpret_cast<bf16x8*>(&w); } while (0)
  PK4(p0, 0, pa0); PK4(p0, 8, pa1); PK4(p1, 0, pa2); PK4(p1, 8, pa3);
#undef PK4
}
__device__ __forceinline__ void qkt(f32x16& p0, f32x16& p1, const bf16_t* Ks, const bf16x8* qr, int r32, int hi) {
  p0 = f32x16{}; p1 = f32x16{};
#pragma unroll
  for (int d0 = 0; d0 < 8; ++d0) { int cb = (d0 * 16 + hi * 8) * 2;
    bf16x8 b0 = *reinterpret_cast<const bf16x8*>((const char*)Ks + KSWZ(r32, cb));
    bf16x8 b1 = *reinterpret_cast<const bf16x8*>((const char*)Ks + KSWZ(32 + r32, cb));
    p0 = __builtin_amdgcn_mfma_f32_32x32x16_bf16(b0, qr[d0], p0, 0, 0, 0);
    p1 = __builtin_amdgcn_mfma_f32_32x32x16_bf16(b1, qr[d0], p1, 0, 0, 0); }
}
__device__ __forceinline__ int v_st(int k, int c) { const int kk = (k & ~0xC) | ((k & 4) << 1) | ((k & 8) >> 1); return ((kk >> 3) * 4 + (c >> 5)) * 512 + ((kk & 7) * 32 + (c & 31)) * 2; }
__device__ __forceinline__ int v_rd_base(int lane) { return ((lane & 3) << 3) | (((lane >> 2) & 3) << 6) | (((lane >> 4) & 1) << 5) | (((lane >> 5) & 1) << 8); }
constexpr int v_rd_off(int d0, int ks, int half) { return d0 * 512 + ks * 4096 + half * 2048; }
template <int OFF> __device__ __forceinline__ s16x4 tr_read(int vb) {
  s16x4 r; asm volatile("ds_read_b64_tr_b16 %0, %1 offset:%2" : "=&v"(r) : "v"(vb), "i"(OFF) : "memory"); return r;
}
template <int D0> __device__ __forceinline__ void pv_one(f32x16& od, int vb, bf16x8 pa0, bf16x8 pa1, bf16x8 pa2, bf16x8 pa3) {
  const s16x4 l0 = tr_read<v_rd_off(D0, 0, 0)>(vb), h0 = tr_read<v_rd_off(D0, 0, 1)>(vb), l1 = tr_read<v_rd_off(D0, 1, 0)>(vb), h1 = tr_read<v_rd_off(D0, 1, 1)>(vb);
  const s16x4 l2 = tr_read<v_rd_off(D0, 2, 0)>(vb), h2 = tr_read<v_rd_off(D0, 2, 1)>(vb), l3 = tr_read<v_rd_off(D0, 3, 0)>(vb), h3 = tr_read<v_rd_off(D0, 3, 1)>(vb);
  asm volatile("s_waitcnt lgkmcnt(0)" ::: "memory"); SBAR();
#define PK(L, H) (bf16x8){L[0], L[1], L[2], L[3], H[0], H[1], H[2], H[3]}
  od = __builtin_amdgcn_mfma_f32_32x32x16_bf16(pa0, PK(l0, h0), od, 0, 0, 0);
  od = __builtin_amdgcn_mfma_f32_32x32x16_bf16(pa1, PK(l1, h1), od, 0, 0, 0);
  od = __builtin_amdgcn_mfma_f32_32x32x16_bf16(pa2, PK(l2, h2), od, 0, 0, 0);
  od = __builtin_amdgcn_mfma_f32_32x32x16_bf16(pa3, PK(l3, h3), od, 0, 0, 0);
#undef PK
}
__device__ __forceinline__ void pv_d0(f32x16* o, int vb, bf16x8 pa0, bf16x8 pa1, bf16x8 pa2, bf16x8 pa3) {
  pv_one<0>(o[0], vb, pa0, pa1, pa2, pa3); pv_one<1>(o[1], vb, pa0, pa1, pa2, pa3); pv_one<2>(o[2], vb, pa0, pa1, pa2, pa3); pv_one<3>(o[3], vb, pa0, pa1, pa2, pa3);
}
__device__ __forceinline__ void attn_dense_body(const bf16_t* Qb, const bf16_t* __restrict__ Kh, const bf16_t* __restrict__ Vh, bf16_t* Ob, int seq, char* lds, int wave_s) {
  const int tid = tid_opaque(wave_s), wid = __builtin_amdgcn_readfirstlane(tid >> 6), lane = tid & 63, r32 = lane & 31, hi = lane >> 5;
  bf16_t* V_lds = (bf16_t*)lds; bf16_t* K_lds = (bf16_t*)(lds + 2 * SHM_V);
  float* ws = (float*)(lds + 2 * SHM_V + 2 * SHM_K) + wid * 64; float* li_l = ws; float* al_l = ws + 32;
  float m_reg = -1e30f, l_reg = 0; f32x16 o[4] = {}; bf16x8 qr[8];
  const bf16_t* Qw = Qb + (long)(wid * QBLK + r32) * LDQ + hi * 8;
#pragma unroll
  for (int d0 = 0; d0 < 8; ++d0) qr[d0] = *reinterpret_cast<const bf16x8*>(Qw + d0 * 16);
  const int sr = tid >> 4, sc = (tid & 15) * 8, vst0 = v_st(sr, sc), vst1 = v_st(32 + sr, sc);
  const int vb0 = (int)(uintptr_t)V_lds + v_rd_base(lane);
  struct { bf16x8 vs0, vs1, ks0, ks1; } sr_[2];
#define SLOAD(i, k0) do { sr_[i].vs0 = *reinterpret_cast<const bf16x8*>(&Vh[(long)((k0) + sr) * LDK + sc]); sr_[i].vs1 = *reinterpret_cast<const bf16x8*>(&Vh[(long)((k0) + 32 + sr) * LDK + sc]); \
    sr_[i].ks0 = *reinterpret_cast<const bf16x8*>(&Kh[(long)((k0) + sr) * LDK + sc]); sr_[i].ks1 = *reinterpret_cast<const bf16x8*>(&Kh[(long)((k0) + 32 + sr) * LDK + sc]); } while (0)
#define SWRITE(b, i) do { *(bf16x8*)((char*)V_lds + (b) * SHM_V + vst0) = sr_[i].vs0;          \
    *(bf16x8*)((char*)V_lds + (b) * SHM_V + vst1) = sr_[i].vs1; int kc = sc * 2;               \
    *(bf16x8*)((char*)K_lds + (b) * SHM_K + KSWZ(sr, kc)) = sr_[i].ks0;                       \
    *(bf16x8*)((char*)K_lds + (b) * SHM_K + KSWZ(32 + sr, kc)) = sr_[i].ks1; } while (0)
#define SWAIT() asm volatile("s_waitcnt vmcnt(4)" ::: "memory")
#define RESC(a) do { if (__any((a) < 1.f)) { if (hi == 0) al_l[r32] = (a); asm volatile("s_waitcnt lgkmcnt(0)" ::: "memory"); \
    for (int d = 0; d < 4; ++d) for (int r = 0; r < 16; ++r) o[d][r] *= al_l[crow(r, hi)]; } } while (0)
  f32x16 pA0, pA1, pB0, pB1; float mnA, mnB, alA, alB; bf16x8 pa0, pa1, pa2, pa3; const int NT = seq / KVBLK;
  constexpr int SE = 0, SO = 1;
  SLOAD(SE, 0); asm volatile("s_waitcnt vmcnt(0)" ::: "memory"); SWRITE(0, SE); __syncthreads();
  qkt(pA0, pA1, K_lds, qr, r32, hi); partialSM(pA0, pA1, m_reg, mnA, alA);
  SLOAD(SO, KVBLK); if (2 < NT) SLOAD(SE, 2 * KVBLK);
  SWAIT(); SWRITE(1, SO); __syncthreads();
  for (int j = 1; j + 1 < NT; j += 2) {
    SBAR(); qkt(pB0, pB1, (bf16_t*)((char*)K_lds + SHM_K), qr, r32, hi);
    finishSM(pA0, pA1, alA, l_reg, pa0, pa1, pa2, pa3); SBAR();
    SLOAD(SO, (j + 2) * KVBLK); SBAR();
    pv_d0(o, vb0, pa0, pa1, pa2, pa3); partialSM(pB0, pB1, m_reg, mnB, alB);
    __syncthreads(); SWAIT(); SWRITE(0, SE);
    RESC(alB); __syncthreads();
    SBAR(); qkt(pA0, pA1, K_lds, qr, r32, hi);
    finishSM(pB0, pB1, alB, l_reg, pa0, pa1, pa2, pa3); SBAR();
    if (j + 3 < NT) SLOAD(SE, (j + 3) * KVBLK); SBAR();
    pv_d0(o, vb0 + (int)SHM_V, pa0, pa1, pa2, pa3); partialSM(pA0, pA1, m_reg, mnA, alA);
    __syncthreads(); SWAIT(); SWRITE(1, SO);
    RESC(alA); __syncthreads();
  }
  SBAR(); qkt(pB0, pB1, (bf16_t*)((char*)K_lds + SHM_K), qr, r32, hi);
  finishSM(pA0, pA1, alA, l_reg, pa0, pa1, pa2, pa3); SBAR();
  pv_d0(o, vb0, pa0, pa1, pa2, pa3); partialSM(pB0, pB1, m_reg, mnB, alB);
  __syncthreads(); RESC(alB);
  finishSM(pB0, pB1, alB, l_reg, pa0, pa1, pa2, pa3); SBAR();
  pv_d0(o, vb0 + (int)SHM_V, pa0, pa1, pa2, pa3);
  if (hi == 0) li_l[r32] = l_reg; asm volatile("s_waitcnt lgkmcnt(0)" ::: "memory");
  float rli[16];
#pragma unroll
  for (int r = 0; r < 16; ++r) rli[r] = __builtin_amdgcn_rcpf(li_l[crow(r, hi)]);
  bf16_t* Ow = Ob + (long)(wid * QBLK) * LDO;
  {
    bf16_t* stg = (bf16_t*)(lds + OST_OFF) + wid * (32 * 136);
#pragma unroll
    for (int r = 0; r < 16; ++r) { const int orow = crow(r, hi);
#pragma unroll
      for (int d0 = 0; d0 < 4; ++d0) { const float v = o[d0][r] * rli[r]; stg[orow * 136 + d0 * 32 + r32] = (bf16_t)(cvtpk_nv(v, v) & 0xffffu); } }
    asm volatile("s_waitcnt lgkmcnt(0)" ::: "memory");
#pragma unroll
    for (int i = 0; i < 8; ++i) { const int row = i * 4 + (lane >> 4), chn = lane & 15; const u32x4 v = *(const u32x4*)(stg + row * 136 + chn * 8); *(u32x4*)(Ow + (long)row * LDO + chn * 8) = v; }
  }
  __syncthreads();
#undef SLOAD
#undef SWRITE
#undef SWAIT
#undef RESC
}
#undef KSWZ
#undef SBAR
}

__device__ __forceinline__ void p0_transpose_item(const float* W, int K, int N, bf16_t* WT, int mode, LAS float* scr, int item, int lane) {
    const int nblk = N / 32, kb = item / nblk, nb = item % nblk, k0 = 64 * kb, n0 = 32 * nb;
#pragma unroll 8
    for (int i = 0; i < 32; ++i) { const int kk = 2 * i + (lane >> 5); scr[kk * 33 + (lane & 31)] = W[(size_t)(k0 + kk) * N + n0 + (lane & 31)]; }
    asm volatile("s_waitcnt lgkmcnt(0)" ::: "memory");
    int r0 = n0;
    if (mode == 1) r0 = n0 < FFW ? 256 * (n0 / 128) + (n0 % 128) : 256 * ((n0 - FFW) / 128) + 128 + ((n0 - FFW) % 128);
    const int c = lane & 7;
#pragma unroll
    for (int j = 0; j < 4; ++j) { const int n = (lane >> 3) + 8 * j; const LAS float* s = scr + (8 * c) * 33 + n;
        u32x4 o; o.x = cvt_pk_bf16(s[0 * 33], s[1 * 33]); o.y = cvt_pk_bf16(s[2 * 33], s[3 * 33]); o.z = cvt_pk_bf16(s[4 * 33], s[5 * 33]); o.w = cvt_pk_bf16(s[6 * 33], s[7 * 33]);
        *(u32x4*)(WT + (size_t)(r0 + n) * K + k0 + 8 * c) = o; }
    asm volatile("s_waitcnt lgkmcnt(0)" ::: "memory");
}

__device__ __forceinline__ void phase_p0(CArgs a, const Frame& F, LAS unsigned char* lds) {
    const int tid = tid_opaque(F.wave_s), lane = tid & 63, wave = __builtin_amdgcn_readfirstlane(tid >> 6);
    for (int it = bid_opaque(); it < 96; it += gridDim.x) {
        const int l = it / 48, cg0 = (it % 48) * 128;
        LAS float* sv = (LAS float*)lds;
        LAS float* red = (LAS float*)(lds + 9 * 1024 * 4);
        for (int e = tid; e < 9 * 1024; e += NTHREADS) { const int b = e >> 10, k = e & 1023; const float v = b < 8 ? a->in[1][b * 1024 + k] : a->in[3][k]; sv[e] = v * fast_sigmoid(v); }
        __syncthreads();
        const int kq = tid >> 7, col = tid & 127;
        float accv[9];
#pragma unroll
        for (int b = 0; b < 9; ++b) accv[b] = 0.f;
        const float* wp = a->in[4] + ((size_t)l * 1024 + kq * 256) * 6144 + cg0 + col;
#pragma unroll 4
        for (int k = 0; k < 256; ++k) { const float w = wp[(size_t)k * 6144];
#pragma unroll
            for (int b = 0; b < 9; ++b) accv[b] += sv[b * 1024 + kq * 256 + k] * w; }
#pragma unroll
        for (int b = 0; b < 9; ++b) red[(kq * 9 + b) * 128 + col] = accv[b];
        __syncthreads();
        if (tid < 128) {
#pragma unroll
            for (int b = 0; b < 9; ++b) { const float s = red[(0 * 9 + b) * 128 + tid] + red[(1 * 9 + b) * 128 + tid] + red[(2 * 9 + b) * 128 + tid] + red[(3 * 9 + b) * 128 + tid];
                ((float*)(a->ws + WS_MOD))[(size_t)(l * 9 + b) * 6144 + cg0 + tid] = s + a->in[5][l * 6144 + cg0 + tid]; }
        }
        __syncthreads();
    }
    if (bid_opaque() == gridDim.x - 1) {
        for (int e = tid; e < 2048; e += NTHREADS) { const int pos = e >> 5, f = e & 31; const float inv = __builtin_amdgcn_exp2f(-(float)f * (13.287712379549449f / 32.0f)); const float rev = (float)pos * inv * 0.15915494309189535f;
            const float fr_ = rev - floorf(rev);
            ((f32x2*)(a->ws + WS_ROPE))[e] = (f32x2){__builtin_amdgcn_cosf(fr_), __builtin_amdgcn_sinf(fr_)}; }
    }
    LAS float* scr = (LAS float*)(lds + 57344 + wave * 8704);
    const int gw = bid_opaque() * NWAVES + wave, NGW = gridDim.x * NWAVES;
    constexpr int I_IN = 16 * 304, I_SQ = 16 * 32, I_F1 = 16 * 176, I_F2 = 44 * 32, I_LRU = 256, I_LAYER = I_IN + 4 * I_SQ + I_F1 + I_F2 + I_LRU;
    for (int it = gw; it < 2 * I_LAYER; it += NGW) {
        const int l = it / I_LAYER; int r = it % I_LAYER;
        unsigned char* wl = a->ws + WS_W + (size_t)l * W_LAYER;
        if (r < I_IN) { p0_transpose_item(a->in[8] + (size_t)l * DM * NIN, DM, NIN, (bf16_t*)(wl + W_IN), 0, scr, r, lane); continue; } r -= I_IN;
        if (r < I_SQ) { p0_transpose_item(a->in[11] + (size_t)l * DM * DM, DM, DM, (bf16_t*)(wl + W_AO), 0, scr, r, lane); continue; } r -= I_SQ;
        if (r < I_SQ) { p0_transpose_item(a->in[14] + (size_t)l * DM * DM, DM, DM, (bf16_t*)(wl + W_SO), 0, scr, r, lane); continue; } r -= I_SQ;
        if (r < I_SQ) { p0_transpose_item(a->in[22] + (size_t)l * DM * DM, DM, DM, (bf16_t*)(wl + W_LO), 0, scr, r, lane); continue; } r -= I_SQ;
        if (r < I_SQ) { p0_transpose_item(a->in[23] + (size_t)l * DM * DM, DM, DM, (bf16_t*)(wl + W_MO), 0, scr, r, lane); continue; } r -= I_SQ;
        if (r < I_F1) { p0_transpose_item(a->in[24] + (size_t)l * DM * 2 * FFW, DM, 2 * FFW, (bf16_t*)(wl + W_F1), 1, scr, r, lane); continue; } r -= I_F1;
        if (r < I_F2) { p0_transpose_item(a->in[25] + (size_t)l * FFW * DM, FFW, DM, (bf16_t*)(wl + W_F2), 0, scr, r, lane); continue; } r -= I_F2;
        { const int mat = r >> 3, d = mat >> 4, g = (mat >> 3) & 1, n = mat & 7;
          const float* src = (g == 0 ? a->in[17] : a->in[19]) + (size_t)((l * 2 + d) * 8 + n) * 16384;
          p0_transpose_item(src, 128, 128, (bf16_t*)(wl + W_LRU) + (size_t)((d * 2 + g) * 8 + n) * 16384, 0, scr, r & 7, lane); }
    }
}

__device__ __forceinline__ void phase_norm(CArgs a, const Frame& F, int which) {
    const int tid_ = tid_opaque(F.wave_s); const int lane = tid_ & 63, wave = __builtin_amdgcn_readfirstlane(tid_ >> 6);
    const int gw = bid_opaque() * NWAVES + wave, NGW = gridDim.x * NWAVES;
    const bool first = (which == 0 && F.l == 0);
    const int nrows = (which == 1 && F.l == 1) ? LROWS : ROWS;
    const float* g = (which == 0 ? a->in[6] : a->in[7]) + F.l * DM;
    for (int m = gw; m < nrows; m += NGW) {
        const bool lat = m < LROWS;
        const float* src = lat ? (first ? F.x : F.out) + (size_t)m * DM : (first ? F.ctx : F.XC()) + (size_t)(m - LROWS) * DM;
        const int b = lat ? (m >> 12) : 8;
        const float* md = F.MOD(b) + (which == 0 ? 0 : 3072);
        f32x4 v[4]; float s = 0.f;
#pragma unroll
        for (int j = 0; j < 4; ++j) { v[j] = *(const f32x4*)(src + 4 * lane + 256 * j); s += (v[j].x * v[j].x + v[j].y * v[j].y) + (v[j].z * v[j].z + v[j].w * v[j].w); }
        const float rstd = rsqrtf(wave_sum(s) * (1.f / DM) + EPS);
        bf16_t* dst = F.H() + (size_t)m * DM;
#pragma unroll
        for (int j = 0; j < 4; ++j) { const int col = 4 * lane + 256 * j;
            const f32x4 gg = *(const f32x4*)(g + col), sh = *(const f32x4*)(md + col), sc = *(const f32x4*)(md + 1024 + col);
            const f32x4 h = (v[j] * rstd * gg) * (sc + 1.0f) + sh;
            u32x2 w; w.x = cvt_pk_bf16(h.x, h.y); w.y = cvt_pk_bf16(h.z, h.w); *(u32x2*)(dst + col) = w; }
    }
}
__device__ __forceinline__ void phase_final(CArgs a, const Frame& F) {
    const int tid_ = tid_opaque(F.wave_s); const int lane = tid_ & 63, wave = __builtin_amdgcn_readfirstlane(tid_ >> 6);
    const int gw = bid_opaque() * NWAVES + wave, NGW = gridDim.x * NWAVES;
    const float* g = a->in[26];
    for (int m = gw; m < LROWS; m += NGW) {
        float* p = F.out + (size_t)m * DM;
        f32x4 v[4]; float s = 0.f;
#pragma unroll
        for (int j = 0; j < 4; ++j) { v[j] = *(const f32x4*)(p + 4 * lane + 256 * j); s += (v[j].x * v[j].x + v[j].y * v[j].y) + (v[j].z * v[j].z + v[j].w * v[j].w); }
        const float rstd = rsqrtf(wave_sum(s) * (1.f / DM) + EPS);
#pragma unroll
        for (int j = 0; j < 4; ++j) { const int col = 4 * lane + 256 * j; *(f32x4*)(p + col) = v[j] * rstd * *(const f32x4*)(g + col); }
    }
}

struct QkRow { u32x4 raw[3]; bf16_t* p[3]; bool act[3]; bool lat; int pos; };
__device__ __forceinline__ void qk_load(const Frame& F, int lr, int s, int i, int qd, QkRow& R) {
    const bool lat = lr < CH_L; R.lat = lat;
    int kvrow, prow = 0, pcol = 0;
    if (lat) { const int bl = lr >> 12, t = lr & 4095; kvrow = bl * KVLEN + CTXL + t; prow = t >> 6; pcol = t & 63; }
    else { const int lc = lr - CH_L; kvrow = (lc >> 8) * KVLEN + (lc & 255); }
    R.pos = qd < 2 ? prow : pcol;
#pragma unroll
    for (int it = 0; it < 3; ++it) { const int hs = 4 * it + s;
        R.act[it] = hs < 10 && (lat || F.l == 0 || it == 2) && lr < CH_ROWS;
        R.p[it] = hs < 8 ? F.Z() + (size_t)lr * ZP + hs * 128 + 8 * i : F.Kb() + (size_t)kvrow * 256 + (hs - 8) * 128 + 8 * i;
        if (R.act[it]) R.raw[it] = *(const u32x4*)R.p[it]; }
}
__device__ __forceinline__ void qk_finish(const Frame& F, const float* qg, const float* kg, const f32x2* rope, int s, int i, int qd, const QkRow& R) {
#pragma unroll
    for (int it = 0; it < 3; ++it) {
        if (R.act[it]) {
            const int hs = 4 * it + s; const float* gp = hs < 8 ? qg : kg; const u32x4 raw = R.raw[it];
            float v[8] = {bf_lo(raw.x), bf_hi(raw.x), bf_lo(raw.y), bf_hi(raw.y), bf_lo(raw.z), bf_hi(raw.z), bf_lo(raw.w), bf_hi(raw.w)};
            float ss = 0.f;
#pragma unroll
            for (int e = 0; e < 8; ++e) ss += v[e] * v[e];
            ss += __shfl_xor(ss, 1); ss += __shfl_xor(ss, 2); ss += __shfl_xor(ss, 4); ss += __shfl_xor(ss, 8);
            const float rstd = rsqrtf(ss * (1.f / 128.f) + EPS);
            const f32x4 g0 = *(const f32x4*)gp, g1 = *(const f32x4*)(gp + 4);
            v[0] *= rstd * g0.x; v[1] *= rstd * g0.y; v[2] *= rstd * g0.z; v[3] *= rstd * g0.w; v[4] *= rstd * g1.x; v[5] *= rstd * g1.y; v[6] *= rstd * g1.z; v[7] *= rstd * g1.w;
            if (R.lat) {
                const f32x2* rp = rope + R.pos * 32 + 8 * (i & 3);
#pragma unroll
                for (int e = 0; e < 8; ++e) { const float pv = __shfl_xor(v[e], 4); const f32x2 cs = rp[e]; v[e] = (qd & 1) ? v[e] * cs.x + pv * cs.y : v[e] * cs.x - pv * cs.y; }
            }
            u32x4 w; w.x = cvt_pk_bf16(v[0], v[1]); w.y = cvt_pk_bf16(v[2], v[3]); w.z = cvt_pk_bf16(v[4], v[5]); w.w = cvt_pk_bf16(v[6], v[7]);
            *(u32x4*)R.p[it] = w;
        }
    }
}
__device__ __forceinline__ void phase_qknorm(CArgs a, const Frame& F) {
    const int tid_ = tid_opaque(F.wave_s); const int lane = tid_ & 63, wave = __builtin_amdgcn_readfirstlane(tid_ >> 6);
    const int gw = bid_opaque() * NWAVES + wave, NGW = gridDim.x * NWAVES;
    const int s = lane >> 4, i = lane & 15, qd = i >> 2;
    const float* qg = a->in[9] + F.l * 128 + 8 * i; const float* kg = a->in[10] + F.l * 128 + 8 * i;
    const f32x2* rope = (const f32x2*)(F.ws + WS_ROPE);
    for (int lr = gw; lr < CH_ROWS; lr += 2 * NGW) {
        QkRow R0, R1;
        qk_load(F, lr, s, i, qd, R0); qk_load(F, lr + NGW, s, i, qd, R1);
        qk_finish(F, qg, kg, rope, s, i, qd, R0); qk_finish(F, qg, kg, rope, s, i, qd, R1);
    }
}

__device__ __forceinline__ void phase_sconv(CArgs a, const Frame& F) {
    const int tid_ = tid_opaque(F.wave_s); const int lane = tid_ & 63, wave = __builtin_amdgcn_readfirstlane(tid_ >> 6);
    const int gw = bid_opaque() * NWAVES + wave, NGW = gridDim.x * NWAVES;
    const int nrows = (F.l == 0) ? CH_ROWS : CH_L;
    const float* wsc = a->in[12] + (size_t)F.l * 3 * DM; const float* bsc = a->in[13] + (size_t)F.l * DM;
    for (int it = gw; it < (nrows / 16) * 2; it += NGW) {
        const int run = it >> 1, ch0 = (it & 1) * 512 + lane * 8, lr0 = run * 16;
        int t0, slen;
        if (lr0 < CH_L) { t0 = lr0 & 4095; slen = SEQ; } else { t0 = (lr0 - CH_L) & 255; slen = CTXL; }
        float w0[8], w1[8], w2[8], bb[8];
#pragma unroll
        for (int e = 0; e < 8; ++e) { w0[e] = wsc[ch0 + e]; w1[e] = wsc[DM + ch0 + e]; w2[e] = wsc[2 * DM + ch0 + e]; bb[e] = bsc[ch0 + e]; }
        bf16_t* zr = F.Z() + (size_t)lr0 * ZP + ch0;
        float up[8], uc[8], un[8];
        auto loadu = [&](int dt, float* u, bool valid) {
            if (valid) { const u32x4 cc = *(const u32x4*)(zr + (long)dt * ZP + CSC), xx = *(const u32x4*)(zr + (long)dt * ZP + CSX);
                u[0] = bf_lo(cc.x) * bf_lo(xx.x); u[1] = bf_hi(cc.x) * bf_hi(xx.x); u[2] = bf_lo(cc.y) * bf_lo(xx.y); u[3] = bf_hi(cc.y) * bf_hi(xx.y);
                u[4] = bf_lo(cc.z) * bf_lo(xx.z); u[5] = bf_hi(cc.z) * bf_hi(xx.z); u[6] = bf_lo(cc.w) * bf_lo(xx.w); u[7] = bf_hi(cc.w) * bf_hi(xx.w); }
            else {
#pragma unroll
                for (int e = 0; e < 8; ++e) u[e] = 0.f; } };
        loadu(-1, up, t0 > 0); loadu(0, uc, true);
#pragma unroll 8
        for (int tt = 0; tt < 16; ++tt) {
            loadu(tt + 1, un, t0 + tt + 1 < slen);
            const u32x4 bq = *(const u32x4*)(zr + (long)tt * ZP + CSB);
            const float bv[8] = {bf_lo(bq.x), bf_hi(bq.x), bf_lo(bq.y), bf_hi(bq.y), bf_lo(bq.z), bf_hi(bq.z), bf_lo(bq.w), bf_hi(bq.w)};
            float o[8];
#pragma unroll
            for (int e = 0; e < 8; ++e) { o[e] = bv[e] * (bb[e] + w0[e] * up[e] + w1[e] * uc[e] + w2[e] * un[e]); up[e] = uc[e]; uc[e] = un[e]; }
            u32x4 w; w.x = cvt_pk_bf16(o[0], o[1]); w.y = cvt_pk_bf16(o[2], o[3]); w.z = cvt_pk_bf16(o[4], o[5]); w.w = cvt_pk_bf16(o[6], o[7]);
            *(u32x4*)(zr + (long)tt * ZP + CSB) = w;
        }
    }
}

constexpr int L_XS = 0, L_XS_STRIDE = 136, L_YT = 17408, L_YT_STRIDE = 132, L_WV = L_YT + 64 * L_YT_STRIDE * 4, L_WV_BYTES = 2 * 16 * 68 * 4, L_CW = L_WV + 8 * L_WV_BYTES;
constexpr int L_XS2 = L_CW + 5 * 128 * 4;
static_assert(L_XS2 + 64 * L_XS_STRIDE * 2 <= MISC_OFF, "lru lds");
struct LruCtx { bf16x8 wf[2][2][4]; float pba[2], pbx[2], spl[2]; };
__device__ __forceinline__ void lru_setup(CArgs a, const Frame& F, int n, LruCtx& C) {
    const int tid = tid_opaque(F.wave_s), lane = tid & 63, wave = __builtin_amdgcn_readfirstlane(tid >> 6), fr = lane & 15, fq = lane >> 4;
    const int l = F.l, ech = wave * 16 + fr, chg = n * 128 + ech;
    const bf16_t* wt = F.W(W_LRU) + (size_t)n * 16384 + (size_t)ech * 128 + fq * 8;
#pragma unroll
    for (int d = 0; d < 2; ++d)
#pragma unroll
        for (int g = 0; g < 2; ++g)
#pragma unroll
            for (int ks = 0; ks < 4; ++ks) C.wf[d][g][ks] = *(const bf16x8*)(wt + (size_t)((d * 2 + g) * 8) * 16384 + ks * 32);
#pragma unroll
    for (int d = 0; d < 2; ++d) { C.pba[d] = a->in[18][(l * 2 + d) * DM + chg]; C.pbx[d] = a->in[20][(l * 2 + d) * DM + chg]; const float lam = a->in[21][(l * 2 + d) * DM + chg];
        const float ey = __builtin_amdgcn_exp2f(-lam * 1.4426950408889634f);
        const float sp_small = ey * (1.0f + ey * (-0.5f + ey * (0.33333334f + ey * (-0.25f + ey * 0.2f))));
        const float sp_big = (lam < -15.f) ? -lam : __builtin_amdgcn_logf(1.0f + ey) * 0.6931471805599453f;
        C.spl[d] = (ey < 0.125f ? sp_small : sp_big) * (8.0f * 1.4426950408889634f); }
}
struct XRows { u32x4 r[4][2]; };
__device__ __forceinline__ void lru_load_rows(const Frame& F, int tile, int n, XRows& X) {
    const int tid = tid_opaque(F.wave_s), t = tid >> 3, c0 = (tid & 7) * 16;
    const int lrow0 = tile < 256 ? tile * 64 : CH_L + (tile - 256) * 64;
#pragma unroll
    for (int k = 0; k < 4; ++k) { int row = lrow0 + t + k - 2; row = row < 0 ? 0 : (row > CH_ROWS - 1 ? CH_ROWS - 1 : row);
        const bf16_t* zr = F.Z() + (size_t)row * ZP + CRX + n * 128 + c0; X.r[k][0] = *(const u32x4*)zr; X.r[k][1] = *(const u32x4*)(zr + 8); }
}
__device__ __forceinline__ void lru_item(CArgs a, const Frame& F, LAS unsigned char* lds, int pass, int tile, int n, const LruCtx& C, const float cy, const XRows& X, const int xbuf) {
    const int tid = tid_opaque(F.wave_s), lane = tid & 63, wave = __builtin_amdgcn_readfirstlane(tid >> 6), fr = lane & 15, fq = lane >> 4;
    const int l = F.l;
    LAS bf16_t* xs = (LAS bf16_t*)(lds + (xbuf ? L_XS2 : L_XS)); LAS float* yt = (LAS float*)(lds + L_YT);
    LAS float* wa = (LAS float*)(lds + L_WV + wave * L_WV_BYTES); LAS float* wu = wa + 16 * 68;
    int lrow0, t0, slen;
    if (tile < 256) { lrow0 = tile * 64; t0 = (tile & 63) * 64; slen = SEQ; }
    else { const int jj = tile - 256; lrow0 = CH_L + jj * 64; t0 = (jj & 3) * 64; slen = CTXL; }
    float* lsum = (float*)(F.ws + WS_LSUM);
    const int ech = wave * 16 + fr, chg = n * 128 + ech;
    u32x4 g0 = {0u, 0u, 0u, 0u}, g1 = {0u, 0u, 0u, 0u};
    if (pass == 2) { const bf16_t* zg = F.Z() + (size_t)(lrow0 + (tid >> 3)) * ZP + CRG + n * 128 + (tid & 7) * 16; g0 = *(const u32x4*)zg; g1 = *(const u32x4*)(zg + 8); }
    {
        const int t = tid >> 3, c0 = (tid & 7) * 16;
        const LAS float* cw = (const LAS float*)(lds + L_CW) + c0;
        float accv[16];
#pragma unroll
        for (int i = 0; i < 4; ++i) { const f32x4 b4 = *(const LAS f32x4*)(cw + 4 * 128 + 4 * i); accv[4 * i] = b4[0]; accv[4 * i + 1] = b4[1]; accv[4 * i + 2] = b4[2]; accv[4 * i + 3] = b4[3]; }
#pragma unroll
        for (int k = 0; k < 4; ++k) { const int ts = t0 + t + k - 2;
            if (ts >= 0 && ts < slen) { const u32x4 r0 = X.r[k][0], r1 = X.r[k][1];
                const float xv[16] = {bf_lo(r0.x), bf_hi(r0.x), bf_lo(r0.y), bf_hi(r0.y), bf_lo(r0.z), bf_hi(r0.z), bf_lo(r0.w), bf_hi(r0.w), bf_lo(r1.x), bf_hi(r1.x), bf_lo(r1.y), bf_hi(r1.y), bf_lo(r1.z), bf_hi(r1.z), bf_lo(r1.w), bf_hi(r1.w)};
#pragma unroll
                for (int i = 0; i < 4; ++i) { const f32x4 w4 = *(const LAS f32x4*)(cw + k * 128 + 4 * i);
                    accv[4 * i] += xv[4 * i] * w4[0]; accv[4 * i + 1] += xv[4 * i + 1] * w4[1]; accv[4 * i + 2] += xv[4 * i + 2] * w4[2]; accv[4 * i + 3] += xv[4 * i + 3] * w4[3]; } } }
        u32x4 w0, w1; w0.x = cvt_pk_bf16(accv[0], accv[1]); w0.y = cvt_pk_bf16(accv[2], accv[3]); w0.z = cvt_pk_bf16(accv[4], accv[5]); w0.w = cvt_pk_bf16(accv[6], accv[7]);
        w1.x = cvt_pk_bf16(accv[8], accv[9]); w1.y = cvt_pk_bf16(accv[10], accv[11]); w1.z = cvt_pk_bf16(accv[12], accv[13]); w1.w = cvt_pk_bf16(accv[14], accv[15]);
        *(LAS u32x4*)(xs + t * L_XS_STRIDE + c0) = w0; *(LAS u32x4*)(xs + t * L_XS_STRIDE + c0 + 8) = w1;
    }
    __syncthreads();
    f32x4 accg[2][2][4];
#pragma unroll
    for (int d = 0; d < 2; ++d)
#pragma unroll
        for (int g = 0; g < 2; ++g)
#pragma unroll
            for (int m = 0; m < 4; ++m) accg[d][g][m] = (f32x4){0.f, 0.f, 0.f, 0.f};
#pragma unroll
    for (int ks = 0; ks < 4; ++ks)
#pragma unroll
        for (int m = 0; m < 4; ++m) { const bf16x8 af = *(const LAS bf16x8*)(xs + (16 * m + fr) * L_XS_STRIDE + ks * 32 + fq * 8);
#pragma unroll
            for (int d = 0; d < 2; ++d)
#pragma unroll
                for (int g = 0; g < 2; ++g) accg[d][g][m] = __builtin_amdgcn_mfma_f32_16x16x32_bf16(af, C.wf[d][g][ks], accg[d][g][m], 0, 0, 0); }
    float xv[4][4];
#pragma unroll
    for (int m = 0; m < 4; ++m)
#pragma unroll
        for (int jj = 0; jj < 4; ++jj) xv[m][jj] = bf1(xs[(16 * m + 4 * fq + jj) * L_XS_STRIDE + ech]);
    float y[16];
#pragma unroll
    for (int d = 0; d < 2; ++d) {
#pragma unroll
        for (int m = 0; m < 4; ++m) { f32x4 av, uv;
#pragma unroll
            for (int jj = 0; jj < 4; ++jj) {
                const float r = fast_sigmoid(accg[d][0][m][jj] + C.pba[d]), ig = fast_sigmoid(accg[d][1][m][jj] + C.pbx[d]);
                const float av1 = __builtin_amdgcn_exp2f(-r * C.spl[d]);
                const float om = __builtin_fmaf(-av1, av1, 1.0f);
                av[jj] = av1; uv[jj] = __builtin_amdgcn_sqrtf(om) * (ig * xv[m][jj]); }
            *(LAS f32x4*)(wa + fr * 68 + 16 * m + 4 * fq) = av; *(LAS f32x4*)(wu + fr * 68 + 16 * m + 4 * fq) = uv; }
        asm volatile("s_waitcnt lgkmcnt(0)" ::: "memory");
        f32x4 A4[4], U4[4];
#pragma unroll
        for (int i = 0; i < 4; ++i) { A4[i] = *(const LAS f32x4*)(wa + fr * 68 + 16 * fq + 4 * i); U4[i] = *(const LAS f32x4*)(wu + fr * 68 + 16 * fq + 4 * i); }
        asm volatile("s_waitcnt lgkmcnt(0)" ::: "memory");
        float hl[16], Pl[16]; float h = 0.f, P = 1.f;
        if (d == 0) {
#pragma unroll
            for (int s = 0; s < 16; ++s) { const float av = A4[s >> 2][s & 3], uv = U4[s >> 2][s & 3]; h = av * h + uv; P *= av; hl[s] = h; Pl[s] = P; }
        } else {
#pragma unroll
            for (int s = 15; s >= 0; --s) { const float av = A4[s >> 2][s & 3], uv = U4[s >> 2][s & 3]; h = av * h + uv; P *= av; hl[s] = h; Pl[s] = P; }
        }
        float Pk[4], Hk[4];
#pragma unroll
        for (int k = 0; k < 4; ++k) { Pk[k] = __shfl(P, k * 16 + fr); Hk[k] = __shfl(h, k * 16 + fr); }
        float c = (pass == 2) ? __shfl(cy, d * 16 + fr) : 0.f, cin = 0.f, Pt = 1.f;
#pragma unroll
        for (int kk = 0; kk < 4; ++kk) { const int k = d == 0 ? kk : 3 - kk; if (k == fq) cin = c; c = Pk[k] * c + Hk[k]; Pt *= Pk[k]; }
        if (pass == 1) { if (fq == 0) ((f32x2*)lsum)[(size_t)tile * 2048 + d * 1024 + chg] = (f32x2){Pt, c}; }
        else {
#pragma unroll
            for (int s = 0; s < 16; ++s) { const float hv = hl[s] + Pl[s] * cin; if (d == 0) y[s] = hv; else y[s] += hv; }
        }
    }
    if (pass == 2) {
#pragma unroll
        for (int s = 0; s < 16; ++s) yt[(16 * fq + s) * L_YT_STRIDE + ech] = y[s];
        __syncthreads();
        const int t = tid >> 3, c0 = (tid & 7) * 16;
        bf16_t* zr = F.Z() + (size_t)(lrow0 + t) * ZP + CRG + n * 128 + c0;
        const float gv[16] = {bf_lo(g0.x), bf_hi(g0.x), bf_lo(g0.y), bf_hi(g0.y), bf_lo(g0.z), bf_hi(g0.z), bf_lo(g0.w), bf_hi(g0.w), bf_lo(g1.x), bf_hi(g1.x), bf_lo(g1.y), bf_hi(g1.y), bf_lo(g1.z), bf_hi(g1.z), bf_lo(g1.w), bf_hi(g1.w)};
        float o[16];
#pragma unroll
        for (int i = 0; i < 4; ++i) { const f32x4 yv = *(const LAS f32x4*)(yt + t * L_YT_STRIDE + c0 + 4 * i); o[4 * i] = yv[0] * gv[4 * i]; o[4 * i + 1] = yv[1] * gv[4 * i + 1]; o[4 * i + 2] = yv[2] * gv[4 * i + 2]; o[4 * i + 3] = yv[3] * gv[4 * i + 3]; }
        u32x4 w0, w1; w0.x = cvt_pk_bf16(o[0], o[1]); w0.y = cvt_pk_bf16(o[2], o[3]); w0.z = cvt_pk_bf16(o[4], o[5]); w0.w = cvt_pk_bf16(o[6], o[7]);
        w1.x = cvt_pk_bf16(o[8], o[9]); w1.y = cvt_pk_bf16(o[10], o[11]); w1.z = cvt_pk_bf16(o[12], o[13]); w1.w = cvt_pk_bf16(o[14], o[15]);
        *(u32x4*)(zr + (CSC - CRG)) = w0; *(u32x4*)(zr + (CSC - CRG) + 8) = w1;
    }
}

__device__ __forceinline__ void lru_phase(CArgs a, const Frame& F, LAS unsigned char* lds, int pass) {
    const int tid = tid_opaque(F.wave_s), lane = tid & 63, wave = __builtin_amdgcn_readfirstlane(tid >> 6), fr = lane & 15;
    const int d = (lane >> 4) & 1; const bool cl = (pass == 2) && lane < 32;
    for (int w = bid_opaque(); w < 256; w += gridDim.x) {
        const int bl = w >> 6, n = (w >> 3) & 7, sg = w & 7;
        LruCtx C; lru_setup(a, F, n, C);
        { LAS float* cwl = (LAS float*)(lds + L_CW);
          for (int e = tid; e < 640; e += NTHREADS) cwl[e] = e < 512 ? a->in[15][(size_t)F.l * 4 * DM + (e >> 7) * DM + n * 128 + (e & 127)] : a->in[16][(size_t)F.l * DM + n * 128 + (e - 512)];
          __syncthreads(); }
        XRows xc, xn; lru_load_rows(F, bl * 64 + sg * 8, n, xc);
        const f32x2* sp = (const f32x2*)(F.ws + WS_LSUM) + (size_t)d * 1024 + n * 128 + wave * 16 + fr;
        const int cf = 256 + bl * 4, lf = bl * 64;
        float cb = 0.f;
        if (cl) {
#pragma unroll
            for (int q = 0; q < 4; ++q) { const f32x2 s = sp[(size_t)(d == 0 ? cf + q : cf + 3 - q) * 2048]; cb = s.x * cb + s.y; }
            const int cnt = d == 0 ? sg * 8 : 56 - sg * 8, start = d == 0 ? lf : lf + 63, step = d == 0 ? 1 : -1;
#pragma unroll 8
            for (int q = 0; q < cnt; ++q) { const f32x2 s = sp[(size_t)(start + q * step) * 2048]; cb = s.x * cb + s.y; }
        }
        float cys[8];
#pragma unroll
        for (int q = 0; q < 8; ++q) cys[q] = 0.f;
        if (cl) { f32x2 ss[8];
#pragma unroll
            for (int q = 0; q < 8; ++q) ss[q] = sp[(size_t)(lf + sg * 8 + q) * 2048];
            float c = cb;
#pragma unroll
            for (int q = 0; q < 8; ++q) { const int qq = d == 0 ? q : 7 - q; const f32x2 sv = d == 0 ? ss[q] : ss[7 - q];
                if (d == 0) { cys[q] = c; } else { cys[7 - q] = c; } c = sv.x * c + sv.y; (void)qq; } }
        for (int jj = 0; jj < 8; ++jj) {
            const int tl = sg * 8 + jj; float cy = cys[0];
#pragma unroll
            for (int q = 1; q < 8; ++q) cy = (jj == q) ? cys[q] : cy;
            const bool has_ctx = sg < 4 && (pass == 1 || F.l == 0);
            if (jj < 7) lru_load_rows(F, lf + tl + 1, n, xn); else if (has_ctx) lru_load_rows(F, cf + sg, n, xn);
            lru_item(a, F, lds, pass, lf + tl, n, C, cy, xc, jj & 1);
            xc = xn;
        }
        if (sg < 4 && (pass == 1 || F.l == 0)) {
            float cy = 0.f;
            if (cl) { if (d == 0) { for (int q = 0; q < sg; ++q) { const f32x2 s = sp[(size_t)(cf + q) * 2048]; cy = s.x * cy + s.y; } }
                      else { for (int q = 3; q > sg; --q) { const f32x2 s = sp[(size_t)(cf + q) * 2048]; cy = s.x * cy + s.y; } } }
            lru_item(a, F, lds, pass, cf + sg, n, C, cy, xc, 0);
        }
        __syncthreads();
    }
}

constexpr int SG_KC = 512, SG_PITCH = SG_KC * 2 + 16, SG_B_OFF = 64 * SG_PITCH;
__device__ __forceinline__ void sg_accum(LAS unsigned char* lds, const bf16_t* A, int lda, const bf16_t* Bt, int K, int tid, int wave, int lane, f32x4 (&acc)[2]) {
    const int fr = lane & 15, fq = lane >> 4, rt = wave & 3, ch = wave >> 2;
    u32x4 ra[8], rb[8];
#define SG_LOADS(k0_) do { _Pragma("unroll") for (int i_ = 0; i_ < 8; ++i_) { const int p_ = tid + 512 * i_, row_ = p_ >> 6, kc_ = (p_ & 63) * 8; \
        if ((k0_) + kc_ < K) { ra[i_] = *(const u32x4*)(A + (size_t)row_ * lda + (k0_) + kc_); rb[i_] = *(const u32x4*)(Bt + (size_t)row_ * K + (k0_) + kc_); } \
        else { ra[i_] = (u32x4){0u, 0u, 0u, 0u}; rb[i_] = (u32x4){0u, 0u, 0u, 0u}; } } } while (0)
    SG_LOADS(0);
    for (int k0 = 0; k0 < K; k0 += SG_KC) {
        __syncthreads();
#pragma unroll
        for (int i = 0; i < 8; ++i) { const int p = tid + 512 * i, row = p >> 6, kc = (p & 63) * 8;
            *(LAS u32x4*)(lds + row * SG_PITCH + kc * 2) = ra[i]; *(LAS u32x4*)(lds + SG_B_OFF + row * SG_PITCH + kc * 2) = rb[i]; }
        if (k0 + SG_KC < K) SG_LOADS(k0 + SG_KC);
        __syncthreads();
        const int nks = (K - k0) >= SG_KC ? 16 : (K - k0) / 32;
        const LAS unsigned char* ap = lds + (16 * rt + fr) * SG_PITCH + fq * 16;
        const LAS unsigned char* bp = lds + SG_B_OFF + (32 * ch + fr) * SG_PITCH + fq * 16;
#pragma unroll 4
        for (int ks = 0; ks < nks; ++ks) { const bf16x8 af = *(const LAS bf16x8*)(ap + ks * 64), b0 = *(const LAS bf16x8*)(bp + ks * 64), b1 = *(const LAS bf16x8*)(bp + 16 * SG_PITCH + ks * 64);
            acc[0] = __builtin_amdgcn_mfma_f32_16x16x32_bf16(af, b0, acc[0], 0, 0, 0); acc[1] = __builtin_amdgcn_mfma_f32_16x16x32_bf16(af, b1, acc[1], 0, 0, 0); }
    }
    __syncthreads();
#undef SG_LOADS
}
__device__ __forceinline__ void ctx_g2_block(const Frame& F, LAS unsigned char* lds, int id) {
    const int tid = tid_opaque(F.wave_s), lane = tid & 63, wave = __builtin_amdgcn_readfirstlane(tid >> 6), fr = lane & 15, fq = lane >> 4, rt = wave & 3, ch = wave >> 2;
    const int rb = id >> 4, cb = id & 15;
    bf16_t* zrow = F.Z() + (size_t)(CH_L + rb * 64) * ZP;
    f32x4 total[2] = {(f32x4){0.f, 0.f, 0.f, 0.f}, (f32x4){0.f, 0.f, 0.f, 0.f}};
#pragma unroll
    for (int seg = 0; seg < 3; ++seg) {
        f32x4 acc[2] = {(f32x4){0.f, 0.f, 0.f, 0.f}, (f32x4){0.f, 0.f, 0.f, 0.f}};
        const int colA = seg == 0 ? CSX : (seg == 1 ? CSB : CSC);
        bf16_t gq[2][4];
#pragma unroll
        for (int ct = 0; ct < 2; ++ct)
#pragma unroll
            for (int j = 0; j < 4; ++j) gq[ct][j] = zrow[(size_t)(16 * rt + 4 * fq + j) * ZP + CGT + seg * 1024 + cb * 64 + 32 * ch + 16 * ct + fr];
        sg_accum(lds, zrow + colA, ZP, F.W(seg == 0 ? W_AO : (seg == 1 ? W_SO : W_LO)) + (size_t)(cb * 64) * DM, DM, tid, wave, lane, acc);
#pragma unroll
        for (int ct = 0; ct < 2; ++ct)
#pragma unroll
            for (int j = 0; j < 4; ++j) total[ct][j] += bf1(gq[ct][j]) * acc[ct][j];
    }
#pragma unroll
    for (int ct = 0; ct < 2; ++ct)
#pragma unroll
        for (int j = 0; j < 4; ++j) zrow[(size_t)(16 * rt + 4 * fq + j) * ZP + CQ + cb * 64 + 32 * ch + 16 * ct + fr] = (bf16_t)(cvt_pk_bf16(total[ct][j], total[ct][j]) & 0xffffu);
}
__device__ __forceinline__ void ctx_res_block(const Frame& F, LAS unsigned char* lds, int id, int which) {
    const int tid = tid_opaque(F.wave_s), lane = tid & 63, wave = __builtin_amdgcn_readfirstlane(tid >> 6), fr = lane & 15, fq = lane >> 4, rt = wave & 3, ch = wave >> 2;
    const int rb = id >> 4, cb = id & 15;
    f32x4 acc[2] = {(f32x4){0.f, 0.f, 0.f, 0.f}, (f32x4){0.f, 0.f, 0.f, 0.f}};
    const size_t xrow0 = which == 0 ? (size_t)F.c * CH_C + rb * 64 : (size_t)rb * 64;
    const float* base = (which == 0 && F.l == 0) ? F.ctx : F.XC();
    const float* vec = F.MOD(8) + (which == 0 ? 2048 : 5120) + cb * 64 + 32 * ch + fr;
    float bq[2][4], gv[2];
#pragma unroll
    for (int ct = 0; ct < 2; ++ct) { gv[ct] = vec[16 * ct];
#pragma unroll
        for (int j = 0; j < 4; ++j) bq[ct][j] = base[(xrow0 + 16 * rt + 4 * fq + j) * DM + cb * 64 + 32 * ch + 16 * ct + fr]; }
    if (which == 0) sg_accum(lds, F.Z() + (size_t)(CH_L + rb * 64) * ZP + CQ, ZP, F.W(W_MO) + (size_t)(cb * 64) * DM, DM, tid, wave, lane, acc);
    else sg_accum(lds, F.Z() + (size_t)(LROWS + rb * 64) * FFW, FFW, F.W(W_F2) + (size_t)(cb * 64) * FFW, FFW, tid, wave, lane, acc);
#pragma unroll
    for (int ct = 0; ct < 2; ++ct)
#pragma unroll
        for (int j = 0; j < 4; ++j) F.XC()[(xrow0 + 16 * rt + 4 * fq + j) * DM + cb * 64 + 32 * ch + 16 * ct + fr] = bq[ct][j] + gv[ct] * acc[ct][j];
}

constexpr int N_PHASES = 30;
__device__ __forceinline__ void decode_phase(int ph, int& kind, int& l, int& c) {
    if (ph == 0) { kind = K_P0; l = 0; c = 0; return; }
    if (ph == N_PHASES - 1) { kind = K_FN; l = 1; c = 0; return; }
    const int q = ph - 1; l = q / 14; const int r = q % 14; c = 0;
    if (r == 0) { kind = K_N1; }
    else if (r <= 10) { c = (r - 1) / 5; const int s = (r - 1) % 5; kind = s == 0 ? K_G1 : s == 1 ? K_M1 : s == 2 ? K_A1 : s == 3 ? K_G2 : K_G3; }
    else { kind = r == 11 ? K_N2 : (r == 12 ? K_G4 : K_G5); }
}

__global__ void __launch_bounds__(NTHREADS, 2) mk_fwd(Args a_) {
    extern __shared__ __attribute__((aligned(16))) unsigned char lds_raw[];
    LAS unsigned char* lds = (LAS unsigned char*)lds_raw;
    cg::grid_group grid = cg::this_grid();
    const int ph_lo = a_.ph_lo, ph_hi = a_.ph_hi;
    const int wave_s = __builtin_amdgcn_readfirstlane(threadIdx.x >> 6);
    volatile LAS unsigned* MISC = (volatile LAS unsigned*)(lds + MISC_OFF);
    if (threadIdx.x < 4) MISC[threadIdx.x] = 0u;
    __syncthreads();
    (void)xcd_barrier_post((unsigned*)(a_.ws + WS_CTL), MISC);
    for (int ph = ph_lo; ph < ph_hi; ++ph) {
        CArgs a; { unsigned long long kp = (unsigned long long)__builtin_amdgcn_kernarg_segment_ptr(); asm volatile("" : "+s"(kp)); a = (CArgs)kp; }
        if (ph > ph_lo) {
            if (ph_hi < 0) grid.sync();
            else { XcdBarrier bar; bar.bar = (unsigned*)(a->ws + WS_CTL); bar.x = xb_xcc_id(); bar.st = (volatile LAS unsigned*)(lds + MISC_OFF); xcd_barrier(bar, tid_opaque(wave_s) == 0); } }
        Frame F;
        F.x = a->in[0]; F.cvec = a->in[1]; F.ctx = a->in[2]; F.cctx = a->in[3]; F.out = a->out; F.ws = a->ws;
        F.G = gridDim.x; { const int bx = bid_opaque(); F.vcu = (F.G % 8 == 0) ? (bx % 8) * (F.G / 8) + bx / 8 : bx; }
        int kind, l, c; decode_phase(ph, kind, l, c);
        F.kind = kind; F.l = l; F.c = c; F.wave_s = wave_s;
        if (kind == K_P0) { phase_p0(a, F, lds); }
        else if (kind == K_N1) { for (int rep = 0; rep < ((kind == REP_KIND) ? 2 : 1); ++rep) phase_norm(a, F, 0); }
        else if (kind == K_N2) { for (int rep = 0; rep < ((kind == REP_KIND) ? 2 : 1); ++rep) phase_norm(a, F, 1); }
        else if (kind == K_FN) { phase_final(a, F); }
        else if (kind == K_M1) {
            for (int rep = 0; rep < REP_LRU1; ++rep) lru_phase(a, F, lds, 1);
            phase_qknorm(a, F);
            phase_sconv(a, F);
        } else if (kind == K_A1) {
            for (int rep = 0; rep < REP_A1; ++rep) lru_phase(a, F, lds, 2);
            const int nlat = CHB * 8 * 16, ntot = nlat + ((l == 0) ? CHB * 8 : 0);
            for (int rep = 0; rep < REP_ATT; ++rep)
            for (int i = 0;; ++i) {
                int U;
                if (F.G == 256) { if (i < 2) U = (F.vcu >> 5) * 64 + i * 32 + (F.vcu & 31); else { const int v2 = F.vcu - 128; U = (i == 2 && v2 >= 0 && v2 < 32) ? nlat + v2 : ntot; } }
                else U = i * F.G + F.vcu;
                if (U >= ntot) break;
                if (U < nlat) {
                    const int bk = U >> 6, bl = bk >> 1, kvh = bk & 1, r = U & 63, h = kvh * 4 + (r >> 4), qb = r & 15;
                    bf16_t* q = F.Z() + (size_t)(bl * SEQ + qb * 256) * ZP + CQ + h * 128;
                    att::attn_dense_body(q, F.Kb() + (size_t)bl * KVLEN * 256 + kvh * 128, F.Vb() + (size_t)bl * KVLEN * 256 + kvh * 128, q + (CSX - CQ), KVLEN, (char*)lds_raw, F.wave_s);
                } else {
                    const int V = U - nlat, bl = V >> 3, h = V & 7, kvh = h >> 2;
                    bf16_t* q = F.Z() + (size_t)(CH_L + bl * CTXL) * ZP + CQ + h * 128;
                    att::attn_dense_body(q, F.Kb() + (size_t)bl * KVLEN * 256 + kvh * 128, F.Vb() + (size_t)bl * KVLEN * 256 + kvh * 128, q + (CSX - CQ), CTXL, (char*)lds_raw, F.wave_s);
                }
            }
        } else {
            GSched S; S.F = F; GEpi E; E.F = F;
            const int K = (kind == K_G5) ? FFW : DM;
            const int lda = (kind == K_G1 || kind == K_G4) ? DM : (kind == K_G5 ? FFW : ZP);
            for (int rep = 0; rep < ((kind == REP_KIND) ? 2 : 1); ++rep)
            pg8::gemm_phase<GEpi, GSched>(lds, K, lda, S, E);
            if (l == 0) {
                if (kind == K_G2) { for (int id = F.vcu; id < 256; id += F.G) ctx_g2_block(F, lds, id); }
                else if (kind == K_G3) { for (int id = F.vcu; id < 256; id += F.G) ctx_res_block(F, lds, id, 0); }
                else if (kind == K_G5) { for (int id = F.vcu; id < 512; id += F.G) ctx_res_block(F, lds, id, 1); }
            }
        }
    }
}

extern "C" void kernel_launch(void* const* d_in, const int* in_sizes, int n_in, void* d_out, int out_size, void* d_ws, size_t ws_size, hipStream_t stream) {
    static int grid = 0;
    if (grid == 0) {
        if (n_in != 27 || out_size != LROWS * DM || ws_size < WS_END) { fprintf(stderr, "kernel_launch: bad shapes n_in %d out %d ws %zu (need %zu)\n", n_in, out_size, ws_size, (size_t)WS_END); grid = -1; return; }
        int dev = 0, cus = 0, per_cu = 0;
        hipGetDevice(&dev); hipDeviceGetAttribute(&cus, hipDeviceAttributeMultiprocessorCount, dev);
        if (hipFuncSetAttribute((const void*)mk_fwd, hipFuncAttributeMaxDynamicSharedMemorySize, LDS_BYTES) != hipSuccess) { fprintf(stderr, "kernel_launch: hipFuncSetAttribute failed\n"); grid = -1; return; }
        if (hipOccupancyMaxActiveBlocksPerMultiprocessor(&per_cu, (const void*)mk_fwd, NTHREADS, LDS_BYTES) != hipSuccess || per_cu < 1) { fprintf(stderr, "kernel_launch: occupancy query failed (%d)\n", per_cu); per_cu = 1; }
        (void)hipGetLastError();
        grid = cus * per_cu;
        fprintf(stderr, "kernel_launch: grid %d (cus %d x %d)\n", grid, cus, per_cu);
    }
    if (grid < 0) return;
    if (hipMemsetAsync((char*)d_ws + WS_CTL, 0, CTL_BYTES, stream) != hipSuccess) { fprintf(stderr, "kernel_launch: memset failed\n"); return; }
    Args a{};
    for (int i = 0; i < 27; ++i) a.in[i] = (const float*)d_in[i];
    a.out = (float*)d_out; a.ws = (unsigned char*)d_ws;
#if MK_PER_PHASE
    for (int ph = 0; ph < N_PHASES; ++ph) {
        a.ph_lo = ph; a.ph_hi = ph + 1;
        void* args[] = {&a};
        hipError_t e = hipLaunchCooperativeKernel((const void*)mk_fwd, dim3(grid), dim3(NTHREADS), args, LDS_BYTES, stream);
        if (e != hipSuccess) { fprintf(stderr, "launch %d failed: %s\n", ph, hipGetErrorString(e)); break; }
    }
#else
    a.ph_lo = 0; a.ph_hi = N_PHASES;
    void* args[] = {&a};
    hipError_t e = hipLaunchCooperativeKernel((const void*)mk_fwd, dim3(grid), dim3(NTHREADS), args, LDS_BYTES, stream);
    if (e != hipSuccess) fprintf(stderr, "cooperative launch failed: %s (grid %d)\n", hipGetErrorString(e), grid);
#endif
}
```

```cpp
#include <hip/hip_runtime.h>
#include <hip/hip_bf16.h>
#include <hip/hip_cooperative_groups.h>
#include <cstdio>
#include <cstdint>
namespace cg = cooperative_groups;

#ifndef REP_KIND
#define REP_KIND -1
#endif
#ifndef REP_LRU1
#define REP_LRU1 1
#endif
#ifndef REP_A1
#define REP_A1 1
#endif
#ifndef REP_ATT
#define REP_ATT 1
#endif
#ifndef MK_PER_PHASE
#define MK_PER_PHASE 0
#endif

#define LAS __attribute__((address_space(3)))
typedef unsigned short bf16_t;
typedef short bf16x8 __attribute__((ext_vector_type(8)));
typedef short s16x4 __attribute__((ext_vector_type(4)));
typedef float f32x2 __attribute__((ext_vector_type(2)));
typedef float f32x4 __attribute__((ext_vector_type(4)));
typedef float f32x16 __attribute__((ext_vector_type(16)));
typedef unsigned u32x4 __attribute__((ext_vector_type(4)));
typedef unsigned u32x2 __attribute__((ext_vector_type(2)));

constexpr int DM = 1024, NBATCH = 8, SEQ = 4096, CTXL = 256, NIN = 9728, FFW = 2816;
constexpr int LROWS = NBATCH * SEQ, CROWS = NBATCH * CTXL, ROWS = LROWS + CROWS;
constexpr int CHB = 4, CH_L = CHB * SEQ, CH_C = CHB * CTXL, CH_ROWS = CH_L + CH_C;
constexpr int ZP = NIN;
constexpr int CQ = 0, CK = 1024, CV = 1280, CSB = 1536, CSC = 2560, CSX = 3584, CRX = 4608, CRG = 5632, CGT = 6656;
constexpr int KVLEN = CTXL + SEQ;
constexpr float EPS = 1e-6f;
constexpr int NTHREADS = 512, NWAVES = 8;
constexpr int MISC_OFF = 143360, LDS_BYTES = MISC_OFF + 1024;

constexpr size_t MiB = 1u << 20;
constexpr size_t WS_MOD = 0, WS_ROPE = 512 * 1024, WS_CTL = 768 * 1024, CTL_BYTES = 16384, WS_LSUM = 1 * MiB, WS_XC = 6 * MiB, WS_W = 14 * MiB;
constexpr size_t W_IN = 0, W_AO = 19 * MiB, W_SO = 21 * MiB, W_LO = 23 * MiB, W_MO = 25 * MiB, W_F1 = 27 * MiB, W_F2 = 38 * MiB, W_LRU = 43 * MiB + 512 * 1024;
constexpr size_t W_LAYER = 44 * MiB + 512 * 1024;
constexpr size_t WS_H = 103 * MiB, WS_K = 171 * MiB, WS_V = WS_K + (size_t)CHB * KVLEN * 256 * 2, WS_Z = 188 * MiB, WS_END = 511 * MiB;
static_assert(WS_W + 2 * W_LAYER <= WS_H, "weights");
static_assert(WS_H + (size_t)ROWS * DM * 2 <= WS_K, "H");
static_assert(WS_V + (size_t)CHB * KVLEN * 256 * 2 <= WS_Z, "KV");
static_assert(WS_Z + (size_t)CH_ROWS * ZP * 2 <= WS_END, "Z");
static_assert((size_t)ROWS * FFW * 2 <= (size_t)CH_ROWS * ZP * 2, "HID in Z");
static_assert(W_F2 + (size_t)DM * FFW * 2 <= W_LRU && W_IN + (size_t)NIN * DM * 2 <= W_AO && W_F1 + (size_t)2 * FFW * DM * 2 <= W_F2, "w map");

struct Args { const float* in[27]; float* out; unsigned char* ws; int ph_lo, ph_hi; };
typedef const __attribute__((address_space(4))) Args* CArgs;

__device__ __forceinline__ unsigned cvt_pk_bf16(float lo, float hi) { unsigned r; asm volatile("v_cvt_pk_bf16_f32 %0, %1, %2" : "=v"(r) : "v"(lo), "v"(hi)); return r; }
typedef __bf16 bf16x2_t __attribute__((ext_vector_type(2)));
__device__ __forceinline__ unsigned cvtpk_nv(float lo, float hi) { f32x2 v = {lo, hi}; bf16x2_t b = __builtin_convertvector(v, bf16x2_t); return __builtin_bit_cast(unsigned, b); }
__device__ __forceinline__ float bf_lo(unsigned u) { return __uint_as_float(u << 16); }
__device__ __forceinline__ float bf_hi(unsigned u) { return __uint_as_float(u & 0xffff0000u); }
__device__ __forceinline__ float bf1(bf16_t b) { return __uint_as_float((unsigned)b << 16); }
__device__ __forceinline__ int tid_opaque(int wave_s) { int t = wave_s * 64 + (int)__builtin_amdgcn_mbcnt_hi(~0u, __builtin_amdgcn_mbcnt_lo(~0u, 0u)); asm volatile("" : "+v"(t)); return t; }
__device__ __forceinline__ int bid_opaque() { int b = blockIdx.x; asm volatile("" : "+s"(b)); return b; }
template <int M> __device__ __forceinline__ float swz_xor(float v) { return __int_as_float(__builtin_amdgcn_ds_swizzle(__float_as_int(v), (M << 10) | 0x1f)); }
__device__ __forceinline__ float bperm(float v, int src_lane) { return __int_as_float(__builtin_amdgcn_ds_bpermute(src_lane << 2, __float_as_int(v))); }
__device__ __forceinline__ float wave_sum(float v) {
    v += swz_xor<1>(v); v += swz_xor<2>(v); v += swz_xor<4>(v); v += swz_xor<8>(v); v += swz_xor<16>(v);
    auto rr = __builtin_amdgcn_permlane32_swap(__float_as_uint(v), __float_as_uint(v), false, false);
    return __uint_as_float(rr[0]) + __uint_as_float(rr[1]);
}
__device__ __forceinline__ float fast_sigmoid(float y) { return __builtin_amdgcn_rcpf(1.0f + __builtin_amdgcn_exp2f(-1.4426950408889634f * y)); }
__device__ __forceinline__ float gelu_tanh(float x) { const float y = 1.5957691216057308f * (x + 0.044715f * x * x * x); return x * fast_sigmoid(y); }
__device__ __forceinline__ float silu_f(float x) { return x * fast_sigmoid(x); }

#define XB_TMO      128
#define XB_XCNT(j)  (256  + 64 * (j))
#define XB_XSUB(j)  (1280 + 64 * (j))
#define XB_XGEN(j)  (2304 + 64 * (j))
#define XB_TOP      3328
#define XB_TOPGEN   3392
#define XCD_BAR_WORDS 3456
#define XB_SPIN_CAP (1u << 18)

__device__ __forceinline__ unsigned xb_ld(unsigned* p)              { return __hip_atomic_load(p, __ATOMIC_RELAXED, __HIP_MEMORY_SCOPE_AGENT); }
__device__ __forceinline__ unsigned xb_add(unsigned* p, unsigned v) { return __hip_atomic_fetch_add(p, v, __ATOMIC_RELAXED, __HIP_MEMORY_SCOPE_AGENT); }
__device__ __forceinline__ unsigned xb_xcc_id() { return (unsigned)__builtin_amdgcn_s_getreg((3 << 11) | 20) & 0xFu; }
#define XB_SPIN(cond, bar) do { unsigned _sp = 0; while (cond) { __builtin_amdgcn_s_sleep(1); \
    if ((++_sp & 255u) == 0u) { if (xb_ld(&(bar)[XB_TMO])) break; if (_sp > XB_SPIN_CAP) { atomicAdd(&(bar)[XB_TMO], 1u); break; } } } } while (0)

struct XcdBarrier {
    unsigned* bar; unsigned x;
    volatile LAS unsigned* st;
};

__device__ __forceinline__ XcdBarrier xcd_barrier_post(unsigned* bar, volatile LAS unsigned* st) {
    XcdBarrier b; b.bar = bar; b.x = xb_xcc_id(); b.st = st;
    if (threadIdx.x == 0) (void)xb_add(&bar[XB_XCNT(b.x)], 1u);
    return b;
}
__device__ __forceinline__ void xcd_barrier_complete(unsigned* bar, unsigned x, unsigned& nloc, unsigned& nx) {
    const unsigned G = gridDim.x * gridDim.y * gridDim.z;
    unsigned sum, cnt, mine, sp = 0u;
    for (;;) {
        sum = 0u; cnt = 0u; mine = 0u;
#pragma unroll
        for (unsigned j = 0; j < 16; ++j) { const unsigned c = xb_ld(&bar[XB_XCNT(j)]); sum += c; cnt += (c > 0u) ? 1u : 0u; mine = (j == x) ? c : mine; }
        if (sum == G) break;
        __builtin_amdgcn_s_sleep(1);
        if ((++sp & 255u) == 0u) { if (xb_ld(&bar[XB_TMO])) break; if (sp > XB_SPIN_CAP) { atomicAdd(&bar[XB_TMO], 1u); break; } }
    }
    nloc = mine > 0u ? mine : 1u; nx = cnt > 0u ? cnt : 1u;
}

__device__ __forceinline__ void xcd_barrier(const XcdBarrier& b, const bool leader_thread) {
    asm volatile("s_waitcnt vmcnt(0)" ::: "memory");
    __syncthreads();
    if (leader_thread) {
        unsigned* bar = b.bar;
        __builtin_amdgcn_s_waitcnt(0);
        unsigned nloc = b.st[0], nx = b.st[1];
        if (nloc == 0u) { xcd_barrier_complete(bar, b.x, nloc, nx); b.st[0] = nloc; b.st[1] = nx; }
        const unsigned old = xb_add(&bar[XB_XSUB(b.x)], 1u);
        const unsigned gen = old / nloc;
        if (old + 1u == (gen + 1u) * nloc) {
            __builtin_amdgcn_fence(__ATOMIC_RELEASE, "agent");
            asm volatile("s_waitcnt vmcnt(0)" ::: "memory");
            const unsigned og = xb_add(&bar[XB_TOP], 1u);
            const unsigned tg = og / nx;
            if (og + 1u == (tg + 1u) * nx) xb_add(&bar[XB_TOPGEN], 1u);
            else XB_SPIN(xb_ld(&bar[XB_TOPGEN]) == tg, bar);
            __builtin_amdgcn_fence(__ATOMIC_ACQUIRE, "agent");
            xb_add(&bar[XB_XGEN(b.x)], 1u);
            asm volatile("s_waitcnt vmcnt(0)" ::: "memory");
        } else {
            XB_SPIN(xb_ld(&bar[XB_XGEN(b.x)]) == gen, bar);
            __builtin_amdgcn_fence(__ATOMIC_ACQUIRE, "agent");
            asm volatile("s_waitcnt vmcnt(0)" ::: "memory");
        }
    }
    __syncthreads();
}


namespace pg8 {
constexpr int BM = 256, BK = 64, HALF = 128, HTB = HALF * BK * 2, STAGE_BYTES = 8 * HTB;
__host__ __device__ __forceinline__ int lds_byte(int r, int c) { const int st = (r >> 4) * 2 + (c >> 5), rr = r & 15, cc = c & 31, ob = rr * 64 + cc * 2; return st * 1024 + (ob ^ (((ob >> 9) & 1) << 5)); }
__host__ __device__ __forceinline__ void stage_rc(int b, int& R, int& C) { const int st = b / 1024, sb = b % 1024, swz = sb ^ (((sb >> 9) & 1) << 5); R = (st >> 1) * 16 + swz / 64; C = (st & 1) * 32 + (swz % 64) / 2; }
__host__ __device__ __forceinline__ int perm32(int rho) { const int n = rho >> 4, i = rho & 15; return 8 * (i >> 2) + 4 * n + (i & 3); }

struct Unit { const char* A; const char* B; int pm, pn, seg; };

template <class Epi, class Sched>
__device__ __forceinline__ void gemm_phase(LAS unsigned char* lds, const int K, const int lda, const Sched& S, const Epi& E) {
    const int tid = tid_opaque(S.F.wave_s), wid = __builtin_amdgcn_readfirstlane(tid >> 6), lane = tid & 63, wr = wid >> 2, wc = wid & 3, fr = lane & 15, fq = lane >> 4;
    const int nt = K / BK;
    unsigned voffA[2], voffB[2];
#pragma unroll
    for (int i = 0; i < 2; ++i) { int R, C; stage_rc(tid * 16 + i * 8192, R, C); const int Rb = (R & ~31) + perm32(R & 31);
        voffA[i] = (unsigned)(R * lda + C) * 2u; voffB[i] = (unsigned)(Rb * K + C) * 2u; }
    const size_t kstep = (size_t)(BK * 2);
    const size_t hstepA = (size_t)HALF * lda * 2, hstepB = (size_t)HALF * K * 2;
    const unsigned ldsw = (unsigned)wid * 1024u;
    const int aoff = lds_byte(wr * 64 + fr, fq * 8), boff = lds_byte(wc * 32 + fr, fq * 8);
#define PG8_SA(b, h) (((b) * 2 + (h)) * HTB)
#define PG8_SB(b, h) ((4 + (b) * 2 + (h)) * HTB)
#define PG8_STAGE(bufoff, gbase, voff) do { _Pragma("unroll") for (int _i = 0; _i < 2; ++_i) \
        __builtin_amdgcn_global_load_lds((const unsigned*)((const char*)(gbase) + (voff)[_i]), (LAS unsigned*)(lds + (bufoff) + ldsw + _i * 8192), 16, 0, 0); } while (0)
#define PG8_LDA(dst, b, h) do { _Pragma("unroll") for (int m = 0; m < 4; ++m) _Pragma("unroll") for (int k = 0; k < 2; ++k) dst[m][k] = *(const LAS bf16x8*)(lds + PG8_SA(b, h) + aoff + m * 2048 + k * 1024); } while (0)
#define PG8_LDB(dst, b, h) do { _Pragma("unroll") for (int n = 0; n < 2; ++n) _Pragma("unroll") for (int k = 0; k < 2; ++k) dst[n][k] = *(const LAS bf16x8*)(lds + PG8_SB(b, h) + boff + n * 2048 + k * 1024); } while (0)
#define PG8_MMA(ai, bj, At, Bt) do { __builtin_amdgcn_s_setprio(1); _Pragma("unroll") for (int m = 0; m < 4; ++m) _Pragma("unroll") for (int n = 0; n < 2; ++n) _Pragma("unroll") for (int k = 0; k < 2; ++k) \
        acc[ai][bj][m][n] = __builtin_amdgcn_mfma_f32_16x16x32_bf16(Bt[n][k], At[m][k], acc[ai][bj][m][n], 0, 0, 0); __builtin_amdgcn_s_setprio(0); } while (0)
#define PG8_WAIT_V(n) asm volatile("s_waitcnt vmcnt(" #n ")" ::: "memory")
#define PG8_WAIT_L(n) asm volatile("s_waitcnt lgkmcnt(" #n ")" ::: "memory")
#define PG8_BAR __builtin_amdgcn_s_barrier()
#define PG8_SCHED __builtin_amdgcn_sched_barrier(0)
    Unit cur, nxt; int ui = 0;
    if (!S.next(0, cur)) return;
    f32x4 acc[2][2][4][2];
#pragma unroll
    for (int a = 0; a < 2; ++a)
#pragma unroll
        for (int b = 0; b < 2; ++b)
#pragma unroll
            for (int m = 0; m < 4; ++m)
#pragma unroll
                for (int n = 0; n < 2; ++n) acc[a][b][m][n] = (f32x4){0.f, 0.f, 0.f, 0.f};
    bf16x8 At[4][2], B0[2][2], B1[2][2];
    const char* cA = cur.A; const char* cB = cur.B;
    PG8_STAGE(PG8_SB(0, 0), cB, voffB); PG8_STAGE(PG8_SB(0, 1), cB + hstepB, voffB); PG8_STAGE(PG8_SA(0, 0), cA, voffA); PG8_STAGE(PG8_SA(0, 1), cA + hstepA, voffA);
    if (wr == 1) PG8_BAR;
    PG8_WAIT_V(2); PG8_BAR;
    PG8_STAGE(PG8_SB(1, 0), cB + kstep, voffB); PG8_STAGE(PG8_SA(1, 0), cA + kstep, voffA); PG8_STAGE(PG8_SB(1, 1), cB + hstepB + kstep, voffB);
    PG8_WAIT_V(6); PG8_BAR;
    for (;;) {
        const bool has_next = S.next(ui + 1, nxt);
        const char* nA = has_next ? nxt.A : cA; const char* nB = has_next ? nxt.B : cB;
        for (int t = 0; t < nt; t += 2) {
            const bool last = (t == nt - 2);
            const char* a1 = cA + (size_t)(t + 1) * kstep;
            const char* a2 = last ? nA : cA + (size_t)(t + 2) * kstep; const char* b2 = last ? nB : cB + (size_t)(t + 2) * kstep;
            const char* a3 = a2 + kstep; const char* b3 = b2 + kstep;
            PG8_LDB(B0, 0, 0); PG8_LDB(B1, 0, 1); PG8_SCHED; PG8_LDA(At, 0, 0); PG8_STAGE(PG8_SA(1, 1), a1 + hstepA, voffA);
            PG8_WAIT_V(8); PG8_WAIT_L(0); PG8_BAR; PG8_MMA(0, 0, At, B0); PG8_MMA(0, 1, At, B1); PG8_BAR; PG8_SCHED;
            PG8_LDA(At, 0, 1); PG8_STAGE(PG8_SB(0, 0), b2, voffB); PG8_STAGE(PG8_SB(0, 1), b2 + hstepB, voffB); PG8_STAGE(PG8_SA(0, 0), a2, voffA);
            PG8_WAIT_V(8); PG8_WAIT_L(0); PG8_BAR; PG8_MMA(1, 0, At, B0); PG8_MMA(1, 1, At, B1); PG8_BAR; PG8_SCHED;
            PG8_LDB(B0, 1, 0); PG8_LDB(B1, 1, 1); PG8_SCHED; PG8_LDA(At, 1, 0); PG8_STAGE(PG8_SA(0, 1), a2 + hstepA, voffA);
            PG8_WAIT_V(8); PG8_WAIT_L(0); PG8_BAR; PG8_MMA(0, 0, At, B0); PG8_MMA(0, 1, At, B1); PG8_BAR; PG8_SCHED;
            PG8_LDA(At, 1, 1); PG8_STAGE(PG8_SB(1, 0), b3, voffB); PG8_STAGE(PG8_SB(1, 1), b3 + hstepB, voffB); PG8_STAGE(PG8_SA(1, 0), a3, voffA);
            PG8_WAIT_V(8); PG8_WAIT_L(0); PG8_BAR; PG8_MMA(1, 0, At, B0); PG8_MMA(1, 1, At, B1); PG8_BAR; PG8_SCHED;
        }
        if (wr == 0) PG8_BAR;
        E(acc, cur, wr, wc, fr, fq);
        if (!has_next) break;
#pragma unroll
        for (int a = 0; a < 2; ++a)
#pragma unroll
            for (int b = 0; b < 2; ++b)
#pragma unroll
                for (int m = 0; m < 4; ++m)
#pragma unroll
                    for (int n = 0; n < 2; ++n) acc[a][b][m][n] = (f32x4){0.f, 0.f, 0.f, 0.f};
        cur = nxt; cA = nA; cB = nB; ++ui;
        if (wr == 1) PG8_BAR;
    }
    PG8_WAIT_V(0);
    PG8_BAR;
#undef PG8_SA
#undef PG8_SB
#undef PG8_STAGE
#undef PG8_LDA
#undef PG8_LDB
#undef PG8_MMA
#undef PG8_WAIT_V
#undef PG8_WAIT_L
#undef PG8_BAR
#undef PG8_SCHED
}
}

enum PhaseKind { K_P0 = 0, K_N1, K_G1, K_M1, K_A1, K_G2, K_G3, K_N2, K_G4, K_G5, K_FN };

struct Frame {
    const float* x; const float* cvec; const float* ctx; const float* cctx;
    float* out; unsigned char* ws;
    int vcu, G, l, c, kind, wave_s;
    __device__ __forceinline__ const bf16_t* W(size_t off) const { return (const bf16_t*)(ws + WS_W + (size_t)l * W_LAYER + off); }
    __device__ __forceinline__ bf16_t* Z() const { return (bf16_t*)(ws + WS_Z); }
    __device__ __forceinline__ bf16_t* H() const { return (bf16_t*)(ws + WS_H); }
    __device__ __forceinline__ bf16_t* Kb() const { return (bf16_t*)(ws + WS_K); }
    __device__ __forceinline__ bf16_t* Vb() const { return (bf16_t*)(ws + WS_V); }
    __device__ __forceinline__ float* XC() const { return (float*)(ws + WS_XC); }
    __device__ __forceinline__ const float* MOD(int b) const { return (const float*)(ws + WS_MOD) + (size_t)(l * 9 + b) * 6144; }
};

struct GSched {
    Frame F;
    __device__ __forceinline__ static void tile_map(int T, int nM, int nN, int& pm, int& pn) {
        const int nig = 8 * nN, gid = T / nig, fm = gid * 8, gsz = (nM - fm) < 8 ? (nM - fm) : 8, w = T % nig; pm = fm + w % gsz; pn = w / gsz;
    }
    __device__ __forceinline__ bool next(int i, pg8::Unit& u) const {
        const int kind = F.kind, l = F.l, c = F.c;
        if (kind == K_G1) {
            const int L = i * F.G + F.vcu, NL = 64 * 38, ncc = (l == 0) ? 38 : 6;
            if (L >= NL + 4 * ncc) return false;
            int lt, pn;
            if (L < NL) { tile_map(L, 64, 38, lt, pn); }
            else { const int q = L - NL; lt = 64 + (q & 3); const int ci = q >> 2; pn = (l == 0) ? ci : (ci < 2 ? 4 + ci : 16 + ci); }
            const size_t grow0 = lt < 64 ? (size_t)(64 * c + lt) * 256 : (size_t)LROWS + (size_t)(4 * c + lt - 64) * 256;
            u.A = (const char*)(F.H() + grow0 * DM); u.B = (const char*)(F.W(W_IN) + (size_t)pn * 256 * DM); u.pm = lt; u.pn = pn; u.seg = 0; return true;
        } else if (kind == K_G2) {
            const int T = (i / 3) * F.G + F.vcu, seg = i % 3, nM = 64;
            if (T >= nM * 4) return false;
            int lt, pn; tile_map(T, nM, 4, lt, pn);
            const int colA = seg == 0 ? CSX : (seg == 1 ? CSB : CSC);
            u.A = (const char*)(F.Z() + (size_t)lt * 256 * ZP + colA);
            u.B = (const char*)(F.W(seg == 0 ? W_AO : (seg == 1 ? W_SO : W_LO)) + (size_t)pn * 256 * DM); u.pm = lt; u.pn = pn; u.seg = seg; return true;
        } else if (kind == K_G3) {
            const int T = i * F.G + F.vcu, nM = 64;
            if (T >= nM * 4) return false;
            int lt, pn; tile_map(T, nM, 4, lt, pn);
            u.A = (const char*)(F.Z() + (size_t)lt * 256 * ZP + CQ); u.B = (const char*)(F.W(W_MO) + (size_t)pn * 256 * DM); u.pm = lt; u.pn = pn; u.seg = 0; return true;
        } else if (kind == K_G4) {
            const int T = i * F.G + F.vcu, nM = (l == 0) ? 136 : 128;
            if (T >= nM * 22) return false;
            int pm, pn; tile_map(T, nM, 22, pm, pn);
            u.A = (const char*)(F.H() + (size_t)pm * 256 * DM); u.B = (const char*)(F.W(W_F1) + (size_t)pn * 256 * DM); u.pm = pm; u.pn = pn; u.seg = 0; return true;
        } else {
            const int T = i * F.G + F.vcu, nM = 128;
            if (T >= nM * 4) return false;
            int pm, pn; tile_map(T, nM, 4, pm, pn);
            u.A = (const char*)(F.Z() + (size_t)pm * 256 * FFW); u.B = (const char*)(F.W(W_F2) + (size_t)pn * 256 * FFW); u.pm = pm; u.pn = pn; u.seg = 0; return true;
        }
    }
};

#ifndef EPI_MASK
#define EPI_MASK 30
#endif
#define EPI_EN(k) ((EPI_MASK >> (k)) & 1)
struct GEpi {
    Frame F;
    __device__ __forceinline__ void operator()(const f32x4 (&acc)[2][2][4][2], const pg8::Unit& u, int wr, int wc, int fr, int fq) const {
        const int kind = F.kind, l = F.l, c = F.c;
        asm volatile("" : "+v"(fr), "+v"(fq));
        const int row0 = wr * 64 + fr, col0 = wc * 32 + 8 * fq;
        if (EPI_EN(1) && kind == K_G1) {
            const int lt = u.pm, pn = u.pn;
            bf16_t* dst; int ldo;
            if (pn == 4 || pn == 5) { const int kvrow0 = lt < 64 ? (lt >> 4) * KVLEN + CTXL + (lt & 15) * 256 : (lt - 64) * KVLEN; dst = (pn == 4 ? F.Kb() : F.Vb()) + (size_t)kvrow0 * 256; ldo = 256; }
            else { dst = F.Z() + (size_t)lt * 256 * ZP + pn * 256; ldo = ZP; }
            const int act = pn >= 26 ? 2 : (pn >= 22 ? 1 : 0);
#pragma unroll
            for (int ai = 0; ai < 2; ++ai)
#pragma unroll
                for (int m = 0; m < 4; ++m) { bf16_t* rowp = dst + (size_t)(row0 + ai * 128 + m * 16) * ldo + col0;
#pragma unroll
                    for (int bj = 0; bj < 2; ++bj) { f32x4 v0 = acc[ai][bj][m][0], v1 = acc[ai][bj][m][1];
                        if (act == 1) { _Pragma("unroll") for (int e = 0; e < 4; ++e) { v0[e] = gelu_tanh(v0[e]); v1[e] = gelu_tanh(v1[e]); } }
                        else if (act == 2) { _Pragma("unroll") for (int e = 0; e < 4; ++e) { v0[e] = fast_sigmoid(v0[e]); v1[e] = fast_sigmoid(v1[e]); } }
                        u32x4 w; w.x = cvt_pk_bf16(v0[0], v0[1]); w.y = cvt_pk_bf16(v0[2], v0[3]); w.z = cvt_pk_bf16(v1[0], v1[1]); w.w = cvt_pk_bf16(v1[2], v1[3]);
                        *(u32x4*)(rowp + bj * 128) = w; } }
        } else if (EPI_EN(2) && kind == K_G2) {
            const int lt = u.pm, pn = u.pn, seg = u.seg;
            const bf16_t* gate = F.Z() + (size_t)lt * 256 * ZP + CGT + seg * 1024 + pn * 256;
            bf16_t* mg = F.Z() + (size_t)lt * 256 * ZP + CQ + pn * 256;
#pragma unroll
            for (int ai = 0; ai < 2; ++ai) {
                u32x4 gq[4][2], pq[4][2];
#pragma unroll
                for (int m = 0; m < 4; ++m)
#pragma unroll
                    for (int bj = 0; bj < 2; ++bj) { const size_t off = (size_t)(row0 + ai * 128 + m * 16) * ZP + col0 + bj * 128;
                        gq[m][bj] = *(const u32x4*)(gate + off); if (seg > 0) pq[m][bj] = *(const u32x4*)(mg + off); }
#pragma unroll
                for (int m = 0; m < 4; ++m)
#pragma unroll
                    for (int bj = 0; bj < 2; ++bj) { const size_t off = (size_t)(row0 + ai * 128 + m * 16) * ZP + col0 + bj * 128;
                        const u32x4 g = gq[m][bj]; const f32x4 a0 = acc[ai][bj][m][0], a1 = acc[ai][bj][m][1];
                        float v[8] = {a0[0] * bf_lo(g.x), a0[1] * bf_hi(g.x), a0[2] * bf_lo(g.y), a0[3] * bf_hi(g.y), a1[0] * bf_lo(g.z), a1[1] * bf_hi(g.z), a1[2] * bf_lo(g.w), a1[3] * bf_hi(g.w)};
                        if (seg > 0) { const u32x4 p = pq[m][bj];
                            v[0] += bf_lo(p.x); v[1] += bf_hi(p.x); v[2] += bf_lo(p.y); v[3] += bf_hi(p.y); v[4] += bf_lo(p.z); v[5] += bf_hi(p.z); v[6] += bf_lo(p.w); v[7] += bf_hi(p.w); }
                        u32x4 w; w.x = cvt_pk_bf16(v[0], v[1]); w.y = cvt_pk_bf16(v[2], v[3]); w.z = cvt_pk_bf16(v[4], v[5]); w.w = cvt_pk_bf16(v[6], v[7]);
                        *(u32x4*)(mg + off) = w; }
                asm volatile("" ::: "memory");
            }
        } else if (EPI_EN(3) && (kind == K_G3 || kind == K_G5)) {
            const int pn = u.pn; const bool g3 = (kind == K_G3);
            bool lat; size_t r0; int b;
            if (g3) { const int lt = u.pm; lat = lt < 64; r0 = lat ? (size_t)(64 * c + lt) * 256 : (size_t)(4 * c + lt - 64) * 256; b = lat ? 4 * c + (lt >> 4) : 8; }
            else { const int pm = u.pm; lat = pm < 128; r0 = lat ? (size_t)pm * 256 : (size_t)(pm - 128) * 256; b = lat ? (pm >> 4) : 8; }
            const float* base = lat ? ((g3 && l == 0) ? F.x : F.out) : ((g3 && l == 0) ? F.ctx : F.XC());
            float* fout = lat ? F.out : F.XC();
            base += r0 * DM + pn * 256; fout += r0 * DM + pn * 256;
            const float* vec = F.MOD(b) + (g3 ? 2048 : 5120) + pn * 256 + col0;
            f32x4 vv[2][2];
#pragma unroll
            for (int bj = 0; bj < 2; ++bj) { vv[bj][0] = *(const f32x4*)(vec + bj * 128); vv[bj][1] = *(const f32x4*)(vec + bj * 128 + 4); }
#pragma unroll
            for (int ai = 0; ai < 2; ++ai) {
                f32x4 bq0[4][2], bq1[4][2];
#pragma unroll
                for (int m = 0; m < 4; ++m)
#pragma unroll
                    for (int bj = 0; bj < 2; ++bj) { const size_t off = (size_t)(row0 + ai * 128 + m * 16) * DM + col0 + bj * 128;
                        bq0[m][bj] = *(const f32x4*)(base + off); bq1[m][bj] = *(const f32x4*)(base + off + 4); }
#pragma unroll
                for (int m = 0; m < 4; ++m)
#pragma unroll
                    for (int bj = 0; bj < 2; ++bj) { const size_t off = (size_t)(row0 + ai * 128 + m * 16) * DM + col0 + bj * 128;
                        *(f32x4*)(fout + off) = bq0[m][bj] + vv[bj][0] * acc[ai][bj][m][0]; *(f32x4*)(fout + off + 4) = bq1[m][bj] + vv[bj][1] * acc[ai][bj][m][1]; }
                asm volatile("" ::: "memory");
            }
        } else if (EPI_EN(4)) {
            bf16_t* dst = F.Z() + (size_t)u.pm * 256 * FFW + u.pn * 128;
#pragma unroll
            for (int ai = 0; ai < 2; ++ai)
#pragma unroll
                for (int m = 0; m < 4; ++m) { bf16_t* rowp = dst + (size_t)(row0 + ai * 128 + m * 16) * FFW + col0;
                    const f32x4 g0 = acc[ai][0][m][0], g1 = acc[ai][0][m][1], u0 = acc[ai][1][m][0], u1 = acc[ai][1][m][1];
                    u32x4 w; w.x = cvt_pk_bf16(silu_f(g0[0]) * u0[0], silu_f(g0[1]) * u0[1]); w.y = cvt_pk_bf16(silu_f(g0[2]) * u0[2], silu_f(g0[3]) * u0[3]);
                    w.z = cvt_pk_bf16(silu_f(g1[0]) * u1[0], silu_f(g1[1]) * u1[1]); w.w = cvt_pk_bf16(silu_f(g1[2]) * u1[2], silu_f(g1[3]) * u1[3]);
                    *(u32x4*)rowp = w; }
        }
    }
};

namespace att {
constexpr int D = 128, NW = 8, QBLK = 32, KVBLK = 64;
constexpr float SCALE = 0.088388347648318440f;
constexpr float THR = 8.f;
constexpr int LDQ = ZP, LDK = 256, LDO = ZP;
constexpr size_t SHM_V = KVBLK * D * 2, SHM_K = KVBLK * D * 2, SHM_ATTN = 2 * SHM_V + 2 * SHM_K + NW * 64 * 4;
constexpr int OST_OFF = (int)SHM_ATTN;
static_assert(SHM_ATTN + NW * 32 * 272 <= MISC_OFF, "attention lds");
#define KSWZ(row, colB) ((row) * 256 + ((colB) ^ (((row) & 7) << 4)))
#define SBAR() __builtin_amdgcn_sched_barrier(0)
__device__ __forceinline__ int crow(int r, int hi) { return (r & 3) + 8 * (r >> 2) + 4 * hi; }
__device__ __forceinline__ void partialSM(f32x16& p0, f32x16& p1, float& m_reg, float& mn, float& alpha) {
  constexpr float C = SCALE * 1.4426950408889634f;
  float pmax = p0[0]; for (int r = 1; r < 16; ++r) pmax = fmaxf(pmax, p0[r]); for (int r = 0; r < 16; ++r) pmax = fmaxf(pmax, p1[r]);
  { auto rr = __builtin_amdgcn_permlane32_swap(__float_as_uint(pmax), __float_as_uint(pmax), false, false);
    pmax = fmaxf(__uint_as_float(rr[0]), __uint_as_float(rr[1])); }
  if (__builtin_expect(__all(pmax - m_reg <= THR / SCALE), 1)) { mn = m_reg; alpha = 1.f; }
  else { mn = fmaxf(m_reg, pmax); alpha = __builtin_amdgcn_exp2f((m_reg - mn) * C); m_reg = mn; }
  float mnC = -mn * C;
  for (int r = 0; r < 16; ++r) p0[r] = fmaf(p0[r], C, mnC); for (int r = 0; r < 16; ++r) p1[r] = fmaf(p1[r], C, mnC);
  for (int r = 0; r < 16; ++r) p0[r] = __builtin_amdgcn_exp2f(p0[r]);
}
__device__ __forceinline__ void finishSM(f32x16& p0, f32x16& p1, float alpha, float& l_reg, bf16x8& pa0, bf16x8& pa1, bf16x8& pa2, bf16x8& pa3) {
  for (int r = 0; r < 16; ++r) p1[r] = __builtin_amdgcn_exp2f(p1[r]);
  float ps = 0; for (int r = 0; r < 16; ++r) ps += p0[r]; for (int r = 0; r < 16; ++r) ps += p1[r];
  { auto rr = __builtin_amdgcn_permlane32_swap(__float_as_uint(ps), __float_as_uint(ps), false, false);
    ps = __uint_as_float(rr[0]) + __uint_as_float(rr[1]); }
  l_reg = l_reg * alpha + ps;
#define PK4(P, BASE, OUT) do { unsigned a0 = cvt_pk_bf16(P[BASE + 0], P[BASE + 1]), a1 = cvt_pk_bf16(P[BASE + 2], P[BASE + 3]);   \
    unsigned b0 = cvt_pk_bf16(P[BASE + 4], P[BASE + 5]), b1 = cvt_pk_bf16(P[BASE + 6], P[BASE + 7]);                              \
    auto r0 = __builtin_amdgcn_permlane32_swap(a0, b0, false, false); auto r1 = __builtin_amdgcn_permlane32_swap(a1, b1, false, false); \
    u32x4 w = {r0[0], r1[0], r0[1], r1[1]}; OUT = *reinterpret_cast<bf16x8*>(&w); } while (0)
  PK4(p0, 0, pa0); PK4(p0, 8, pa1); PK4(p1, 0, pa2); PK4(p1, 8, pa3);
#undef PK4
}
__device__ __forceinline__ void qkt(f32x16& p0, f32x16& p1, const bf16_t* Ks, const bf16x8* qr, int r32, int hi) {
  p0 = f32x16{}; p1 = f32x16{};
#pragma unroll
  for (int d0 = 0; d0 < 8; ++d0) { int cb = (d0 * 16 + hi * 8) * 2;
    bf16x8 b0 = *reinterpret_cast<const bf16x8*>((const char*)Ks + KSWZ(r32, cb));
    bf16x8 b1 = *reinterpret_cast<const bf16x8*>((const char*)Ks + KSWZ(32 + r32, cb));
    p0 = __builtin_amdgcn_mfma_f32_32x32x16_bf16(b0, qr[d0], p0, 0, 0, 0);
    p1 = __builtin_amdgcn_mfma_f32_32x32x16_bf16(b1, qr[d0], p1, 0, 0, 0); }
}
__device__ __forceinline__ int v_st(int k, int c) { const int kk = (k & ~0xC) | ((k & 4) << 1) | ((k & 8) >> 1); return ((kk >> 3) * 4 + (c >> 5)) * 512 + ((kk & 7) * 32 + (c & 31)) * 2; }
__device__ __forceinline__ int v_rd_base(int lane) { return ((lane & 3) << 3) | (((lane >> 2) & 3) << 6) | (((lane >> 4) & 1) << 5) | (((lane >> 5) & 1) << 8); }
constexpr int v_rd_off(int d0, int ks, int half) { return d0 * 512 + ks * 4096 + half * 2048; }
template <int OFF> __device__ __forceinline__ s16x4 tr_read(int vb) {
  s16x4 r; asm volatile("ds_read_b64_tr_b16 %0, %1 offset:%2" : "=&v"(r) : "v"(vb), "i"(OFF) : "memory"); return r;
}
template <int D0> __device__ __forceinline__ void pv_one(f32x16& od, int vb, bf16x8 pa0, bf16x8 pa1, bf16x8 pa2, bf16x8 pa3) {
  const s16x4 l0 = tr_read<v_rd_off(D0, 0, 0)>(vb), h0 = tr_read<v_rd_off(D0, 0, 1)>(vb), l1 = tr_read<v_rd_off(D0, 1, 0)>(vb), h1 = tr_read<v_rd_off(D0, 1, 1)>(vb);
  const s16x4 l2 = tr_read<v_rd_off(D0, 2, 0)>(vb), h2 = tr_read<v_rd_off(D0, 2, 1)>(vb), l3 = tr_read<v_rd_off(D0, 3, 0)>(vb), h3 = tr_read<v_rd_off(D0, 3, 1)>(vb);
  asm volatile("s_waitcnt lgkmcnt(0)" ::: "memory"); SBAR();
#define PK(L, H) (bf16x8){L[0], L[1], L[2], L[3], H[0], H[1], H[2], H[3]}
  od = __builtin_amdgcn_mfma_f32_32x32x16_bf16(pa0, PK(l0, h0), od, 0, 0, 0);
  od = __builtin_amdgcn_mfma_f32_32x32x16_bf16(pa1, PK(l1, h1), od, 0, 0, 0);
  od = __builtin_amdgcn_mfma_f32_32x32x16_bf16(pa2, PK(l2, h2), od, 0, 0, 0);
  od = __builtin_amdgcn_mfma_f32_32x32x16_bf16(pa3, PK(l3, h3), od, 0, 0, 0);
#undef PK
}
__device__ __forceinline__ void pv_d0(f32x16* o, int vb, bf16x8 pa0, bf16x8 pa1, bf16x8 pa2, bf16x8 pa3) {
  pv_one<0>(o[0], vb, pa0, pa1, pa2, pa3); pv_one<1>(o[1], vb, pa0, pa1, pa2, pa3); pv_one<2>(o[2], vb, pa0, pa1, pa2, pa3); pv_one<3>(o[3], vb, pa0, pa1, pa2, pa3);
}
__device__ __forceinline__ void attn_dense_body(const bf16_t* Qb, const bf16_t* __restrict__ Kh, const bf16_t* __restrict__ Vh, bf16_t* Ob, int seq, char* lds, int wave_s) {
  const int tid = tid_opaque(wave_s), wid = __builtin_amdgcn_readfirstlane(tid >> 6), lane = tid & 63, r32 = lane & 31, hi = lane >> 5;
  bf16_t* V_lds = (bf16_t*)lds; bf16_t* K_lds = (bf16_t*)(lds + 2 * SHM_V);
  float* ws = (float*)(lds + 2 * SHM_V + 2 * SHM_K) + wid * 64; float* li_l = ws; float* al_l = ws + 32;
  float m_reg = -1e30f, l_reg = 0; f32x16 o[4] = {}; bf16x8 qr[8];
  const bf16_t* Qw = Qb + (long)(wid * QBLK + r32) * LDQ + hi * 8;
#pragma unroll
  for (int d0 = 0; d0 < 8; ++d0) qr[d0] = *reinterpret_cast<const bf16x8*>(Qw + d0 * 16);
  const int sr = tid >> 4, sc = (tid & 15) * 8, vst0 = v_st(sr, sc), vst1 = v_st(32 + sr, sc);
  const int vb0 = (int)(uintptr_t)V_lds + v_rd_base(lane);
  struct { bf16x8 vs0, vs1, ks0, ks1; } sr_[2];
#define SLOAD(i, k0) do { sr_[i].vs0 = *reinterpret_cast<const bf16x8*>(&Vh[(long)((k0) + sr) * LDK + sc]); sr_[i].vs1 = *reinterpret_cast<const bf16x8*>(&Vh[(long)((k0) + 32 + sr) * LDK + sc]); \
    sr_[i].ks0 = *reinterpret_cast<const bf16x8*>(&Kh[(long)((k0) + sr) * LDK + sc]); sr_[i].ks1 = *reinterpret_cast<const bf16x8*>(&Kh[(long)((k0) + 32 + sr) * LDK + sc]); } while (0)
#define SWRITE(b, i) do { *(bf16x8*)((char*)V_lds + (b) * SHM_V + vst0) = sr_[i].vs0;          \
    *(bf16x8*)((char*)V_lds + (b) * SHM_V + vst1) = sr_[i].vs1; int kc = sc * 2;               \
    *(bf16x8*)((char*)K_lds + (b) * SHM_K + KSWZ(sr, kc)) = sr_[i].ks0;                       \
    *(bf16x8*)((char*)K_lds + (b) * SHM_K + KSWZ(32 + sr, kc)) = sr_[i].ks1; } while (0)
#define SWAIT() asm volatile("s_waitcnt vmcnt(4)" ::: "memory")
#define RESC(a) do { if (__any((a) < 1.f)) { if (hi == 0) al_l[r32] = (a); asm volatile("s_waitcnt lgkmcnt(0)" ::: "memory"); \
    for (int d = 0; d < 4; ++d) for (int r = 0; r < 16; ++r) o[d][r] *= al_l[crow(r, hi)]; } } while (0)
  f32x16 pA0, pA1, pB0, pB1; float mnA, mnB, alA, alB; bf16x8 pa0, pa1, pa2, pa3; const int NT = seq / KVBLK;
  constexpr int SE = 0, SO = 1;
  SLOAD(SE, 0); asm volatile("s_waitcnt vmcnt(0)" ::: "memory"); SWRITE(0, SE); __syncthreads();
  qkt(pA0, pA1, K_lds, qr, r32, hi); partialSM(pA0, pA1, m_reg, mnA, alA);
  SLOAD(SO, KVBLK); if (2 < NT) SLOAD(SE, 2 * KVBLK);
  SWAIT(); SWRITE(1, SO); __syncthreads();
  for (int j = 1; j + 1 < NT; j += 2) {
    SBAR(); qkt(pB0, pB1, (bf16_t*)((char*)K_lds + SHM_K), qr, r32, hi);
    finishSM(pA0, pA1, alA, l_reg, pa0, pa1, pa2, pa3); SBAR();
    SLOAD(SO, (j + 2) * KVBLK); SBAR();
    pv_d0(o, vb0, pa0, pa1, pa2, pa3); partialSM(pB0, pB1, m_reg, mnB, alB);
    __syncthreads(); SWAIT(); SWRITE(0, SE);
    RESC(alB); __syncthreads();
    SBAR(); qkt(pA0, pA1, K_lds, qr, r32, hi);
    finishSM(pB0, pB1, alB, l_reg, pa0, pa1, pa2, pa3); SBAR();
    if (j + 3 < NT) SLOAD(SE, (j + 3) * KVBLK); SBAR();
    pv_d0(o, vb0 + (int)SHM_V, pa0, pa1, pa2, pa3); partialSM(pA0, pA1, m_reg, mnA, alA);
    __syncthreads(); SWAIT(); SWRITE(1, SO);
    RESC(alA); __syncthreads();
  }
  SBAR(); qkt(pB0, pB1, (bf16_t*)((char*)K_lds + SHM_K), qr, r32, hi);
  finishSM(pA0, pA1, alA, l_reg, pa0, pa1, pa2, pa3); SBAR();
  pv_d0(o, vb0, pa0, pa1, pa2, pa3); partialSM(pB0, pB1, m_reg, mnB, alB);
  __syncthreads(); RESC(alB);
  finishSM(pB0, pB1, alB, l_reg, pa0, pa1, pa2, pa3); SBAR();
  pv_d0(o, vb0 + (int)SHM_V, pa0, pa1, pa2, pa3);
  if (hi == 0) li_l[r32] = l_reg; asm volatile("s_waitcnt lgkmcnt(0)" ::: "memory");
  float rli[16];
#pragma unroll
  for (int r = 0; r < 16; ++r) rli[r] = __builtin_amdgcn_rcpf(li_l[crow(r, hi)]);
  bf16_t* Ow = Ob + (long)(wid * QBLK) * LDO;
  {
    bf16_t* stg = (bf16_t*)(lds + OST_OFF) + wid * (32 * 136);
#pragma unroll
    for (int r = 0; r < 16; ++r) { const int orow = crow(r, hi);
#pragma unroll
      for (int d0 = 0; d0 < 4; ++d0) { const float v = o[d0][r] * rli[r]; stg[orow * 136 + d0 * 32 + r32] = (bf16_t)(cvtpk_nv(v, v) & 0xffffu); } }
    asm volatile("s_waitcnt lgkmcnt(0)" ::: "memory");
#pragma unroll
    for (int i = 0; i < 8; ++i) { const int row = i * 4 + (lane >> 4), chn = lane & 15; const u32x4 v = *(const u32x4*)(stg + row * 136 + chn * 8); *(u32x4*)(Ow + (long)row * LDO + chn * 8) = v; }
  }
  __syncthreads();
#undef SLOAD
#undef SWRITE
#undef SWAIT
#undef RESC
}
#undef KSWZ
#undef SBAR
}

__device__ __forceinline__ void p0_transpose_item(const float* W, int K, int N, bf16_t* WT, int mode, LAS float* scr, int item, int lane) {
    const int nblk = N / 32, kb = item / nblk, nb = item % nblk, k0 = 64 * kb, n0 = 32 * nb;
    const float wscale = (mode == 2) ? -1.4426950408889634f : 1.0f;
#pragma unroll 8
    for (int i = 0; i < 32; ++i) { const int kk = 2 * i + (lane >> 5); scr[kk * 33 + (lane & 31)] = W[(size_t)(k0 + kk) * N + n0 + (lane & 31)] * wscale; }
    asm volatile("s_waitcnt lgkmcnt(0)" ::: "memory");
    int r0 = n0;
    if (mode == 1) r0 = n0 < FFW ? 256 * (n0 / 128) + (n0 % 128) : 256 * ((n0 - FFW) / 128) + 128 + ((n0 - FFW) % 128);
    const int c = lane & 7;
#pragma unroll
    for (int j = 0; j < 4; ++j) { const int n = (lane >> 3) + 8 * j; const LAS float* s = scr + (8 * c) * 33 + n;
        u32x4 o; o.x = cvt_pk_bf16(s[0 * 33], s[1 * 33]); o.y = cvt_pk_bf16(s[2 * 33], s[3 * 33]); o.z = cvt_pk_bf16(s[4 * 33], s[5 * 33]); o.w = cvt_pk_bf16(s[6 * 33], s[7 * 33]);
        *(u32x4*)(WT + (size_t)(r0 + n) * K + k0 + 8 * c) = o; }
    asm volatile("s_waitcnt lgkmcnt(0)" ::: "memory");
}

__device__ __forceinline__ void phase_p0(CArgs a, const Frame& F, LAS unsigned char* lds) {
    const int tid = tid_opaque(F.wave_s), lane = tid & 63, wave = __builtin_amdgcn_readfirstlane(tid >> 6);
    for (int it = bid_opaque(); it < 96; it += gridDim.x) {
        const int l = it / 48, cg0 = (it % 48) * 128;
        LAS float* sv = (LAS float*)lds;
        LAS float* red = (LAS float*)(lds + 9 * 1024 * 4);
        for (int e = tid; e < 9 * 1024; e += NTHREADS) { const int b = e >> 10, k = e & 1023; const float v = b < 8 ? a->in[1][b * 1024 + k] : a->in[3][k]; sv[e] = v * fast_sigmoid(v); }
        __syncthreads();
        const int kq = tid >> 7, col = tid & 127;
        float accv[9];
#pragma unroll
        for (int b = 0; b < 9; ++b) accv[b] = 0.f;
        const float* wp = a->in[4] + ((size_t)l * 1024 + kq * 256) * 6144 + cg0 + col;
#pragma unroll 4
        for (int k = 0; k < 256; ++k) { const float w = wp[(size_t)k * 6144];
#pragma unroll
            for (int b = 0; b < 9; ++b) accv[b] += sv[b * 1024 + kq * 256 + k] * w; }
#pragma unroll
        for (int b = 0; b < 9; ++b) red[(kq * 9 + b) * 128 + col] = accv[b];
        __syncthreads();
        if (tid < 128) {
#pragma unroll
            for (int b = 0; b < 9; ++b) { const float s = red[(0 * 9 + b) * 128 + tid] + red[(1 * 9 + b) * 128 + tid] + red[(2 * 9 + b) * 128 + tid] + red[(3 * 9 + b) * 128 + tid];
                ((float*)(a->ws + WS_MOD))[(size_t)(l * 9 + b) * 6144 + cg0 + tid] = s + a->in[5][l * 6144 + cg0 + tid]; }
        }
        __syncthreads();
    }
    if (bid_opaque() == gridDim.x - 1) {
        for (int e = tid; e < 2048; e += NTHREADS) { const int pos = e >> 5, f = e & 31; const float inv = __builtin_amdgcn_exp2f(-(float)f * (13.287712379549449f / 32.0f)); const float rev = (float)pos * inv * 0.15915494309189535f;
            const float fr_ = rev - floorf(rev);
            ((f32x2*)(a->ws + WS_ROPE))[e] = (f32x2){__builtin_amdgcn_cosf(fr_), __builtin_amdgcn_sinf(fr_)}; }
    }
    LAS float* scr = (LAS float*)(lds + 57344 + wave * 8704);
    const int gw = bid_opaque() * NWAVES + wave, NGW = gridDim.x * NWAVES;
    constexpr int I_IN = 16 * 304, I_SQ = 16 * 32, I_F1 = 16 * 176, I_F2 = 44 * 32, I_LRU = 256, I_LAYER = I_IN + 4 * I_SQ + I_F1 + I_F2 + I_LRU;
    for (int it = gw; it < 2 * I_LAYER; it += NGW) {
        const int l = it / I_LAYER; int r = it % I_LAYER;
        unsigned char* wl = a->ws + WS_W + (size_t)l * W_LAYER;
        if (r < I_IN) { p0_transpose_item(a->in[8] + (size_t)l * DM * NIN, DM, NIN, (bf16_t*)(wl + W_IN), 0, scr, r, lane); continue; } r -= I_IN;
        if (r < I_SQ) { p0_transpose_item(a->in[11] + (size_t)l * DM * DM, DM, DM, (bf16_t*)(wl + W_AO), 0, scr, r, lane); continue; } r -= I_SQ;
        if (r < I_SQ) { p0_transpose_item(a->in[14] + (size_t)l * DM * DM, DM, DM, (bf16_t*)(wl + W_SO), 0, scr, r, lane); continue; } r -= I_SQ;
        if (r < I_SQ) { p0_transpose_item(a->in[22] + (size_t)l * DM * DM, DM, DM, (bf16_t*)(wl + W_LO), 0, scr, r, lane); continue; } r -= I_SQ;
        if (r < I_SQ) { p0_transpose_item(a->in[23] + (size_t)l * DM * DM, DM, DM, (bf16_t*)(wl + W_MO), 0, scr, r, lane); continue; } r -= I_SQ;
        if (r < I_F1) { p0_transpose_item(a->in[24] + (size_t)l * DM * 2 * FFW, DM, 2 * FFW, (bf16_t*)(wl + W_F1), 1, scr, r, lane); continue; } r -= I_F1;
        if (r < I_F2) { p0_transpose_item(a->in[25] + (size_t)l * FFW * DM, FFW, DM, (bf16_t*)(wl + W_F2), 0, scr, r, lane); continue; } r -= I_F2;
        { const int mat = r >> 3, d = mat >> 4, g = (mat >> 3) & 1, n = mat & 7;
          const float* src = (g == 0 ? a->in[17] : a->in[19]) + (size_t)((l * 2 + d) * 8 + n) * 16384;
          p0_transpose_item(src, 128, 128, (bf16_t*)(wl + W_LRU) + (size_t)((d * 2 + g) * 8 + n) * 16384, 2, scr, r & 7, lane); }
    }
}

__device__ __forceinline__ void phase_norm(CArgs a, const Frame& F, int which) {
    const int tid_ = tid_opaque(F.wave_s); const int lane = tid_ & 63, wave = __builtin_amdgcn_readfirstlane(tid_ >> 6);
    const int gw = bid_opaque() * NWAVES + wave, NGW = gridDim.x * NWAVES;
    const bool first = (which == 0 && F.l == 0);
    const int nrows = (which == 1 && F.l == 1) ? LROWS : ROWS;
    const float* g = (which == 0 ? a->in[6] : a->in[7]) + F.l * DM;
    for (int m = gw; m < nrows; m += NGW) {
        const bool lat = m < LROWS;
        const float* src = lat ? (first ? F.x : F.out) + (size_t)m * DM : (first ? F.ctx : F.XC()) + (size_t)(m - LROWS) * DM;
        const int b = lat ? (m >> 12) : 8;
        const float* md = F.MOD(b) + (which == 0 ? 0 : 3072);
        f32x4 v[4]; float s = 0.f;
#pragma unroll
        for (int j = 0; j < 4; ++j) { v[j] = *(const f32x4*)(src + 4 * lane + 256 * j); s += (v[j].x * v[j].x + v[j].y * v[j].y) + (v[j].z * v[j].z + v[j].w * v[j].w); }
        const float rstd = rsqrtf(wave_sum(s) * (1.f / DM) + EPS);
        bf16_t* dst = F.H() + (size_t)m * DM;
#pragma unroll
        for (int j = 0; j < 4; ++j) { const int col = 4 * lane + 256 * j;
            const f32x4 gg = *(const f32x4*)(g + col), sh = *(const f32x4*)(md + col), sc = *(const f32x4*)(md + 1024 + col);
            const f32x4 h = (v[j] * rstd * gg) * (sc + 1.0f) + sh;
            u32x2 w; w.x = cvt_pk_bf16(h.x, h.y); w.y = cvt_pk_bf16(h.z, h.w); *(u32x2*)(dst + col) = w; }
    }
}
__device__ __forceinline__ void phase_final(CArgs a, const Frame& F) {
    const int tid_ = tid_opaque(F.wave_s); const int lane = tid_ & 63, wave = __builtin_amdgcn_readfirstlane(tid_ >> 6);
    const int gw = bid_opaque() * NWAVES + wave, NGW = gridDim.x * NWAVES;
    const float* g = a->in[26];
    for (int m = gw; m < LROWS; m += NGW) {
        float* p = F.out + (size_t)m * DM;
        f32x4 v[4]; float s = 0.f;
#pragma unroll
        for (int j = 0; j < 4; ++j) { v[j] = *(const f32x4*)(p + 4 * lane + 256 * j); s += (v[j].x * v[j].x + v[j].y * v[j].y) + (v[j].z * v[j].z + v[j].w * v[j].w); }
        const float rstd = rsqrtf(wave_sum(s) * (1.f / DM) + EPS);
#pragma unroll
        for (int j = 0; j < 4; ++j) { const int col = 4 * lane + 256 * j; *(f32x4*)(p + col) = v[j] * rstd * *(const f32x4*)(g + col); }
    }
}

struct QkRow { u32x4 raw[3]; bf16_t* p[3]; bool act[3]; bool lat; int pos; };
__device__ __forceinline__ void qk_load(const Frame& F, int lr, int s, int i, int qd, QkRow& R) {
    const bool lat = lr < CH_L; R.lat = lat;
    int kvrow, prow = 0, pcol = 0;
    if (lat) { const int bl = lr >> 12, t = lr & 4095; kvrow = bl * KVLEN + CTXL + t; prow = t >> 6; pcol = t & 63; }
    else { const int lc = lr - CH_L; kvrow = (lc >> 8) * KVLEN + (lc & 255); }
    R.pos = qd < 2 ? prow : pcol;
#pragma unroll
    for (int it = 0; it < 3; ++it) { const int hs = 4 * it + s;
        R.act[it] = hs < 10 && (lat || F.l == 0 || it == 2) && lr < CH_ROWS;
        R.p[it] = hs < 8 ? F.Z() + (size_t)lr * ZP + hs * 128 + 8 * i : F.Kb() + (size_t)kvrow * 256 + (hs - 8) * 128 + 8 * i;
        if (R.act[it]) R.raw[it] = *(const u32x4*)R.p[it]; }
}
__device__ __forceinline__ void qk_finish(const Frame& F, const float* qg, const float* kg, const f32x2* rope, int s, int i, int qd, const QkRow& R) {
#pragma unroll
    for (int it = 0; it < 3; ++it) {
        if (R.act[it]) {
            const int hs = 4 * it + s; const float* gp = hs < 8 ? qg : kg; const u32x4 raw = R.raw[it];
            float v[8] = {bf_lo(raw.x), bf_hi(raw.x), bf_lo(raw.y), bf_hi(raw.y), bf_lo(raw.z), bf_hi(raw.z), bf_lo(raw.w), bf_hi(raw.w)};
            float ss = 0.f;
#pragma unroll
            for (int e = 0; e < 8; ++e) ss += v[e] * v[e];
            ss += swz_xor<1>(ss); ss += swz_xor<2>(ss); ss += swz_xor<4>(ss); ss += swz_xor<8>(ss);
            const float rstd = rsqrtf(ss * (1.f / 128.f) + EPS);
            const f32x4 g0 = *(const f32x4*)gp, g1 = *(const f32x4*)(gp + 4);
            v[0] *= rstd * g0.x; v[1] *= rstd * g0.y; v[2] *= rstd * g0.z; v[3] *= rstd * g0.w; v[4] *= rstd * g1.x; v[5] *= rstd * g1.y; v[6] *= rstd * g1.z; v[7] *= rstd * g1.w;
            if (R.lat) {
                const f32x2* rp = rope + R.pos * 32 + 8 * (i & 3);
#pragma unroll
                for (int e = 0; e < 8; ++e) { const float pv = swz_xor<4>(v[e]); const f32x2 cs = rp[e]; v[e] = (qd & 1) ? v[e] * cs.x + pv * cs.y : v[e] * cs.x - pv * cs.y; }
            }
            u32x4 w; w.x = cvt_pk_bf16(v[0], v[1]); w.y = cvt_pk_bf16(v[2], v[3]); w.z = cvt_pk_bf16(v[4], v[5]); w.w = cvt_pk_bf16(v[6], v[7]);
            *(u32x4*)R.p[it] = w;
        }
    }
}
__device__ __forceinline__ void phase_qknorm(CArgs a, const Frame& F) {
    const int tid_ = tid_opaque(F.wave_s); const int lane = tid_ & 63, wave = __builtin_amdgcn_readfirstlane(tid_ >> 6);
    const int gw = bid_opaque() * NWAVES + wave, NGW = gridDim.x * NWAVES;
    const int s = lane >> 4, i = lane & 15, qd = i >> 2;
    const float* qg = a->in[9] + F.l * 128 + 8 * i; const float* kg = a->in[10] + F.l * 128 + 8 * i;
    const f32x2* rope = (const f32x2*)(F.ws + WS_ROPE);
    for (int lr = gw; lr < CH_ROWS; lr += 2 * NGW) {
        QkRow R0, R1;
        qk_load(F, lr, s, i, qd, R0); qk_load(F, lr + NGW, s, i, qd, R1);
        qk_finish(F, qg, kg, rope, s, i, qd, R0); qk_finish(F, qg, kg, rope, s, i, qd, R1);
    }
}

__device__ __forceinline__ void phase_sconv(CArgs a, const Frame& F) {
    const int tid_ = tid_opaque(F.wave_s); const int lane = tid_ & 63, wave = __builtin_amdgcn_readfirstlane(tid_ >> 6);
    const int gw = bid_opaque() * NWAVES + wave, NGW = gridDim.x * NWAVES;
    const int nrows = (F.l == 0) ? CH_ROWS : CH_L;
    const float* wsc = a->in[12] + (size_t)F.l * 3 * DM; const float* bsc = a->in[13] + (size_t)F.l * DM;
    for (int it = gw; it < (nrows / 16) * 2; it += NGW) {
        const int run = it >> 1, ch0 = (it & 1) * 512 + lane * 8, lr0 = run * 16;
        int t0, slen;
        if (lr0 < CH_L) { t0 = lr0 & 4095; slen = SEQ; } else { t0 = (lr0 - CH_L) & 255; slen = CTXL; }
        float w0[8], w1[8], w2[8], bb[8];
#pragma unroll
        for (int e = 0; e < 8; ++e) { w0[e] = wsc[ch0 + e]; w1[e] = wsc[DM + ch0 + e]; w2[e] = wsc[2 * DM + ch0 + e]; bb[e] = bsc[ch0 + e]; }
        bf16_t* zr = F.Z() + (size_t)lr0 * ZP + ch0;
        float up[8], uc[8], un[8];
        auto loadu = [&](int dt, float* u, bool valid) {
            if (valid) { const u32x4 cc = *(const u32x4*)(zr + (long)dt * ZP + CSC), xx = *(const u32x4*)(zr + (long)dt * ZP + CSX);
                u[0] = bf_lo(cc.x) * bf_lo(xx.x); u[1] = bf_hi(cc.x) * bf_hi(xx.x); u[2] = bf_lo(cc.y) * bf_lo(xx.y); u[3] = bf_hi(cc.y) * bf_hi(xx.y);
                u[4] = bf_lo(cc.z) * bf_lo(xx.z); u[5] = bf_hi(cc.z) * bf_hi(xx.z); u[6] = bf_lo(cc.w) * bf_lo(xx.w); u[7] = bf_hi(cc.w) * bf_hi(xx.w); }
            else {
#pragma unroll
                for (int e = 0; e < 8; ++e) u[e] = 0.f; } };
        loadu(-1, up, t0 > 0); loadu(0, uc, true);
#pragma unroll 8
        for (int tt = 0; tt < 16; ++tt) {
            loadu(tt + 1, un, t0 + tt + 1 < slen);
            const u32x4 bq = *(const u32x4*)(zr + (long)tt * ZP + CSB);
            const float bv[8] = {bf_lo(bq.x), bf_hi(bq.x), bf_lo(bq.y), bf_hi(bq.y), bf_lo(bq.z), bf_hi(bq.z), bf_lo(bq.w), bf_hi(bq.w)};
            float o[8];
#pragma unroll
            for (int e = 0; e < 8; ++e) { o[e] = bv[e] * (bb[e] + w0[e] * up[e] + w1[e] * uc[e] + w2[e] * un[e]); up[e] = uc[e]; uc[e] = un[e]; }
            u32x4 w; w.x = cvt_pk_bf16(o[0], o[1]); w.y = cvt_pk_bf16(o[2], o[3]); w.z = cvt_pk_bf16(o[4], o[5]); w.w = cvt_pk_bf16(o[6], o[7]);
            *(u32x4*)(zr + (long)tt * ZP + CSB) = w;
        }
    }
}

constexpr int L_XS = 0, L_XS_STRIDE = 136, L_YT = 17408, L_YT_STRIDE = 132, L_WV = L_YT + 64 * L_YT_STRIDE * 4, L_WV_BYTES = 2 * 16 * 68 * 4, L_CW = L_WV + 8 * L_WV_BYTES;
constexpr int L_XS2 = L_CW + 5 * 128 * 4;
static_assert(L_XS2 + 64 * L_XS_STRIDE * 2 <= MISC_OFF, "lru lds");
struct LruCtx { bf16x8 wf[2][2][4]; float pba[2], pbx[2], spl[2]; };
__device__ __forceinline__ void lru_setup(CArgs a, const Frame& F, int n, LruCtx& C) {
    const int tid = tid_opaque(F.wave_s), lane = tid & 63, wave = __builtin_amdgcn_readfirstlane(tid >> 6), fr = lane & 15, fq = lane >> 4;
    const int l = F.l, ech = wave * 16 + fr, chg = n * 128 + ech;
    const bf16_t* wt = F.W(W_LRU) + (size_t)n * 16384 + (size_t)ech * 128 + fq * 8;
#pragma unroll
    for (int d = 0; d < 2; ++d)
#pragma unroll
        for (int g = 0; g < 2; ++g)
#pragma unroll
            for (int ks = 0; ks < 4; ++ks) C.wf[d][g][ks] = *(const bf16x8*)(wt + (size_t)((d * 2 + g) * 8) * 16384 + ks * 32);
#pragma unroll
    for (int d = 0; d < 2; ++d) { C.pba[d] = a->in[18][(l * 2 + d) * DM + chg] * -1.4426950408889634f; C.pbx[d] = a->in[20][(l * 2 + d) * DM + chg] * -1.4426950408889634f;   const float lam = a->in[21][(l * 2 + d) * DM + chg];
        const float ey = __builtin_amdgcn_exp2f(-lam * 1.4426950408889634f);
        const float sp_small = ey * (1.0f + ey * (-0.5f + ey * (0.33333334f + ey * (-0.25f + ey * 0.2f))));
        const float sp_big = (lam < -15.f) ? -lam : __builtin_amdgcn_logf(1.0f + ey) * 0.6931471805599453f;
        C.spl[d] = (ey < 0.125f ? sp_small : sp_big) * (8.0f * 1.4426950408889634f); }
}
struct XRows { u32x4 r[4][2]; };
__device__ __forceinline__ void lru_load_rows(const Frame& F, int tile, int n, XRows& X) {
    const int tid = tid_opaque(F.wave_s), t = tid >> 3, c0 = (tid & 7) * 16;
    const int lrow0 = tile < 256 ? tile * 64 : CH_L + (tile - 256) * 64;
#pragma unroll
    for (int k = 0; k < 4; ++k) { int row = lrow0 + t + k - 2; row = row < 0 ? 0 : (row > CH_ROWS - 1 ? CH_ROWS - 1 : row);
        const bf16_t* zr = F.Z() + (size_t)row * ZP + CRX + n * 128 + c0; X.r[k][0] = *(const u32x4*)zr; X.r[k][1] = *(const u32x4*)(zr + 8); }
}
__device__ __forceinline__ void lru_item(CArgs a, const Frame& F, LAS unsigned char* lds, int pass, int tile, int n, const LruCtx& C, const float cy, const XRows& X, const int xbuf) {
    const int tid = tid_opaque(F.wave_s), lane = tid & 63, wave = __builtin_amdgcn_readfirstlane(tid >> 6), fr = lane & 15, fq = lane >> 4;
    const int l = F.l;
    LAS bf16_t* xs = (LAS bf16_t*)(lds + (xbuf ? L_XS2 : L_XS)); LAS float* yt = (LAS float*)(lds + L_YT);
    LAS float* wa = (LAS float*)(lds + L_WV + wave * L_WV_BYTES); LAS float* wu = wa + 16 * 68;
    int lrow0, t0, slen;
    if (tile < 256) { lrow0 = tile * 64; t0 = (tile & 63) * 64; slen = SEQ; }
    else { const int jj = tile - 256; lrow0 = CH_L + jj * 64; t0 = (jj & 3) * 64; slen = CTXL; }
    float* lsum = (float*)(F.ws + WS_LSUM);
    const int ech = wave * 16 + fr, chg = n * 128 + ech;
    u32x4 g0 = {0u, 0u, 0u, 0u}, g1 = {0u, 0u, 0u, 0u};
    if (pass == 2) { const bf16_t* zg = F.Z() + (size_t)(lrow0 + (tid >> 3)) * ZP + CRG + n * 128 + (tid & 7) * 16; g0 = *(const u32x4*)zg; g1 = *(const u32x4*)(zg + 8); }
    {
        const int t = tid >> 3, c0 = (tid & 7) * 16;
        const LAS float* cw = (const LAS float*)(lds + L_CW) + c0;
        float accv[16];
#pragma unroll
        for (int i = 0; i < 4; ++i) { const f32x4 b4 = *(const LAS f32x4*)(cw + 4 * 128 + 4 * i); accv[4 * i] = b4[0]; accv[4 * i + 1] = b4[1]; accv[4 * i + 2] = b4[2]; accv[4 * i + 3] = b4[3]; }
#pragma unroll
        for (int k = 0; k < 4; ++k) { const int ts = t0 + t + k - 2;
            if (ts >= 0 && ts < slen) { const u32x4 r0 = X.r[k][0], r1 = X.r[k][1];
                const float xv[16] = {bf_lo(r0.x), bf_hi(r0.x), bf_lo(r0.y), bf_hi(r0.y), bf_lo(r0.z), bf_hi(r0.z), bf_lo(r0.w), bf_hi(r0.w), bf_lo(r1.x), bf_hi(r1.x), bf_lo(r1.y), bf_hi(r1.y), bf_lo(r1.z), bf_hi(r1.z), bf_lo(r1.w), bf_hi(r1.w)};
#pragma unroll
                for (int i = 0; i < 4; ++i) { const f32x4 w4 = *(const LAS f32x4*)(cw + k * 128 + 4 * i);
                    accv[4 * i] += xv[4 * i] * w4[0]; accv[4 * i + 1] += xv[4 * i + 1] * w4[1]; accv[4 * i + 2] += xv[4 * i + 2] * w4[2]; accv[4 * i + 3] += xv[4 * i + 3] * w4[3]; } } }
        u32x4 w0, w1; w0.x = cvt_pk_bf16(accv[0], accv[1]); w0.y = cvt_pk_bf16(accv[2], accv[3]); w0.z = cvt_pk_bf16(accv[4], accv[5]); w0.w = cvt_pk_bf16(accv[6], accv[7]);
        w1.x = cvt_pk_bf16(accv[8], accv[9]); w1.y = cvt_pk_bf16(accv[10], accv[11]); w1.z = cvt_pk_bf16(accv[12], accv[13]); w1.w = cvt_pk_bf16(accv[14], accv[15]);
        *(LAS u32x4*)(xs + t * L_XS_STRIDE + c0) = w0; *(LAS u32x4*)(xs + t * L_XS_STRIDE + c0 + 8) = w1;
    }
    __syncthreads();
    f32x4 accg[2][2][4];
#pragma unroll
    for (int d = 0; d < 2; ++d)
#pragma unroll
        for (int g = 0; g < 2; ++g)
#pragma unroll
            for (int m = 0; m < 4; ++m) { const float b = g == 0 ? C.pba[d] : C.pbx[d]; accg[d][g][m] = (f32x4){b, b, b, b}; }
#pragma unroll
    for (int ks = 0; ks < 4; ++ks)
#pragma unroll
        for (int m = 0; m < 4; ++m) { const bf16x8 af = *(const LAS bf16x8*)(xs + (16 * m + fr) * L_XS_STRIDE + ks * 32 + fq * 8);
#pragma unroll
            for (int d = 0; d < 2; ++d)
#pragma unroll
                for (int g = 0; g < 2; ++g) accg[d][g][m] = __builtin_amdgcn_mfma_f32_16x16x32_bf16(af, C.wf[d][g][ks], accg[d][g][m], 0, 0, 0); }
    float xv[4][4];
#pragma unroll
    for (int m = 0; m < 4; ++m)
#pragma unroll
        for (int jj = 0; jj < 4; ++jj) xv[m][jj] = bf1(xs[(16 * m + 4 * fq + jj) * L_XS_STRIDE + ech]);
    float y[16];
#pragma unroll
    for (int d = 0; d < 2; ++d) {
#pragma unroll
        for (int m = 0; m < 4; ++m) { f32x4 av, uv;
#pragma unroll
            for (int jj = 0; jj < 4; ++jj) {
                const float r = __builtin_amdgcn_rcpf(1.0f + __builtin_amdgcn_exp2f(accg[d][0][m][jj])), ig = __builtin_amdgcn_rcpf(1.0f + __builtin_amdgcn_exp2f(accg[d][1][m][jj]));
                const float av1 = __builtin_amdgcn_exp2f(-r * C.spl[d]);
                const float om = __builtin_fmaf(-av1, av1, 1.0f);
                av[jj] = av1; uv[jj] = __builtin_amdgcn_sqrtf(om) * (ig * xv[m][jj]); }
            *(LAS f32x4*)(wa + fr * 68 + 16 * m + 4 * fq) = av; *(LAS f32x4*)(wu + fr * 68 + 16 * m + 4 * fq) = uv; }
        asm volatile("s_waitcnt lgkmcnt(0)" ::: "memory");
        f32x4 A4[4], U4[4];
#pragma unroll
        for (int i = 0; i < 4; ++i) { A4[i] = *(const LAS f32x4*)(wa + fr * 68 + 16 * fq + 4 * i); U4[i] = *(const LAS f32x4*)(wu + fr * 68 + 16 * fq + 4 * i); }
        asm volatile("s_waitcnt lgkmcnt(0)" ::: "memory");
        float hl[16], Pl[16]; float h = 0.f, P = 1.f;
        if (d == 0) {
#pragma unroll
            for (int s = 0; s < 16; ++s) { const float av = A4[s >> 2][s & 3], uv = U4[s >> 2][s & 3]; h = av * h + uv; P *= av; hl[s] = h; Pl[s] = P; }
        } else {
#pragma unroll
            for (int s = 15; s >= 0; --s) { const float av = A4[s >> 2][s & 3], uv = U4[s >> 2][s & 3]; h = av * h + uv; P *= av; hl[s] = h; Pl[s] = P; }
        }
        float Pk[4], Hk[4];
#pragma unroll
        for (int k = 0; k < 4; ++k) { Pk[k] = bperm(P, k * 16 + fr); Hk[k] = bperm(h, k * 16 + fr); }
        float c = (pass == 2) ? bperm(cy, d * 16 + fr) : 0.f, cin = 0.f, Pt = 1.f;
#pragma unroll
        for (int kk = 0; kk < 4; ++kk) { const int k = d == 0 ? kk : 3 - kk; if (k == fq) cin = c; c = Pk[k] * c + Hk[k]; Pt *= Pk[k]; }
        if (pass == 1) { if (fq == 0) ((f32x2*)lsum)[(size_t)tile * 2048 + d * 1024 + chg] = (f32x2){Pt, c}; }
        else {
#pragma unroll
            for (int s = 0; s < 16; ++s) { const float hv = hl[s] + Pl[s] * cin; if (d == 0) y[s] = hv; else y[s] += hv; }
        }
    }
    if (pass == 2) {
#pragma unroll
        for (int s = 0; s < 16; ++s) yt[(16 * fq + s) * L_YT_STRIDE + ech] = y[s];
        __syncthreads();
        const int t = tid >> 3, c0 = (tid & 7) * 16;
        bf16_t* zr = F.Z() + (size_t)(lrow0 + t) * ZP + CRG + n * 128 + c0;
        const float gv[16] = {bf_lo(g0.x), bf_hi(g0.x), bf_lo(g0.y), bf_hi(g0.y), bf_lo(g0.z), bf_hi(g0.z), bf_lo(g0.w), bf_hi(g0.w), bf_lo(g1.x), bf_hi(g1.x), bf_lo(g1.y), bf_hi(g1.y), bf_lo(g1.z), bf_hi(g1.z), bf_lo(g1.w), bf_hi(g1.w)};
        float o[16];
#pragma unroll
        for (int i = 0; i < 4; ++i) { const f32x4 yv = *(const LAS f32x4*)(yt + t * L_YT_STRIDE + c0 + 4 * i); o[4 * i] = yv[0] * gv[4 * i]; o[4 * i + 1] = yv[1] * gv[4 * i + 1]; o[4 * i + 2] = yv[2] * gv[4 * i + 2]; o[4 * i + 3] = yv[3] * gv[4 * i + 3]; }
        u32x4 w0, w1; w0.x = cvt_pk_bf16(o[0], o[1]); w0.y = cvt_pk_bf16(o[2], o[3]); w0.z = cvt_pk_bf16(o[4], o[5]); w0.w = cvt_pk_bf16(o[6], o[7]);
        w1.x = cvt_pk_bf16(o[8], o[9]); w1.y = cvt_pk_bf16(o[10], o[11]); w1.z = cvt_pk_bf16(o[12], o[13]); w1.w = cvt_pk_bf16(o[14], o[15]);
        *(u32x4*)(zr + (CSC - CRG)) = w0; *(u32x4*)(zr + (CSC - CRG) + 8) = w1;
    }
}

__device__ __forceinline__ void lru_phase(CArgs a, const Frame& F, LAS unsigned char* lds, int pass) {
    const int tid = tid_opaque(F.wave_s), lane = tid & 63, wave = __builtin_amdgcn_readfirstlane(tid >> 6), fr = lane & 15;
    const int d = (lane >> 4) & 1; const bool cl = (pass == 2) && lane < 32;
    for (int w = bid_opaque(); w < 256; w += gridDim.x) {
        const int bl = w >> 6, n = (w >> 3) & 7, sg = w & 7;
        LruCtx C; lru_setup(a, F, n, C);
        { LAS float* cwl = (LAS float*)(lds + L_CW);
          for (int e = tid_opaque(F.wave_s); e < 640; e += NTHREADS) cwl[e] = e < 512 ? a->in[15][(size_t)F.l * 4 * DM + (e >> 7) * DM + n * 128 + (e & 127)] : a->in[16][(size_t)F.l * DM + n * 128 + (e - 512)];
          __syncthreads(); }
        XRows xc, xn; lru_load_rows(F, bl * 64 + sg * 8, n, xc);
        const int lane1 = tid_opaque(F.wave_s) & 63;
        const int d1 = (lane1 >> 4) & 1;
        const f32x2* sp = (const f32x2*)(F.ws + WS_LSUM) + (size_t)d1 * 1024 + n * 128 + wave * 16 + (lane1 & 15);
        const int cf = 256 + bl * 4, lf = bl * 64;
        float cb = 0.f;
        if (cl) {
#pragma unroll
            for (int q = 0; q < 4; ++q) { const f32x2 s = sp[(size_t)(d1 == 0 ? cf + q : cf + 3 - q) * 2048]; cb = s.x * cb + s.y; }
            const int cnt = d1 == 0 ? sg * 8 : 56 - sg * 8, start = d1 == 0 ? lf : lf + 63, step = d1 == 0 ? 1 : -1;
#pragma unroll 8
            for (int q = 0; q < cnt; ++q) { const f32x2 s = sp[(size_t)(start + q * step) * 2048]; cb = s.x * cb + s.y; }
        }
        float cys[8];
#pragma unroll
        for (int q = 0; q < 8; ++q) cys[q] = 0.f;
        if (cl) { f32x2 ss[8];
#pragma unroll
            for (int q = 0; q < 8; ++q) ss[q] = sp[(size_t)(lf + sg * 8 + q) * 2048];
            float c = cb;
#pragma unroll
            for (int q = 0; q < 8; ++q) { const int qq = d1 == 0 ? q : 7 - q; const f32x2 sv = d1 == 0 ? ss[q] : ss[7 - q];
                if (d1 == 0) { cys[q] = c; } else { cys[7 - q] = c; } c = sv.x * c + sv.y; (void)qq; } }
        for (int jj = 0; jj < 8; ++jj) {
            const int tl = sg * 8 + jj; float cy = cys[0];
#pragma unroll
            for (int q = 1; q < 8; ++q) cy = (jj == q) ? cys[q] : cy;
            const bool has_ctx = sg < 4 && (pass == 1 || F.l == 0);
            if (jj < 7) lru_load_rows(F, lf + tl + 1, n, xn); else if (has_ctx) lru_load_rows(F, cf + sg, n, xn);
            lru_item(a, F, lds, pass, lf + tl, n, C, cy, xc, jj & 1);
            xc = xn;
        }
        if (sg < 4 && (pass == 1 || F.l == 0)) {
            float cy = 0.f;
            const int lane2 = tid_opaque(F.wave_s) & 63;
            const f32x2* sp = (const f32x2*)(F.ws + WS_LSUM) + (size_t)((lane2 >> 4) & 1) * 1024 + n * 128 + wave * 16 + (lane2 & 15);
            if (cl) { if (d == 0) { for (int q = 0; q < sg; ++q) { const f32x2 s = sp[(size_t)(cf + q) * 2048]; cy = s.x * cy + s.y; } }
                      else { for (int q = 3; q > sg; --q) { const f32x2 s = sp[(size_t)(cf + q) * 2048]; cy = s.x * cy + s.y; } } }
            lru_item(a, F, lds, pass, cf + sg, n, C, cy, xc, 0);
        }
        __syncthreads();
    }
}

constexpr int SG_KC = 512, SG_PITCH = SG_KC * 2 + 16, SG_B_OFF = 64 * SG_PITCH;
__device__ __forceinline__ void sg_accum(LAS unsigned char* lds, const bf16_t* A, int lda, const bf16_t* Bt, int K, int tid, int wave, int lane, f32x4 (&acc)[2]) {
    const int fr = lane & 15, fq = lane >> 4, rt = wave & 3, ch = wave >> 2;
    u32x4 ra[8], rb[8];
#define SG_LOADS(k0_) do { _Pragma("unroll") for (int i_ = 0; i_ < 8; ++i_) { const int p_ = tid + 512 * i_, row_ = p_ >> 6, kc_ = (p_ & 63) * 8; \
        if ((k0_) + kc_ < K) { ra[i_] = *(const u32x4*)(A + (size_t)row_ * lda + (k0_) + kc_); rb[i_] = *(const u32x4*)(Bt + (size_t)row_ * K + (k0_) + kc_); } \
        else { ra[i_] = (u32x4){0u, 0u, 0u, 0u}; rb[i_] = (u32x4){0u, 0u, 0u, 0u}; } } } while (0)
    SG_LOADS(0);
    for (int k0 = 0; k0 < K; k0 += SG_KC) {
        __syncthreads();
#pragma unroll
        for (int i = 0; i < 8; ++i) { const int p = tid + 512 * i, row = p >> 6, kc = (p & 63) * 8;
            *(LAS u32x4*)(lds + row * SG_PITCH + kc * 2) = ra[i]; *(LAS u32x4*)(lds + SG_B_OFF + row * SG_PITCH + kc * 2) = rb[i]; }
        if (k0 + SG_KC < K) SG_LOADS(k0 + SG_KC);
        __syncthreads();
        const int nks = (K - k0) >= SG_KC ? 16 : (K - k0) / 32;
        const LAS unsigned char* ap = lds + (16 * rt + fr) * SG_PITCH + fq * 16;
        const LAS unsigned char* bp = lds + SG_B_OFF + (32 * ch + fr) * SG_PITCH + fq * 16;
#pragma unroll 4
        for (int ks = 0; ks < nks; ++ks) { const bf16x8 af = *(const LAS bf16x8*)(ap + ks * 64), b0 = *(const LAS bf16x8*)(bp + ks * 64), b1 = *(const LAS bf16x8*)(bp + 16 * SG_PITCH + ks * 64);
            acc[0] = __builtin_amdgcn_mfma_f32_16x16x32_bf16(af, b0, acc[0], 0, 0, 0); acc[1] = __builtin_amdgcn_mfma_f32_16x16x32_bf16(af, b1, acc[1], 0, 0, 0); }
    }
    __syncthreads();
#undef SG_LOADS
}
__device__ __forceinline__ void ctx_g2_block(const Frame& F, LAS unsigned char* lds, int id) {
    const int tid = tid_opaque(F.wave_s), lane = tid & 63, wave = __builtin_amdgcn_readfirstlane(tid >> 6), fr = lane & 15, fq = lane >> 4, rt = wave & 3, ch = wave >> 2;
    const int rb = id >> 4, cb = id & 15;
    bf16_t* zrow = F.Z() + (size_t)(CH_L + rb * 64) * ZP;
    f32x4 total[2] = {(f32x4){0.f, 0.f, 0.f, 0.f}, (f32x4){0.f, 0.f, 0.f, 0.f}};
#pragma unroll
    for (int seg = 0; seg < 3; ++seg) {
        f32x4 acc[2] = {(f32x4){0.f, 0.f, 0.f, 0.f}, (f32x4){0.f, 0.f, 0.f, 0.f}};
        const int colA = seg == 0 ? CSX : (seg == 1 ? CSB : CSC);
        bf16_t gq[2][4];
#pragma unroll
        for (int ct = 0; ct < 2; ++ct)
#pragma unroll
            for (int j = 0; j < 4; ++j) gq[ct][j] = zrow[(size_t)(16 * rt + 4 * fq + j) * ZP + CGT + seg * 1024 + cb * 64 + 32 * ch + 16 * ct + fr];
        sg_accum(lds, zrow + colA, ZP, F.W(seg == 0 ? W_AO : (seg == 1 ? W_SO : W_LO)) + (size_t)(cb * 64) * DM, DM, tid, wave, lane, acc);
#pragma unroll
        for (int ct = 0; ct < 2; ++ct)
#pragma unroll
            for (int j = 0; j < 4; ++j) total[ct][j] += bf1(gq[ct][j]) * acc[ct][j];
    }
#pragma unroll
    for (int ct = 0; ct < 2; ++ct)
#pragma unroll
        for (int j = 0; j < 4; ++j) zrow[(size_t)(16 * rt + 4 * fq + j) * ZP + CQ + cb * 64 + 32 * ch + 16 * ct + fr] = (bf16_t)(cvt_pk_bf16(total[ct][j], total[ct][j]) & 0xffffu);
}
__device__ __forceinline__ void ctx_res_block(const Frame& F, LAS unsigned char* lds, int id, int which) {
    const int tid = tid_opaque(F.wave_s), lane = tid & 63, wave = __builtin_amdgcn_readfirstlane(tid >> 6), fr = lane & 15, fq = lane >> 4, rt = wave & 3, ch = wave >> 2;
    const int rb = id >> 4, cb = id & 15;
    f32x4 acc[2] = {(f32x4){0.f, 0.f, 0.f, 0.f}, (f32x4){0.f, 0.f, 0.f, 0.f}};
    const size_t xrow0 = which == 0 ? (size_t)F.c * CH_C + rb * 64 : (size_t)rb * 64;
    const float* base = (which == 0 && F.l == 0) ? F.ctx : F.XC();
    const float* vec = F.MOD(8) + (which == 0 ? 2048 : 5120) + cb * 64 + 32 * ch + fr;
    float bq[2][4], gv[2];
#pragma unroll
    for (int ct = 0; ct < 2; ++ct) { gv[ct] = vec[16 * ct];
#pragma unroll
        for (int j = 0; j < 4; ++j) bq[ct][j] = base[(xrow0 + 16 * rt + 4 * fq + j) * DM + cb * 64 + 32 * ch + 16 * ct + fr]; }
    if (which == 0) sg_accum(lds, F.Z() + (size_t)(CH_L + rb * 64) * ZP + CQ, ZP, F.W(W_MO) + (size_t)(cb * 64) * DM, DM, tid, wave, lane, acc);
    else sg_accum(lds, F.Z() + (size_t)(LROWS + rb * 64) * FFW, FFW, F.W(W_F2) + (size_t)(cb * 64) * FFW, FFW, tid, wave, lane, acc);
#pragma unroll
    for (int ct = 0; ct < 2; ++ct)
#pragma unroll
        for (int j = 0; j < 4; ++j) F.XC()[(xrow0 + 16 * rt + 4 * fq + j) * DM + cb * 64 + 32 * ch + 16 * ct + fr] = bq[ct][j] + gv[ct] * acc[ct][j];
}

constexpr int N_PHASES = 30;
__device__ __forceinline__ void decode_phase(int ph, int& kind, int& l, int& c) {
    if (ph == 0) { kind = K_P0; l = 0; c = 0; return; }
    if (ph == N_PHASES - 1) { kind = K_FN; l = 1; c = 0; return; }
    const int q = ph - 1; l = q / 14; const int r = q % 14; c = 0;
    if (r == 0) { kind = K_N1; }
    else if (r <= 10) { c = (r - 1) / 5; const int s = (r - 1) % 5; kind = s == 0 ? K_G1 : s == 1 ? K_M1 : s == 2 ? K_A1 : s == 3 ? K_G2 : K_G3; }
    else { kind = r == 11 ? K_N2 : (r == 12 ? K_G4 : K_G5); }
}

__global__ void __launch_bounds__(NTHREADS, 2) mk_fwd(Args a_) {
    extern __shared__ __attribute__((aligned(16))) unsigned char lds_raw[];
    LAS unsigned char* lds = (LAS unsigned char*)lds_raw;
    cg::grid_group grid = cg::this_grid();
    const int ph_lo = a_.ph_lo, ph_hi = a_.ph_hi;
    const int wave_s = __builtin_amdgcn_readfirstlane(threadIdx.x >> 6);
    volatile LAS unsigned* MISC = (volatile LAS unsigned*)(lds + MISC_OFF);
    if (threadIdx.x < 4) MISC[threadIdx.x] = 0u;
    __syncthreads();
    (void)xcd_barrier_post((unsigned*)(a_.ws + WS_CTL), MISC);
    for (int ph = ph_lo; ph < ph_hi; ++ph) {
        CArgs a; { unsigned long long kp = (unsigned long long)__builtin_amdgcn_kernarg_segment_ptr(); asm volatile("" : "+s"(kp)); a = (CArgs)kp; }
        if (ph > ph_lo) {
            if (ph_hi < 0) grid.sync();
            else { XcdBarrier bar; bar.bar = (unsigned*)(a->ws + WS_CTL); bar.x = xb_xcc_id(); bar.st = (volatile LAS unsigned*)(lds + MISC_OFF); xcd_barrier(bar, tid_opaque(wave_s) == 0); } }
        Frame F;
        F.x = a->in[0]; F.cvec = a->in[1]; F.ctx = a->in[2]; F.cctx = a->in[3]; F.out = a->out; F.ws = a->ws;
        F.G = gridDim.x; { const int bx = bid_opaque(); F.vcu = (F.G % 8 == 0) ? (bx % 8) * (F.G / 8) + bx / 8 : bx; }
        int kind, l, c; decode_phase(ph, kind, l, c);
        F.kind = kind; F.l = l; F.c = c; F.wave_s = wave_s;
        if (kind == K_P0) { phase_p0(a, F, lds); }
        else if (kind == K_N1) { for (int rep = 0; rep < ((kind == REP_KIND) ? 2 : 1); ++rep) phase_norm(a, F, 0); }
        else if (kind == K_N2) { for (int rep = 0; rep < ((kind == REP_KIND) ? 2 : 1); ++rep) phase_norm(a, F, 1); }
        else if (kind == K_FN) { phase_final(a, F); }
        else if (kind == K_M1) {
            for (int rep = 0; rep < REP_LRU1; ++rep) lru_phase(a, F, lds, 1);
            phase_qknorm(a, F);
            phase_sconv(a, F);
        } else if (kind == K_A1) {
            for (int rep = 0; rep < REP_A1; ++rep) lru_phase(a, F, lds, 2);
            const int nlat = CHB * 8 * 16, ntot = nlat + ((l == 0) ? CHB * 8 : 0);
            for (int rep = 0; rep < REP_ATT; ++rep)
            for (int i = 0;; ++i) {
                int U;
                if (F.G == 256) { if (i < 2) U = (F.vcu >> 5) * 64 + i * 32 + (F.vcu & 31); else { const int v2 = F.vcu - 128; U = (i == 2 && v2 >= 0 && v2 < 32) ? nlat + v2 : ntot; } }
                else U = i * F.G + F.vcu;
                if (U >= ntot) break;
                if (U < nlat) {
                    const int bk = U >> 6, bl = bk >> 1, kvh = bk & 1, r = U & 63, h = kvh * 4 + (r >> 4), qb = r & 15;
                    bf16_t* q = F.Z() + (size_t)(bl * SEQ + qb * 256) * ZP + CQ + h * 128;
                    att::attn_dense_body(q, F.Kb() + (size_t)bl * KVLEN * 256 + kvh * 128, F.Vb() + (size_t)bl * KVLEN * 256 + kvh * 128, q + (CSX - CQ), KVLEN, (char*)lds_raw, F.wave_s);
                } else {
                    const int V = U - nlat, bl = V >> 3, h = V & 7, kvh = h >> 2;
                    bf16_t* q = F.Z() + (size_t)(CH_L + bl * CTXL) * ZP + CQ + h * 128;
                    att::attn_dense_body(q, F.Kb() + (size_t)bl * KVLEN * 256 + kvh * 128, F.Vb() + (size_t)bl * KVLEN * 256 + kvh * 128, q + (CSX - CQ), CTXL, (char*)lds_raw, F.wave_s);
                }
            }
        } else {
            GSched S; S.F = F; GEpi E; E.F = F;
            const int K = (kind == K_G5) ? FFW : DM;
            const int lda = (kind == K_G1 || kind == K_G4) ? DM : (kind == K_G5 ? FFW : ZP);
            for (int rep = 0; rep < ((kind == REP_KIND) ? 2 : 1); ++rep)
            pg8::gemm_phase<GEpi, GSched>(lds, K, lda, S, E);
            if (l == 0) {
                if (kind == K_G2) { for (int id = F.vcu; id < 256; id += F.G) ctx_g2_block(F, lds, id); }
                else if (kind == K_G3) { for (int id = F.vcu; id < 256; id += F.G) ctx_res_block(F, lds, id, 0); }
                else if (kind == K_G5) { for (int id = F.vcu; id < 512; id += F.G) ctx_res_block(F, lds, id, 1); }
            }
        }
    }
}

extern "C" void kernel_launch(void* const* d_in, const int* in_sizes, int n_in, void* d_out, int out_size, void* d_ws, size_t ws_size, hipStream_t stream) {
    static int grid = 0;
    if (grid == 0) {
        if (n_in != 27 || out_size != LROWS * DM || ws_size < WS_END) { fprintf(stderr, "kernel_launch: bad shapes n_in %d out %d ws %zu (need %zu)\n", n_in, out_size, ws_size, (size_t)WS_END); grid = -1; return; }
        int dev = 0, cus = 0, per_cu = 0;
        hipGetDevice(&dev); hipDeviceGetAttribute(&cus, hipDeviceAttributeMultiprocessorCount, dev);
        if (hipFuncSetAttribute((const void*)mk_fwd, hipFuncAttributeMaxDynamicSharedMemorySize, LDS_BYTES) != hipSuccess) { fprintf(stderr, "kernel_launch: hipFuncSetAttribute failed\n"); grid = -1; return; }
        if (hipOccupancyMaxActiveBlocksPerMultiprocessor(&per_cu, (const void*)mk_fwd, NTHREADS, LDS_BYTES) != hipSuccess || per_cu < 1) { fprintf(stderr, "kernel_launch: occupancy query failed (%d)\n", per_cu); per_cu = 1; }
        (void)hipGetLastError();
        grid = cus * per_cu;
        fprintf(stderr, "kernel_launch: grid %d (cus %d x %d)\n", grid, cus, per_cu);
    }
    if (grid < 0) return;
    if (hipMemsetAsync((char*)d_ws + WS_CTL, 0, CTL_BYTES, stream) != hipSuccess) { fprintf(stderr, "kernel_launch: memset failed\n"); return; }
    Args a{};
    for (int i = 0; i < 27; ++i) a.in[i] = (const float*)d_in[i];
    a.out = (float*)d_out; a.ws = (unsigned char*)d_ws;
#if MK_PER_PHASE
    for (int ph = 0; ph < N_PHASES; ++ph) {
        a.ph_lo = ph; a.ph_hi = ph + 1;
        void* args[] = {&a};
        hipError_t e = hipLaunchCooperativeKernel((const void*)mk_fwd, dim3(grid), dim3(NTHREADS), args, LDS_BYTES, stream);
        if (e != hipSuccess) { fprintf(stderr, "launch %d failed: %s\n", ph, hipGetErrorString(e)); break; }
    }
#else
    a.ph_lo = 0; a.ph_hi = N_PHASES;
    void* args[] = {&a};
    hipError_t e = hipLaunchCooperativeKernel((const void*)mk_fwd, dim3(grid), dim3(NTHREADS), args, LDS_BYTES, stream);
    if (e != hipSuccess) fprintf(stderr, "cooperative launch failed: %s (grid %d)\n", hipGetErrorString(e), grid);
#endif
}
```

```cpp
#include <hip/hip_runtime.h>
#include <hip/hip_bf16.h>
#include <hip/hip_cooperative_groups.h>
#include <cstdio>
#include <cstdint>
namespace cg = cooperative_groups;

#ifndef REP_KIND
#define REP_KIND -1
#endif
#ifndef REP_LRU1
#define REP_LRU1 1
#endif
#ifndef REP_A1
#define REP_A1 1
#endif
#ifndef REP_ATT
#define REP_ATT 1
#endif
#ifndef MK_PER_PHASE
#define MK_PER_PHASE 0
#endif

#define LAS __attribute__((address_space(3)))
typedef unsigned short bf16_t;
typedef short bf16x8 __attribute__((ext_vector_type(8)));
typedef short s16x4 __attribute__((ext_vector_type(4)));
typedef float f32x2 __attribute__((ext_vector_type(2)));
typedef float f32x4 __attribute__((ext_vector_type(4)));
typedef float f32x16 __attribute__((ext_vector_type(16)));
typedef unsigned u32x4 __attribute__((ext_vector_type(4)));
typedef unsigned u32x2 __attribute__((ext_vector_type(2)));

constexpr int DM = 1024, NBATCH = 8, SEQ = 4096, CTXL = 256, NIN = 9728, FFW = 2816;
constexpr int LROWS = NBATCH * SEQ, CROWS = NBATCH * CTXL, ROWS = LROWS + CROWS;
constexpr int CHB = 4, CH_L = CHB * SEQ, CH_C = CHB * CTXL, CH_ROWS = CH_L + CH_C;
constexpr int ZP = NIN;
constexpr int CQ = 0, CK = 1024, CV = 1280, CSB = 1536, CSC = 2560, CSX = 3584, CRX = 4608, CRG = 5632, CGT = 6656;
constexpr int KVLEN = CTXL + SEQ;
constexpr float EPS = 1e-6f;
constexpr int NTHREADS = 512, NWAVES = 8;
constexpr int MISC_OFF = 143360, LDS_BYTES = MISC_OFF + 1024;

constexpr size_t MiB = 1u << 20;
constexpr size_t WS_MOD = 0, WS_ROPE = 512 * 1024, WS_CTL = 768 * 1024, CTL_BYTES = 16384, WS_LSUM = 1 * MiB, WS_XC = 6 * MiB, WS_W = 14 * MiB;
constexpr size_t W_IN = 0, W_AO = 19 * MiB, W_SO = 21 * MiB, W_LO = 23 * MiB, W_MO = 25 * MiB, W_F1 = 27 * MiB, W_F2 = 38 * MiB, W_LRU = 43 * MiB + 512 * 1024;
constexpr size_t W_LAYER = 44 * MiB + 512 * 1024;
constexpr size_t WS_H = 103 * MiB, WS_K = 171 * MiB, WS_V = WS_K + (size_t)CHB * KVLEN * 256 * 2, WS_Z = 188 * MiB, WS_END = 511 * MiB;
static_assert(WS_W + 2 * W_LAYER <= WS_H, "weights");
static_assert(WS_H + (size_t)ROWS * DM * 2 <= WS_K, "H");
static_assert(WS_V + (size_t)CHB * KVLEN * 256 * 2 <= WS_Z, "KV");
static_assert(WS_Z + (size_t)CH_ROWS * ZP * 2 <= WS_END, "Z");
static_assert((size_t)ROWS * FFW * 2 <= (size_t)CH_ROWS * ZP * 2, "HID in Z");
static_assert(W_F2 + (size_t)DM * FFW * 2 <= W_LRU && W_IN + (size_t)NIN * DM * 2 <= W_AO && W_F1 + (size_t)2 * FFW * DM * 2 <= W_F2, "w map");

struct Args { const float* in[27]; float* out; unsigned char* ws; int ph_lo, ph_hi; };
typedef const __attribute__((address_space(4))) Args* CArgs;

__device__ __forceinline__ unsigned cvt_pk_bf16(float lo, float hi) { unsigned r; asm volatile("v_cvt_pk_bf16_f32 %0, %1, %2" : "=v"(r) : "v"(lo), "v"(hi)); return r; }
typedef __bf16 bf16x2_t __attribute__((ext_vector_type(2)));
__device__ __forceinline__ unsigned cvtpk_nv(float lo, float hi) { f32x2 v = {lo, hi}; bf16x2_t b = __builtin_convertvector(v, bf16x2_t); return __builtin_bit_cast(unsigned, b); }
__device__ __forceinline__ float bf_lo(unsigned u) { return __uint_as_float(u << 16); }
__device__ __forceinline__ float bf_hi(unsigned u) { return __uint_as_float(u & 0xffff0000u); }
__device__ __forceinline__ float bf1(bf16_t b) { return __uint_as_float((unsigned)b << 16); }
__device__ __forceinline__ int tid_opaque(int wave_s) { int t = wave_s * 64 + (int)__builtin_amdgcn_mbcnt_hi(~0u, __builtin_amdgcn_mbcnt_lo(~0u, 0u)); asm volatile("" : "+v"(t)); return t; }
__device__ __forceinline__ int bid_opaque() { int b = blockIdx.x; asm volatile("" : "+s"(b)); return b; }
template <int M> __device__ __forceinline__ float swz_xor(float v) { return __int_as_float(__builtin_amdgcn_ds_swizzle(__float_as_int(v), (M << 10) | 0x1f)); }
__device__ __forceinline__ float bperm(float v, int src_lane) { return __int_as_float(__builtin_amdgcn_ds_bpermute(src_lane << 2, __float_as_int(v))); }
__device__ __forceinline__ float wave_sum(float v) {
    v += swz_xor<1>(v); v += swz_xor<2>(v); v += swz_xor<4>(v); v += swz_xor<8>(v); v += swz_xor<16>(v);
    auto rr = __builtin_amdgcn_permlane32_swap(__float_as_uint(v), __float_as_uint(v), false, false);
    return __uint_as_float(rr[0]) + __uint_as_float(rr[1]);
}
__device__ __forceinline__ float fast_sigmoid(float y) { return __builtin_amdgcn_rcpf(1.0f + __builtin_amdgcn_exp2f(-1.4426950408889634f * y)); }
__device__ __forceinline__ float gelu_tanh(float x) { const float y = 1.5957691216057308f * (x + 0.044715f * x * x * x); return x * fast_sigmoid(y); }
__device__ __forceinline__ float silu_f(float x) { return x * fast_sigmoid(x); }

#define XB_TMO      128
#define XB_XCNT(j)  (256  + 64 * (j))
#define XB_XSUB(j)  (1280 + 64 * (j))
#define XB_XGEN(j)  (2304 + 64 * (j))
#define XB_TOP      3328
#define XB_TOPGEN   3392
#define XCD_BAR_WORDS 3456
#define XB_SPIN_CAP (1u << 18)

__device__ __forceinline__ unsigned xb_ld(unsigned* p)              { return __hip_atomic_load(p, __ATOMIC_RELAXED, __HIP_MEMORY_SCOPE_AGENT); }
__device__ __forceinline__ unsigned xb_add(unsigned* p, unsigned v) { return __hip_atomic_fetch_add(p, v, __ATOMIC_RELAXED, __HIP_MEMORY_SCOPE_AGENT); }
__device__ __forceinline__ unsigned xb_xcc_id() { return (unsigned)__builtin_amdgcn_s_getreg((3 << 11) | 20) & 0xFu; }
#define XB_SPIN(cond, bar) do { unsigned _sp = 0; while (cond) { __builtin_amdgcn_s_sleep(1); \
    if ((++_sp & 255u) == 0u) { if (xb_ld(&(bar)[XB_TMO])) break; if (_sp > XB_SPIN_CAP) { atomicAdd(&(bar)[XB_TMO], 1u); break; } } } } while (0)

struct XcdBarrier {
    unsigned* bar; unsigned x;
    volatile LAS unsigned* st;
};

__device__ __forceinline__ XcdBarrier xcd_barrier_post(unsigned* bar, volatile LAS unsigned* st) {
    XcdBarrier b; b.bar = bar; b.x = xb_xcc_id(); b.st = st;
    if (threadIdx.x == 0) (void)xb_add(&bar[XB_XCNT(b.x)], 1u);
    return b;
}
__device__ __forceinline__ void xcd_barrier_complete(unsigned* bar, unsigned x, unsigned& nloc, unsigned& nx) {
    const unsigned G = gridDim.x * gridDim.y * gridDim.z;
    unsigned sum, cnt, mine, sp = 0u;
    for (;;) {
        sum = 0u; cnt = 0u; mine = 0u;
#pragma unroll
        for (unsigned j = 0; j < 16; ++j) { const unsigned c = xb_ld(&bar[XB_XCNT(j)]); sum += c; cnt += (c > 0u) ? 1u : 0u; mine = (j == x) ? c : mine; }
        if (sum == G) break;
        __builtin_amdgcn_s_sleep(1);
        if ((++sp & 255u) == 0u) { if (xb_ld(&bar[XB_TMO])) break; if (sp > XB_SPIN_CAP) { atomicAdd(&bar[XB_TMO], 1u); break; } }
    }
    nloc = mine > 0u ? mine : 1u; nx = cnt > 0u ? cnt : 1u;
}

__device__ __forceinline__ void xcd_barrier(const XcdBarrier& b, const bool leader_thread) {
    asm volatile("s_waitcnt vmcnt(0)" ::: "memory");
    __syncthreads();
    if (leader_thread) {
        unsigned* bar = b.bar;
        __builtin_amdgcn_s_waitcnt(0);
        unsigned nloc = b.st[0], nx = b.st[1];
        if (nloc == 0u) { xcd_barrier_complete(bar, b.x, nloc, nx); b.st[0] = nloc; b.st[1] = nx; }
        const unsigned old = xb_add(&bar[XB_XSUB(b.x)], 1u);
        const unsigned gen = old / nloc;
        if (old + 1u == (gen + 1u) * nloc) {
            __builtin_amdgcn_fence(__ATOMIC_RELEASE, "agent");
            asm volatile("s_waitcnt vmcnt(0)" ::: "memory");
            const unsigned og = xb_add(&bar[XB_TOP], 1u);
            const unsigned tg = og / nx;
            if (og + 1u == (tg + 1u) * nx) xb_add(&bar[XB_TOPGEN], 1u);
            else XB_SPIN(xb_ld(&bar[XB_TOPGEN]) == tg, bar);
            __builtin_amdgcn_fence(__ATOMIC_ACQUIRE, "agent");
            xb_add(&bar[XB_XGEN(b.x)], 1u);
            asm volatile("s_waitcnt vmcnt(0)" ::: "memory");
        } else {
            XB_SPIN(xb_ld(&bar[XB_XGEN(b.x)]) == gen, bar);
            __builtin_amdgcn_fence(__ATOMIC_ACQUIRE, "agent");
            asm volatile("s_waitcnt vmcnt(0)" ::: "memory");
        }
    }
    __syncthreads();
}


namespace pg8 {
constexpr int BM = 256, BK = 64, HALF = 128, HTB = HALF * BK * 2, STAGE_BYTES = 8 * HTB;
__host__ __device__ __forceinline__ int lds_byte(int r, int c) { const int st = (r >> 4) * 2 + (c >> 5), rr = r & 15, cc = c & 31, ob = rr * 64 + cc * 2; return st * 1024 + (ob ^ (((ob >> 9) & 1) << 5)); }
__host__ __device__ __forceinline__ void stage_rc(int b, int& R, int& C) { const int st = b / 1024, sb = b % 1024, swz = sb ^ (((sb >> 9) & 1) << 5); R = (st >> 1) * 16 + swz / 64; C = (st & 1) * 32 + (swz % 64) / 2; }
__host__ __device__ __forceinline__ int perm32(int rho) { const int n = rho >> 4, i = rho & 15; return 8 * (i >> 2) + 4 * n + (i & 3); }

struct Unit { const char* A; const char* B; int pm, pn, seg; };

template <class Epi, class Sched>
__device__ __forceinline__ void gemm_phase(LAS unsigned char* lds, const int K, const int lda, const Sched& S, const Epi& E) {
    const int tid = tid_opaque(S.F.wave_s), wid = __builtin_amdgcn_readfirstlane(tid >> 6), lane = tid & 63, wr = wid >> 2, wc = wid & 3, fr = lane & 15, fq = lane >> 4;
    const int nt = K / BK;
    unsigned voffA[2], voffB[2];
#pragma unroll
    for (int i = 0; i < 2; ++i) { int R, C; stage_rc(tid * 16 + i * 8192, R, C); const int Rb = (R & ~31) + perm32(R & 31);
        voffA[i] = (unsigned)(R * lda + C) * 2u; voffB[i] = (unsigned)(Rb * K + C) * 2u; }
    const size_t kstep = (size_t)(BK * 2);
    const size_t hstepA = (size_t)HALF * lda * 2, hstepB = (size_t)HALF * K * 2;
    const unsigned ldsw = (unsigned)wid * 1024u;
    const int aoff = lds_byte(wr * 64 + fr, fq * 8), boff = lds_byte(wc * 32 + fr, fq * 8);
#define PG8_SA(b, h) (((b) * 2 + (h)) * HTB)
#define PG8_SB(b, h) ((4 + (b) * 2 + (h)) * HTB)
#define PG8_STAGE(bufoff, gbase, voff) do { _Pragma("unroll") for (int _i = 0; _i < 2; ++_i) \
        __builtin_amdgcn_global_load_lds((const unsigned*)((const char*)(gbase) + (voff)[_i]), (LAS unsigned*)(lds + (bufoff) + ldsw + _i * 8192), 16, 0, 0); } while (0)
#define PG8_LDA(dst, b, h) do { _Pragma("unroll") for (int m = 0; m < 4; ++m) _Pragma("unroll") for (int k = 0; k < 2; ++k) dst[m][k] = *(const LAS bf16x8*)(lds + PG8_SA(b, h) + aoff + m * 2048 + k * 1024); } while (0)
#define PG8_LDB(dst, b, h) do { _Pragma("unroll") for (int n = 0; n < 2; ++n) _Pragma("unroll") for (int k = 0; k < 2; ++k) dst[n][k] = *(const LAS bf16x8*)(lds + PG8_SB(b, h) + boff + n * 2048 + k * 1024); } while (0)
#define PG8_MMA(ai, bj, At, Bt) do { __builtin_amdgcn_s_setprio(1); _Pragma("unroll") for (int m = 0; m < 4; ++m) _Pragma("unroll") for (int n = 0; n < 2; ++n) _Pragma("unroll") for (int k = 0; k < 2; ++k) \
        acc[ai][bj][m][n] = __builtin_amdgcn_mfma_f32_16x16x32_bf16(Bt[n][k], At[m][k], acc[ai][bj][m][n], 0, 0, 0); __builtin_amdgcn_s_setprio(0); } while (0)
#define PG8_WAIT_V(n) asm volatile("s_waitcnt vmcnt(" #n ")" ::: "memory")
#define PG8_WAIT_L(n) asm volatile("s_waitcnt lgkmcnt(" #n ")" ::: "memory")
#define PG8_BAR __builtin_amdgcn_s_barrier()
#define PG8_SCHED __builtin_amdgcn_sched_barrier(0)
    Unit cur, nxt; int ui = 0;
    if (!S.next(0, cur)) return;
    f32x4 acc[2][2][4][2];
#pragma unroll
    for (int a = 0; a < 2; ++a)
#pragma unroll
        for (int b = 0; b < 2; ++b)
#pragma unroll
            for (int m = 0; m < 4; ++m)
#pragma unroll
                for (int n = 0; n < 2; ++n) acc[a][b][m][n] = (f32x4){0.f, 0.f, 0.f, 0.f};
    bf16x8 At[4][2], B0[2][2], B1[2][2];
    const char* cA = cur.A; const char* cB = cur.B;
    PG8_STAGE(PG8_SB(0, 0), cB, voffB); PG8_STAGE(PG8_SB(0, 1), cB + hstepB, voffB); PG8_STAGE(PG8_SA(0, 0), cA, voffA); PG8_STAGE(PG8_SA(0, 1), cA + hstepA, voffA);
    if (wr == 1) PG8_BAR;
    PG8_WAIT_V(2); PG8_BAR;
    PG8_STAGE(PG8_SB(1, 0), cB + kstep, voffB); PG8_STAGE(PG8_SA(1, 0), cA + kstep, voffA); PG8_STAGE(PG8_SB(1, 1), cB + hstepB + kstep, voffB);
    PG8_WAIT_V(6); PG8_BAR;
    for (;;) {
        const bool has_next = S.next(ui + 1, nxt);
        const char* nA = has_next ? nxt.A : cA; const char* nB = has_next ? nxt.B : cB;
        for (int t = 0; t < nt; t += 2) {
            const bool last = (t == nt - 2);
            const char* a1 = cA + (size_t)(t + 1) * kstep;
            const char* a2 = last ? nA : cA + (size_t)(t + 2) * kstep; const char* b2 = last ? nB : cB + (size_t)(t + 2) * kstep;
            const char* a3 = a2 + kstep; const char* b3 = b2 + kstep;
            PG8_LDB(B0, 0, 0); PG8_LDB(B1, 0, 1); PG8_SCHED; PG8_LDA(At, 0, 0); PG8_STAGE(PG8_SA(1, 1), a1 + hstepA, voffA);
            PG8_WAIT_V(8); PG8_WAIT_L(0); PG8_BAR; PG8_MMA(0, 0, At, B0); PG8_MMA(0, 1, At, B1); PG8_BAR; PG8_SCHED;
            PG8_LDA(At, 0, 1); PG8_STAGE(PG8_SB(0, 0), b2, voffB); PG8_STAGE(PG8_SB(0, 1), b2 + hstepB, voffB); PG8_STAGE(PG8_SA(0, 0), a2, voffA);
            PG8_WAIT_V(8); PG8_WAIT_L(0); PG8_BAR; PG8_MMA(1, 0, At, B0); PG8_MMA(1, 1, At, B1); PG8_BAR; PG8_SCHED;
            PG8_LDB(B0, 1, 0); PG8_LDB(B1, 1, 1); PG8_SCHED; PG8_LDA(At, 1, 0); PG8_STAGE(PG8_SA(0, 1), a2 + hstepA, voffA);
            PG8_WAIT_V(8); PG8_WAIT_L(0); PG8_BAR; PG8_MMA(0, 0, At, B0); PG8_MMA(0, 1, At, B1); PG8_BAR; PG8_SCHED;
            PG8_LDA(At, 1, 1); PG8_STAGE(PG8_SB(1, 0), b3, voffB); PG8_STAGE(PG8_SB(1, 1), b3 + hstepB, voffB); PG8_STAGE(PG8_SA(1, 0), a3, voffA);
            PG8_WAIT_V(8); PG8_WAIT_L(0); PG8_BAR; PG8_MMA(1, 0, At, B0); PG8_MMA(1, 1, At, B1); PG8_BAR; PG8_SCHED;
        }
        if (wr == 0) PG8_BAR;
        E(acc, cur, wr, wc, fr, fq);
        if (!has_next) break;
#pragma unroll
        for (int a = 0; a < 2; ++a)
#pragma unroll
            for (int b = 0; b < 2; ++b)
#pragma unroll
                for (int m = 0; m < 4; ++m)
#pragma unroll
                    for (int n = 0; n < 2; ++n) acc[a][b][m][n] = (f32x4){0.f, 0.f, 0.f, 0.f};
        cur = nxt; cA = nA; cB = nB; ++ui;
        if (wr == 1) PG8_BAR;
    }
    PG8_WAIT_V(0);
    PG8_BAR;
#undef PG8_SA
#undef PG8_SB
#undef PG8_STAGE
#undef PG8_LDA
#undef PG8_LDB
#undef PG8_MMA
#undef PG8_WAIT_V
#undef PG8_WAIT_L
#undef PG8_BAR
#undef PG8_SCHED
}
}

enum PhaseKind { K_P0 = 0, K_N1, K_G1, K_M1, K_A1, K_G2, K_G3, K_N2, K_G4, K_G5, K_FN };

struct Frame {
    const float* x; const float* cvec; const float* ctx; const float* cctx;
    float* out; unsigned char* ws;
    int vcu, G, l, c, kind, wave_s;
    __device__ __forceinline__ const bf16_t* W(size_t off) const { return (const bf16_t*)(ws + WS_W + (size_t)l * W_LAYER + off); }
    __device__ __forceinline__ bf16_t* Z() const { return (bf16_t*)(ws + WS_Z); }
    __device__ __forceinline__ bf16_t* H() const { return (bf16_t*)(ws + WS_H); }
    __device__ __forceinline__ bf16_t* Kb() const { return (bf16_t*)(ws + WS_K); }
    __device__ __forceinline__ bf16_t* Vb() const { return (bf16_t*)(ws + WS_V); }
    __device__ __forceinline__ float* XC() const { return (float*)(ws + WS_XC); }
    __device__ __forceinline__ const float* MOD(int b) const { return (const float*)(ws + WS_MOD) + (size_t)(l * 9 + b) * 6144; }
};

struct GSched {
    Frame F;
    __device__ __forceinline__ static void tile_map(int T, int nM, int nN, int& pm, int& pn) {
        const int nig = 8 * nN, gid = T / nig, fm = gid * 8, gsz = (nM - fm) < 8 ? (nM - fm) : 8, w = T % nig; pm = fm + w % gsz; pn = w / gsz;
    }
    __device__ __forceinline__ bool next(int i, pg8::Unit& u) const {
        const int kind = F.kind, l = F.l, c = F.c;
        if (kind == K_G1) {
            const int L = i * F.G + F.vcu, NL = 64 * 38, ncc = (l == 0) ? 38 : 6;
            if (L >= NL + 4 * ncc) return false;
            int lt, pn;
            if (L < NL) { tile_map(L, 64, 38, lt, pn); }
            else { const int q = L - NL; lt = 64 + (q & 3); const int ci = q >> 2; pn = (l == 0) ? ci : (ci < 2 ? 4 + ci : 16 + ci); }
            const size_t grow0 = lt < 64 ? (size_t)(64 * c + lt) * 256 : (size_t)LROWS + (size_t)(4 * c + lt - 64) * 256;
            u.A = (const char*)(F.H() + grow0 * DM); u.B = (const char*)(F.W(W_IN) + (size_t)pn * 256 * DM); u.pm = lt; u.pn = pn; u.seg = 0; return true;
        } else if (kind == K_G2) {
            const int T = (i / 3) * F.G + F.vcu, seg = i % 3, nM = 64;
            if (T >= nM * 4) return false;
            int lt, pn; tile_map(T, nM, 4, lt, pn);
            const int colA = seg == 0 ? CSX : (seg == 1 ? CSB : CSC);
            u.A = (const char*)(F.Z() + (size_t)lt * 256 * ZP + colA);
            u.B = (const char*)(F.W(seg == 0 ? W_AO : (seg == 1 ? W_SO : W_LO)) + (size_t)pn * 256 * DM); u.pm = lt; u.pn = pn; u.seg = seg; return true;
        } else if (kind == K_G3) {
            const int T = i * F.G + F.vcu, nM = 64;
            if (T >= nM * 4) return false;
            int lt, pn; tile_map(T, nM, 4, lt, pn);
            u.A = (const char*)(F.Z() + (size_t)lt * 256 * ZP + CQ); u.B = (const char*)(F.W(W_MO) + (size_t)pn * 256 * DM); u.pm = lt; u.pn = pn; u.seg = 0; return true;
        } else if (kind == K_G4) {
            const int T = i * F.G + F.vcu, nM = (l == 0) ? 136 : 128;
            if (T >= nM * 22) return false;
            int pm, pn; tile_map(T, nM, 22, pm, pn);
            u.A = (const char*)(F.H() + (size_t)pm * 256 * DM); u.B = (const char*)(F.W(W_F1) + (size_t)pn * 256 * DM); u.pm = pm; u.pn = pn; u.seg = 0; return true;
        } else {
            const int T = i * F.G + F.vcu, nM = 128;
            if (T >= nM * 4) return false;
            int pm, pn; tile_map(T, nM, 4, pm, pn);
            u.A = (const char*)(F.Z() + (size_t)pm * 256 * FFW); u.B = (const char*)(F.W(W_F2) + (size_t)pn * 256 * FFW); u.pm = pm; u.pn = pn; u.seg = 0; return true;
        }
    }
};

#ifndef EPI_MASK
#define EPI_MASK 30
#endif
#define EPI_EN(k) ((EPI_MASK >> (k)) & 1)
struct GEpi {
    Frame F;
    __device__ __forceinline__ void operator()(const f32x4 (&acc)[2][2][4][2], const pg8::Unit& u, int wr, int wc, int fr, int fq) const {
        const int kind = F.kind, l = F.l, c = F.c;
        asm volatile("" : "+v"(fr), "+v"(fq));
        const int row0 = wr * 64 + fr, col0 = wc * 32 + 8 * fq;
        if (EPI_EN(1) && kind == K_G1) {
            const int lt = u.pm, pn = u.pn;
            bf16_t* dst; int ldo;
            if (pn == 4 || pn == 5) { const int kvrow0 = lt < 64 ? (lt >> 4) * KVLEN + CTXL + (lt & 15) * 256 : (lt - 64) * KVLEN; dst = (pn == 4 ? F.Kb() : F.Vb()) + (size_t)kvrow0 * 256; ldo = 256; }
            else { dst = F.Z() + (size_t)lt * 256 * ZP + pn * 256; ldo = ZP; }
            const int act = pn >= 26 ? 2 : (pn >= 22 ? 1 : 0);
            if (pn >= 10 && pn < 18) {
                bf16_t* ud = F.Z() + (size_t)lt * 256 * ZP + CSC + (pn - 10) * 128;
#pragma unroll
                for (int ai = 0; ai < 2; ++ai)
#pragma unroll
                    for (int m = 0; m < 4; ++m) { const f32x4 c0 = acc[ai][0][m][0], c1 = acc[ai][0][m][1], x0 = acc[ai][1][m][0], x1 = acc[ai][1][m][1];
                        u32x4 w; w.x = cvt_pk_bf16(c0[0] * x0[0], c0[1] * x0[1]); w.y = cvt_pk_bf16(c0[2] * x0[2], c0[3] * x0[3]); w.z = cvt_pk_bf16(c1[0] * x1[0], c1[1] * x1[1]); w.w = cvt_pk_bf16(c1[2] * x1[2], c1[3] * x1[3]);
                        *(u32x4*)(ud + (size_t)(row0 + ai * 128 + m * 16) * ZP + col0) = w; }
                return;
            }
#pragma unroll
            for (int ai = 0; ai < 2; ++ai)
#pragma unroll
                for (int m = 0; m < 4; ++m) { bf16_t* rowp = dst + (size_t)(row0 + ai * 128 + m * 16) * ldo + col0;
#pragma unroll
                    for (int bj = 0; bj < 2; ++bj) { f32x4 v0 = acc[ai][bj][m][0], v1 = acc[ai][bj][m][1];
                        if (act == 1) { _Pragma("unroll") for (int e = 0; e < 4; ++e) { v0[e] = gelu_tanh(v0[e]); v1[e] = gelu_tanh(v1[e]); } }
                        else if (act == 2) { _Pragma("unroll") for (int e = 0; e < 4; ++e) { v0[e] = fast_sigmoid(v0[e]); v1[e] = fast_sigmoid(v1[e]); } }
                        u32x4 w; w.x = cvt_pk_bf16(v0[0], v0[1]); w.y = cvt_pk_bf16(v0[2], v0[3]); w.z = cvt_pk_bf16(v1[0], v1[1]); w.w = cvt_pk_bf16(v1[2], v1[3]);
                        *(u32x4*)(rowp + bj * 128) = w; } }
        } else if (EPI_EN(2) && kind == K_G2) {
            const int lt = u.pm, pn = u.pn, seg = u.seg;
            const bf16_t* gate = F.Z() + (size_t)lt * 256 * ZP + CGT + seg * 1024 + pn * 256;
            bf16_t* mg = F.Z() + (size_t)lt * 256 * ZP + CQ + pn * 256;
#pragma unroll
            for (int ai = 0; ai < 2; ++ai) {
                u32x4 gq[4][2], pq[4][2];
#pragma unroll
                for (int m = 0; m < 4; ++m)
#pragma unroll
                    for (int bj = 0; bj < 2; ++bj) { const size_t off = (size_t)(row0 + ai * 128 + m * 16) * ZP + col0 + bj * 128;
                        gq[m][bj] = *(const u32x4*)(gate + off); if (seg > 0) pq[m][bj] = *(const u32x4*)(mg + off); }
#pragma unroll
                for (int m = 0; m < 4; ++m)
#pragma unroll
                    for (int bj = 0; bj < 2; ++bj) { const size_t off = (size_t)(row0 + ai * 128 + m * 16) * ZP + col0 + bj * 128;
                        const u32x4 g = gq[m][bj]; const f32x4 a0 = acc[ai][bj][m][0], a1 = acc[ai][bj][m][1];
                        float v[8] = {a0[0] * bf_lo(g.x), a0[1] * bf_hi(g.x), a0[2] * bf_lo(g.y), a0[3] * bf_hi(g.y), a1[0] * bf_lo(g.z), a1[1] * bf_hi(g.z), a1[2] * bf_lo(g.w), a1[3] * bf_hi(g.w)};
                        if (seg > 0) { const u32x4 p = pq[m][bj];
                            v[0] += bf_lo(p.x); v[1] += bf_hi(p.x); v[2] += bf_lo(p.y); v[3] += bf_hi(p.y); v[4] += bf_lo(p.z); v[5] += bf_hi(p.z); v[6] += bf_lo(p.w); v[7] += bf_hi(p.w); }
                        u32x4 w; w.x = cvt_pk_bf16(v[0], v[1]); w.y = cvt_pk_bf16(v[2], v[3]); w.z = cvt_pk_bf16(v[4], v[5]); w.w = cvt_pk_bf16(v[6], v[7]);
                        *(u32x4*)(mg + off) = w; }
                asm volatile("" ::: "memory");
            }
        } else if (EPI_EN(3) && (kind == K_G3 || kind == K_G5)) {
            const int pn = u.pn; const bool g3 = (kind == K_G3);
            bool lat; size_t r0; int b;
            if (g3) { const int lt = u.pm; lat = lt < 64; r0 = lat ? (size_t)(64 * c + lt) * 256 : (size_t)(4 * c + lt - 64) * 256; b = lat ? 4 * c + (lt >> 4) : 8; }
            else { const int pm = u.pm; lat = pm < 128; r0 = lat ? (size_t)pm * 256 : (size_t)(pm - 128) * 256; b = lat ? (pm >> 4) : 8; }
            const float* base = lat ? ((g3 && l == 0) ? F.x : F.out) : ((g3 && l == 0) ? F.ctx : F.XC());
            float* fout = lat ? F.out : F.XC();
            base += r0 * DM + pn * 256; fout += r0 * DM + pn * 256;
            const float* vec = F.MOD(b) + (g3 ? 2048 : 5120) + pn * 256 + col0;
            f32x4 vv[2][2];
#pragma unroll
            for (int bj = 0; bj < 2; ++bj) { vv[bj][0] = *(const f32x4*)(vec + bj * 128); vv[bj][1] = *(const f32x4*)(vec + bj * 128 + 4); }
#pragma unroll
            for (int ai = 0; ai < 2; ++ai) {
                f32x4 bq0[4][2], bq1[4][2];
#pragma unroll
                for (int m = 0; m < 4; ++m)
#pragma unroll
                    for (int bj = 0; bj < 2; ++bj) { const size_t off = (size_t)(row0 + ai * 128 + m * 16) * DM + col0 + bj * 128;
                        bq0[m][bj] = *(const f32x4*)(base + off); bq1[m][bj] = *(const f32x4*)(base + off + 4); }
#pragma unroll
                for (int m = 0; m < 4; ++m)
#pragma unroll
                    for (int bj = 0; bj < 2; ++bj) { const size_t off = (size_t)(row0 + ai * 128 + m * 16) * DM + col0 + bj * 128;
                        *(f32x4*)(fout + off) = bq0[m][bj] + vv[bj][0] * acc[ai][bj][m][0]; *(f32x4*)(fout + off + 4) = bq1[m][bj] + vv[bj][1] * acc[ai][bj][m][1]; }
                asm volatile("" ::: "memory");
            }
        } else if (EPI_EN(4)) {
            bf16_t* dst = F.Z() + (size_t)u.pm * 256 * FFW + u.pn * 128;
#pragma unroll
            for (int ai = 0; ai < 2; ++ai)
#pragma unroll
                for (int m = 0; m < 4; ++m) { bf16_t* rowp = dst + (size_t)(row0 + ai * 128 + m * 16) * FFW + col0;
                    const f32x4 g0 = acc[ai][0][m][0], g1 = acc[ai][0][m][1], u0 = acc[ai][1][m][0], u1 = acc[ai][1][m][1];
                    u32x4 w; w.x = cvt_pk_bf16(silu_f(g0[0]) * u0[0], silu_f(g0[1]) * u0[1]); w.y = cvt_pk_bf16(silu_f(g0[2]) * u0[2], silu_f(g0[3]) * u0[3]);
                    w.z = cvt_pk_bf16(silu_f(g1[0]) * u1[0], silu_f(g1[1]) * u1[1]); w.w = cvt_pk_bf16(silu_f(g1[2]) * u1[2], silu_f(g1[3]) * u1[3]);
                    *(u32x4*)rowp = w; }
        }
    }
};

namespace att {
constexpr int D = 128, NW = 8, QBLK = 32, KVBLK = 64;
constexpr float SCALE = 0.088388347648318440f;
constexpr float THR = 8.f;
constexpr int LDQ = ZP, LDK = 256, LDO = ZP;
constexpr size_t SHM_V = KVBLK * D * 2, SHM_K = KVBLK * D * 2, SHM_ATTN = 2 * SHM_V + 2 * SHM_K + NW * 64 * 4;
constexpr int OST_OFF = (int)SHM_ATTN;
static_assert(SHM_ATTN + NW * 32 * 272 <= MISC_OFF, "attention lds");
#define KSWZ(row, colB) ((row) * 256 + ((colB) ^ (((row) & 7) << 4)))
#define SBAR() __builtin_amdgcn_sched_barrier(0)
__device__ __forceinline__ int crow(int r, int hi) { return (r & 3) + 8 * (r >> 2) + 4 * hi; }
__device__ __forceinline__ void partialSM(f32x16& p0, f32x16& p1, float& m_reg, float& mn, float& alpha) {
  constexpr float C = SCALE * 1.4426950408889634f;
  float pmax = p0[0]; for (int r = 1; r < 16; ++r) pmax = fmaxf(pmax, p0[r]); for (int r = 0; r < 16; ++r) pmax = fmaxf(pmax, p1[r]);
  { auto rr = __builtin_amdgcn_permlane32_swap(__float_as_uint(pmax), __float_as_uint(pmax), false, false);
    pmax = fmaxf(__uint_as_float(rr[0]), __uint_as_float(rr[1])); }
  if (__builtin_expect(__all(pmax - m_reg <= THR / SCALE), 1)) { mn = m_reg; alpha = 1.f; }
  else { mn = fmaxf(m_reg, pmax); alpha = __builtin_amdgcn_exp2f((m_reg - mn) * C); m_reg = mn; }
  float mnC = -mn * C;
  for (int r = 0; r < 16; ++r) p0[r] = fmaf(p0[r], C, mnC); for (int r = 0; r < 16; ++r) p1[r] = fmaf(p1[r], C, mnC);
  for (int r = 0; r < 16; ++r) p0[r] = __builtin_amdgcn_exp2f(p0[r]);
}
__device__ __forceinline__ void finishSM(f32x16& p0, f32x16& p1, float alpha, float& l_reg, bf16x8& pa0, bf16x8& pa1, bf16x8& pa2, bf16x8& pa3) {
  for (int r = 0; r < 16; ++r) p1[r] = __builtin_amdgcn_exp2f(p1[r]);
  float ps = 0; for (int r = 0; r < 16; ++r) ps += p0[r]; for (int r = 0; r < 16; ++r) ps += p1[r];
  { auto rr = __builtin_amdgcn_permlane32_swap(__float_as_uint(ps), __float_as_uint(ps), false, false);
    ps = __uint_as_float(rr[0]) + __uint_as_float(rr[1]); }
  l_reg = l_reg * alpha + ps;
#define PK4(P, BASE, OUT) do { unsigned a0 = cvt_pk_bf16(P[BASE + 0], P[BASE + 1]), a1 = cvt_pk_bf16(P[BASE + 2], P[BASE + 3]);   \
    unsigned b0 = cvt_pk_bf16(P[BASE + 4], P[BASE + 5]), b1 = cvt_pk_bf16(P[BASE + 6], P[BASE + 7]);                              \
    auto r0 = __builtin_amdgcn_permlane32_swap(a0, b0, false, false); auto r1 = __builtin_amdgcn_permlane32_swap(a1, b1, false, false); \
    u32x4 w = {r0[0], r1[0], r0[1], r1[1]}; OUT = *reinterpret_cast<bf16x8*>(&w); } while (0)
  PK4(p0, 0, pa0); PK4(p0, 8, pa1); PK4(p1, 0, pa2); PK4(p1, 8, pa3);
#undef PK4
}
__device__ __forceinline__ void qkt(f32x16& p0, f32x16& p1, const bf16_t* Ks, const bf16x8* qr, int r32, int hi) {
  p0 = f32x16{}; p1 = f32x16{};
#pragma unroll
  for (int d0 = 0; d0 < 8; ++d0) { int cb = (d0 * 16 + hi * 8) * 2;
    bf16x8 b0 = *reinterpret_cast<const bf16x8*>((const char*)Ks + KSWZ(r32, cb));
    bf16x8 b1 = *reinterpret_cast<const bf16x8*>((const char*)Ks + KSWZ(32 + r32, cb));
    p0 = __builtin_amdgcn_mfma_f32_32x32x16_bf16(b0, qr[d0], p0, 0, 0, 0);
    p1 = __builtin_amdgcn_mfma_f32_32x32x16_bf16(b1, qr[d0], p1, 0, 0, 0); }
}
__device__ __forceinline__ int v_st(int k, int c) { const int kk = (k & ~0xC) | ((k & 4) << 1) | ((k & 8) >> 1); return ((kk >> 3) * 4 + (c >> 5)) * 512 + ((kk & 7) * 32 + (c & 31)) * 2; }
__device__ __forceinline__ int v_rd_base(int lane) { return ((lane & 3) << 3) | (((lane >> 2) & 3) << 6) | (((lane >> 4) & 1) << 5) | (((lane >> 5) & 1) << 8); }
constexpr int v_rd_off(int d0, int ks, int half) { return d0 * 512 + ks * 4096 + half * 2048; }
template <int OFF> __device__ __forceinline__ s16x4 tr_read(int vb) {
  s16x4 r; asm volatile("ds_read_b64_tr_b16 %0, %1 offset:%2" : "=&v"(r) : "v"(vb), "i"(OFF) : "memory"); return r;
}
template <int D0> __device__ __forceinline__ void pv_one(f32x16& od, int vb, bf16x8 pa0, bf16x8 pa1, bf16x8 pa2, bf16x8 pa3) {
  const s16x4 l0 = tr_read<v_rd_off(D0, 0, 0)>(vb), h0 = tr_read<v_rd_off(D0, 0, 1)>(vb), l1 = tr_read<v_rd_off(D0, 1, 0)>(vb), h1 = tr_read<v_rd_off(D0, 1, 1)>(vb);
  const s16x4 l2 = tr_read<v_rd_off(D0, 2, 0)>(vb), h2 = tr_read<v_rd_off(D0, 2, 1)>(vb), l3 = tr_read<v_rd_off(D0, 3, 0)>(vb), h3 = tr_read<v_rd_off(D0, 3, 1)>(vb);
  asm volatile("s_waitcnt lgkmcnt(0)" ::: "memory"); SBAR();
#define PK(L, H) (bf16x8){L[0], L[1], L[2], L[3], H[0], H[1], H[2], H[3]}
  od = __builtin_amdgcn_mfma_f32_32x32x16_bf16(pa0, PK(l0, h0), od, 0, 0, 0);
  od = __builtin_amdgcn_mfma_f32_32x32x16_bf16(pa1, PK(l1, h1), od, 0, 0, 0);
  od = __builtin_amdgcn_mfma_f32_32x32x16_bf16(pa2, PK(l2, h2), od, 0, 0, 0);
  od = __builtin_amdgcn_mfma_f32_32x32x16_bf16(pa3, PK(l3, h3), od, 0, 0, 0);
#undef PK
}
__device__ __forceinline__ void pv_d0(f32x16* o, int vb, bf16x8 pa0, bf16x8 pa1, bf16x8 pa2, bf16x8 pa3) {
  pv_one<0>(o[0], vb, pa0, pa1, pa2, pa3); pv_one<1>(o[1], vb, pa0, pa1, pa2, pa3); pv_one<2>(o[2], vb, pa0, pa1, pa2, pa3); pv_one<3>(o[3], vb, pa0, pa1, pa2, pa3);
}
__device__ __forceinline__ void attn_dense_body(const bf16_t* Qb, const bf16_t* __restrict__ Kh, const bf16_t* __restrict__ Vh, bf16_t* Ob, int seq, char* lds, int wave_s) {
  const int tid = tid_opaque(wave_s), wid = __builtin_amdgcn_readfirstlane(tid >> 6), lane = tid & 63, r32 = lane & 31, hi = lane >> 5;
  bf16_t* V_lds = (bf16_t*)lds; bf16_t* K_lds = (bf16_t*)(lds + 2 * SHM_V);
  float* ws = (float*)(lds + 2 * SHM_V + 2 * SHM_K) + wid * 64; float* li_l = ws; float* al_l = ws + 32;
  float m_reg = -1e30f, l_reg = 0; f32x16 o[4] = {}; bf16x8 qr[8];
  const bf16_t* Qw = Qb + (long)(wid * QBLK + r32) * LDQ + hi * 8;
#pragma unroll
  for (int d0 = 0; d0 < 8; ++d0) qr[d0] = *reinterpret_cast<const bf16x8*>(Qw + d0 * 16);
  const int sr = tid >> 4, sc = (tid & 15) * 8, vst0 = v_st(sr, sc), vst1 = v_st(32 + sr, sc);
  const int vb0 = (int)(uintptr_t)V_lds + v_rd_base(lane);
  struct { bf16x8 vs0, vs1, ks0, ks1; } sr_[2];
#define SLOAD(i, k0) do { sr_[i].vs0 = *reinterpret_cast<const bf16x8*>(&Vh[(long)((k0) + sr) * LDK + sc]); sr_[i].vs1 = *reinterpret_cast<const bf16x8*>(&Vh[(long)((k0) + 32 + sr) * LDK + sc]); \
    sr_[i].ks0 = *reinterpret_cast<const bf16x8*>(&Kh[(long)((k0) + sr) * LDK + sc]); sr_[i].ks1 = *reinterpret_cast<const bf16x8*>(&Kh[(long)((k0) + 32 + sr) * LDK + sc]); } while (0)
#define SWRITE(b, i) do { *(bf16x8*)((char*)V_lds + (b) * SHM_V + vst0) = sr_[i].vs0;          \
    *(bf16x8*)((char*)V_lds + (b) * SHM_V + vst1) = sr_[i].vs1; int kc = sc * 2;               \
    *(bf16x8*)((char*)K_lds + (b) * SHM_K + KSWZ(sr, kc)) = sr_[i].ks0;                       \
    *(bf16x8*)((char*)K_lds + (b) * SHM_K + KSWZ(32 + sr, kc)) = sr_[i].ks1; } while (0)
#define SWAIT() asm volatile("s_waitcnt vmcnt(4)" ::: "memory")
#define RESC(a) do { if (__any((a) < 1.f)) { if (hi == 0) al_l[r32] = (a); asm volatile("s_waitcnt lgkmcnt(0)" ::: "memory"); \
    for (int d = 0; d < 4; ++d) for (int r = 0; r < 16; ++r) o[d][r] *= al_l[crow(r, hi)]; } } while (0)
  f32x16 pA0, pA1, pB0, pB1; float mnA, mnB, alA, alB; bf16x8 pa0, pa1, pa2, pa3; const int NT = seq / KVBLK;
  constexpr int SE = 0, SO = 1;
  SLOAD(SE, 0); asm volatile("s_waitcnt vmcnt(0)" ::: "memory"); SWRITE(0, SE); __syncthreads();
  qkt(pA0, pA1, K_lds, qr, r32, hi); partialSM(pA0, pA1, m_reg, mnA, alA);
  SLOAD(SO, KVBLK); if (2 < NT) SLOAD(SE, 2 * KVBLK);
  SWAIT(); SWRITE(1, SO); __syncthreads();
  for (int j = 1; j + 1 < NT; j += 2) {
    SBAR(); qkt(pB0, pB1, (bf16_t*)((char*)K_lds + SHM_K), qr, r32, hi);
    finishSM(pA0, pA1, alA, l_reg, pa0, pa1, pa2, pa3); SBAR();
    SLOAD(SO, (j + 2) * KVBLK); SBAR();
    pv_d0(o, vb0, pa0, pa1, pa2, pa3); partialSM(pB0, pB1, m_reg, mnB, alB);
    __syncthreads(); SWAIT(); SWRITE(0, SE);
    RESC(alB); __syncthreads();
    SBAR(); qkt(pA0, pA1, K_lds, qr, r32, hi);
    finishSM(pB0, pB1, alB, l_reg, pa0, pa1, pa2, pa3); SBAR();
    if (j + 3 < NT) SLOAD(SE, (j + 3) * KVBLK); SBAR();
    pv_d0(o, vb0 + (int)SHM_V, pa0, pa1, pa2, pa3); partialSM(pA0, pA1, m_reg, mnA, alA);
    __syncthreads(); SWAIT(); SWRITE(1, SO);
    RESC(alA); __syncthreads();
  }
  SBAR(); qkt(pB0, pB1, (bf16_t*)((char*)K_lds + SHM_K), qr, r32, hi);
  finishSM(pA0, pA1, alA, l_reg, pa0, pa1, pa2, pa3); SBAR();
  pv_d0(o, vb0, pa0, pa1, pa2, pa3); partialSM(pB0, pB1, m_reg, mnB, alB);
  __syncthreads(); RESC(alB);
  finishSM(pB0, pB1, alB, l_reg, pa0, pa1, pa2, pa3); SBAR();
  pv_d0(o, vb0 + (int)SHM_V, pa0, pa1, pa2, pa3);
  if (hi == 0) li_l[r32] = l_reg; asm volatile("s_waitcnt lgkmcnt(0)" ::: "memory");
  float rli[16];
#pragma unroll
  for (int r = 0; r < 16; ++r) rli[r] = __builtin_amdgcn_rcpf(li_l[crow(r, hi)]);
  bf16_t* Ow = Ob + (long)(wid * QBLK) * LDO;
  {
    bf16_t* stg = (bf16_t*)(lds + OST_OFF) + wid * (32 * 136);
#pragma unroll
    for (int r = 0; r < 16; ++r) { const int orow = crow(r, hi);
#pragma unroll
      for (int d0 = 0; d0 < 4; ++d0) { const float v = o[d0][r] * rli[r]; stg[orow * 136 + d0 * 32 + r32] = (bf16_t)(cvtpk_nv(v, v) & 0xffffu); } }
    asm volatile("s_waitcnt lgkmcnt(0)" ::: "memory");
#pragma unroll
    for (int i = 0; i < 8; ++i) { const int row = i * 4 + (lane >> 4), chn = lane & 15; const u32x4 v = *(const u32x4*)(stg + row * 136 + chn * 8); *(u32x4*)(Ow + (long)row * LDO + chn * 8) = v; }
  }
  __syncthreads();
#undef SLOAD
#undef SWRITE
#undef SWAIT
#undef RESC
}
#undef KSWZ
#undef SBAR
}

__device__ __forceinline__ void p0_transpose_item(const float* W, int K, int N, bf16_t* WT, int mode, LAS float* scr, int item, int lane) {
    const int nblk = N / 32, kb = item / nblk, nb = item % nblk, k0 = 64 * kb, n0 = 32 * nb;
    const float wscale = (mode == 2) ? -1.4426950408889634f : 1.0f;
#pragma unroll 8
    for (int i = 0; i < 32; ++i) { const int kk = 2 * i + (lane >> 5); scr[kk * 33 + (lane & 31)] = W[(size_t)(k0 + kk) * N + n0 + (lane & 31)] * wscale; }
    asm volatile("s_waitcnt lgkmcnt(0)" ::: "memory");
    int r0 = n0;
    if (mode == 1) r0 = n0 < FFW ? 256 * (n0 / 128) + (n0 % 128) : 256 * ((n0 - FFW) / 128) + 128 + ((n0 - FFW) % 128);
    if (mode == 3 && n0 >= CSC && n0 < CSC + 2048) { const int rel = n0 - CSC;
        r0 = rel < 1024 ? CSC + 256 * (rel / 128) + (rel % 128) : CSC + 256 * ((rel - 1024) / 128) + 128 + ((rel - 1024) % 128); }
    const int c = lane & 7;
#pragma unroll
    for (int j = 0; j < 4; ++j) { const int n = (lane >> 3) + 8 * j; const LAS float* s = scr + (8 * c) * 33 + n;
        u32x4 o; o.x = cvt_pk_bf16(s[0 * 33], s[1 * 33]); o.y = cvt_pk_bf16(s[2 * 33], s[3 * 33]); o.z = cvt_pk_bf16(s[4 * 33], s[5 * 33]); o.w = cvt_pk_bf16(s[6 * 33], s[7 * 33]);
        *(u32x4*)(WT + (size_t)(r0 + n) * K + k0 + 8 * c) = o; }
    asm volatile("s_waitcnt lgkmcnt(0)" ::: "memory");
}

__device__ __forceinline__ void phase_p0(CArgs a, const Frame& F, LAS unsigned char* lds) {
    const int tid = tid_opaque(F.wave_s), lane = tid & 63, wave = __builtin_amdgcn_readfirstlane(tid >> 6);
    for (int it = bid_opaque(); it < 96; it += gridDim.x) {
        const int l = it / 48, cg0 = (it % 48) * 128;
        LAS float* sv = (LAS float*)lds;
        LAS float* red = (LAS float*)(lds + 9 * 1024 * 4);
        for (int e = tid; e < 9 * 1024; e += NTHREADS) { const int b = e >> 10, k = e & 1023; const float v = b < 8 ? a->in[1][b * 1024 + k] : a->in[3][k]; sv[e] = v * fast_sigmoid(v); }
        __syncthreads();
        const int kq = tid >> 7, col = tid & 127;
        float accv[9];
#pragma unroll
        for (int b = 0; b < 9; ++b) accv[b] = 0.f;
        const float* wp = a->in[4] + ((size_t)l * 1024 + kq * 256) * 6144 + cg0 + col;
#pragma unroll 4
        for (int k = 0; k < 256; ++k) { const float w = wp[(size_t)k * 6144];
#pragma unroll
            for (int b = 0; b < 9; ++b) accv[b] += sv[b * 1024 + kq * 256 + k] * w; }
#pragma unroll
        for (int b = 0; b < 9; ++b) red[(kq * 9 + b) * 128 + col] = accv[b];
        __syncthreads();
        if (tid < 128) {
#pragma unroll
            for (int b = 0; b < 9; ++b) { const float s = red[(0 * 9 + b) * 128 + tid] + red[(1 * 9 + b) * 128 + tid] + red[(2 * 9 + b) * 128 + tid] + red[(3 * 9 + b) * 128 + tid];
                ((float*)(a->ws + WS_MOD))[(size_t)(l * 9 + b) * 6144 + cg0 + tid] = s + a->in[5][l * 6144 + cg0 + tid]; }
        }
        __syncthreads();
    }
    if (bid_opaque() == gridDim.x - 1) {
        for (int e = tid; e < 2048; e += NTHREADS) { const int pos = e >> 5, f = e & 31; const float inv = __builtin_amdgcn_exp2f(-(float)f * (13.287712379549449f / 32.0f)); const float rev = (float)pos * inv * 0.15915494309189535f;
            const float fr_ = rev - floorf(rev);
            ((f32x2*)(a->ws + WS_ROPE))[e] = (f32x2){__builtin_amdgcn_cosf(fr_), __builtin_amdgcn_sinf(fr_)}; }
    }
    LAS float* scr = (LAS float*)(lds + 57344 + wave * 8704);
    const int gw = bid_opaque() * NWAVES + wave, NGW = gridDim.x * NWAVES;
    constexpr int I_IN = 16 * 304, I_SQ = 16 * 32, I_F1 = 16 * 176, I_F2 = 44 * 32, I_LRU = 256, I_LAYER = I_IN + 4 * I_SQ + I_F1 + I_F2 + I_LRU;
    for (int it = gw; it < 2 * I_LAYER; it += NGW) {
        const int l = it / I_LAYER; int r = it % I_LAYER;
        unsigned char* wl = a->ws + WS_W + (size_t)l * W_LAYER;
        if (r < I_IN) { p0_transpose_item(a->in[8] + (size_t)l * DM * NIN, DM, NIN, (bf16_t*)(wl + W_IN), 3, scr, r, lane); continue; } r -= I_IN;
        if (r < I_SQ) { p0_transpose_item(a->in[11] + (size_t)l * DM * DM, DM, DM, (bf16_t*)(wl + W_AO), 0, scr, r, lane); continue; } r -= I_SQ;
        if (r < I_SQ) { p0_transpose_item(a->in[14] + (size_t)l * DM * DM, DM, DM, (bf16_t*)(wl + W_SO), 0, scr, r, lane); continue; } r -= I_SQ;
        if (r < I_SQ) { p0_transpose_item(a->in[22] + (size_t)l * DM * DM, DM, DM, (bf16_t*)(wl + W_LO), 0, scr, r, lane); continue; } r -= I_SQ;
        if (r < I_SQ) { p0_transpose_item(a->in[23] + (size_t)l * DM * DM, DM, DM, (bf16_t*)(wl + W_MO), 0, scr, r, lane); continue; } r -= I_SQ;
        if (r < I_F1) { p0_transpose_item(a->in[24] + (size_t)l * DM * 2 * FFW, DM, 2 * FFW, (bf16_t*)(wl + W_F1), 1, scr, r, lane); continue; } r -= I_F1;
        if (r < I_F2) { p0_transpose_item(a->in[25] + (size_t)l * FFW * DM, FFW, DM, (bf16_t*)(wl + W_F2), 0, scr, r, lane); continue; } r -= I_F2;
        { const int mat = r >> 3, d = mat >> 4, g = (mat >> 3) & 1, n = mat & 7;
          const float* src = (g == 0 ? a->in[17] : a->in[19]) + (size_t)((l * 2 + d) * 8 + n) * 16384;
          p0_transpose_item(src, 128, 128, (bf16_t*)(wl + W_LRU) + (size_t)((d * 2 + g) * 8 + n) * 16384, 2, scr, r & 7, lane); }
    }
}

__device__ __forceinline__ void phase_norm(CArgs a, const Frame& F, int which) {
    const int tid_ = tid_opaque(F.wave_s); const int lane = tid_ & 63, wave = __builtin_amdgcn_readfirstlane(tid_ >> 6);
    const int gw = bid_opaque() * NWAVES + wave, NGW = gridDim.x * NWAVES;
    const bool first = (which == 0 && F.l == 0);
    const int nrows = (which == 1 && F.l == 1) ? LROWS : ROWS;
    const float* g = (which == 0 ? a->in[6] : a->in[7]) + F.l * DM;
    for (int m = gw; m < nrows; m += NGW) {
        const bool lat = m < LROWS;
        const float* src = lat ? (first ? F.x : F.out) + (size_t)m * DM : (first ? F.ctx : F.XC()) + (size_t)(m - LROWS) * DM;
        const int b = lat ? (m >> 12) : 8;
        const float* md = F.MOD(b) + (which == 0 ? 0 : 3072);
        f32x4 v[4]; float s = 0.f;
#pragma unroll
        for (int j = 0; j < 4; ++j) { v[j] = *(const f32x4*)(src + 4 * lane + 256 * j); s += (v[j].x * v[j].x + v[j].y * v[j].y) + (v[j].z * v[j].z + v[j].w * v[j].w); }
        const float rstd = rsqrtf(wave_sum(s) * (1.f / DM) + EPS);
        bf16_t* dst = F.H() + (size_t)m * DM;
#pragma unroll
        for (int j = 0; j < 4; ++j) { const int col = 4 * lane + 256 * j;
            const f32x4 gg = *(const f32x4*)(g + col), sh = *(const f32x4*)(md + col), sc = *(const f32x4*)(md + 1024 + col);
            const f32x4 h = (v[j] * rstd * gg) * (sc + 1.0f) + sh;
            u32x2 w; w.x = cvt_pk_bf16(h.x, h.y); w.y = cvt_pk_bf16(h.z, h.w); *(u32x2*)(dst + col) = w; }
    }
}
__device__ __forceinline__ void phase_final(CArgs a, const Frame& F) {
    const int tid_ = tid_opaque(F.wave_s); const int lane = tid_ & 63, wave = __builtin_amdgcn_readfirstlane(tid_ >> 6);
    const int gw = bid_opaque() * NWAVES + wave, NGW = gridDim.x * NWAVES;
    const float* g = a->in[26];
    for (int m = gw; m < LROWS; m += NGW) {
        float* p = F.out + (size_t)m * DM;
        f32x4 v[4]; float s = 0.f;
#pragma unroll
        for (int j = 0; j < 4; ++j) { v[j] = *(const f32x4*)(p + 4 * lane + 256 * j); s += (v[j].x * v[j].x + v[j].y * v[j].y) + (v[j].z * v[j].z + v[j].w * v[j].w); }
        const float rstd = rsqrtf(wave_sum(s) * (1.f / DM) + EPS);
#pragma unroll
        for (int j = 0; j < 4; ++j) { const int col = 4 * lane + 256 * j; *(f32x4*)(p + col) = v[j] * rstd * *(const f32x4*)(g + col); }
    }
}

struct QkRow { u32x4 raw[3]; bf16_t* p[3]; bool act[3]; bool lat; int pos; };
__device__ __forceinline__ void qk_load(const Frame& F, int lr, int s, int i, int qd, QkRow& R) {
    const bool lat = lr < CH_L; R.lat = lat;
    int kvrow, prow = 0, pcol = 0;
    if (lat) { const int bl = lr >> 12, t = lr & 4095; kvrow = bl * KVLEN + CTXL + t; prow = t >> 6; pcol = t & 63; }
    else { const int lc = lr - CH_L; kvrow = (lc >> 8) * KVLEN + (lc & 255); }
    R.pos = qd < 2 ? prow : pcol;
#pragma unroll
    for (int it = 0; it < 3; ++it) { const int hs = 4 * it + s;
        R.act[it] = hs < 10 && (lat || F.l == 0 || it == 2) && lr < CH_ROWS;
        R.p[it] = hs < 8 ? F.Z() + (size_t)lr * ZP + hs * 128 + 8 * i : F.Kb() + (size_t)kvrow * 256 + (hs - 8) * 128 + 8 * i;
        if (R.act[it]) R.raw[it] = *(const u32x4*)R.p[it]; }
}
__device__ __forceinline__ void qk_finish(const Frame& F, const float* qg, const float* kg, const f32x2* rope, int s, int i, int qd, const QkRow& R) {
#pragma unroll
    for (int it = 0; it < 3; ++it) {
        if (R.act[it]) {
            const int hs = 4 * it + s; const float* gp = hs < 8 ? qg : kg; const u32x4 raw = R.raw[it];
            float v[8] = {bf_lo(raw.x), bf_hi(raw.x), bf_lo(raw.y), bf_hi(raw.y), bf_lo(raw.z), bf_hi(raw.z), bf_lo(raw.w), bf_hi(raw.w)};
            float ss = 0.f;
#pragma unroll
            for (int e = 0; e < 8; ++e) ss += v[e] * v[e];
            ss += swz_xor<1>(ss); ss += swz_xor<2>(ss); ss += swz_xor<4>(ss); ss += swz_xor<8>(ss);
            const float rstd = rsqrtf(ss * (1.f / 128.f) + EPS);
            const f32x4 g0 = *(const f32x4*)gp, g1 = *(const f32x4*)(gp + 4);
            v[0] *= rstd * g0.x; v[1] *= rstd * g0.y; v[2] *= rstd * g0.z; v[3] *= rstd * g0.w; v[4] *= rstd * g1.x; v[5] *= rstd * g1.y; v[6] *= rstd * g1.z; v[7] *= rstd * g1.w;
            if (R.lat) {
                const f32x2* rp = rope + R.pos * 32 + 8 * (i & 3);
#pragma unroll
                for (int e = 0; e < 8; ++e) { const float pv = swz_xor<4>(v[e]); const f32x2 cs = rp[e]; v[e] = (qd & 1) ? v[e] * cs.x + pv * cs.y : v[e] * cs.x - pv * cs.y; }
            }
            u32x4 w; w.x = cvt_pk_bf16(v[0], v[1]); w.y = cvt_pk_bf16(v[2], v[3]); w.z = cvt_pk_bf16(v[4], v[5]); w.w = cvt_pk_bf16(v[6], v[7]);
            *(u32x4*)R.p[it] = w;
        }
    }
}
__device__ __forceinline__ void phase_qknorm(CArgs a, const Frame& F) {
    const int tid_ = tid_opaque(F.wave_s); const int lane = tid_ & 63, wave = __builtin_amdgcn_readfirstlane(tid_ >> 6);
    const int gw = bid_opaque() * NWAVES + wave, NGW = gridDim.x * NWAVES;
    const int s = lane >> 4, i = lane & 15, qd = i >> 2;
    const float* qg = a->in[9] + F.l * 128 + 8 * i; const float* kg = a->in[10] + F.l * 128 + 8 * i;
    const f32x2* rope = (const f32x2*)(F.ws + WS_ROPE);
    for (int lr = gw; lr < CH_ROWS; lr += 2 * NGW) {
        QkRow R0, R1;
        qk_load(F, lr, s, i, qd, R0); qk_load(F, lr + NGW, s, i, qd, R1);
        qk_finish(F, qg, kg, rope, s, i, qd, R0); qk_finish(F, qg, kg, rope, s, i, qd, R1);
    }
}

__device__ __forceinline__ void phase_sconv(CArgs a, const Frame& F) {
    const int tid_ = tid_opaque(F.wave_s); const int lane = tid_ & 63, wave = __builtin_amdgcn_readfirstlane(tid_ >> 6);
    const int gw = bid_opaque() * NWAVES + wave, NGW = gridDim.x * NWAVES;
    const int nrows = (F.l == 0) ? CH_ROWS : CH_L;
    const float* wsc = a->in[12] + (size_t)F.l * 3 * DM; const float* bsc = a->in[13] + (size_t)F.l * DM;
    for (int it = gw; it < (nrows / 16) * 2; it += NGW) {
        const int run = it >> 1, ch0 = (it & 1) * 512 + lane * 8, lr0 = run * 16;
        int t0, slen;
        if (lr0 < CH_L) { t0 = lr0 & 4095; slen = SEQ; } else { t0 = (lr0 - CH_L) & 255; slen = CTXL; }
        float w0[8], w1[8], w2[8], bb[8];
#pragma unroll
        for (int e = 0; e < 8; ++e) { w0[e] = wsc[ch0 + e]; w1[e] = wsc[DM + ch0 + e]; w2[e] = wsc[2 * DM + ch0 + e]; bb[e] = bsc[ch0 + e]; }
        bf16_t* zr = F.Z() + (size_t)lr0 * ZP + ch0;
        float up[8], uc[8], un[8];
        auto loadu = [&](int dt, float* u, bool valid) {
            if (valid) { const u32x4 cc = *(const u32x4*)(zr + (long)dt * ZP + CSC);
                u[0] = bf_lo(cc.x); u[1] = bf_hi(cc.x); u[2] = bf_lo(cc.y); u[3] = bf_hi(cc.y); u[4] = bf_lo(cc.z); u[5] = bf_hi(cc.z); u[6] = bf_lo(cc.w); u[7] = bf_hi(cc.w); }
            else {
#pragma unroll
                for (int e = 0; e < 8; ++e) u[e] = 0.f; } };
        loadu(-1, up, t0 > 0); loadu(0, uc, true);
#pragma unroll 8
        for (int tt = 0; tt < 16; ++tt) {
            loadu(tt + 1, un, t0 + tt + 1 < slen);
            const u32x4 bq = *(const u32x4*)(zr + (long)tt * ZP + CSB);
            const float bv[8] = {bf_lo(bq.x), bf_hi(bq.x), bf_lo(bq.y), bf_hi(bq.y), bf_lo(bq.z), bf_hi(bq.z), bf_lo(bq.w), bf_hi(bq.w)};
            float o[8];
#pragma unroll
            for (int e = 0; e < 8; ++e) { o[e] = bv[e] * (bb[e] + w0[e] * up[e] + w1[e] * uc[e] + w2[e] * un[e]); up[e] = uc[e]; uc[e] = un[e]; }
            u32x4 w; w.x = cvt_pk_bf16(o[0], o[1]); w.y = cvt_pk_bf16(o[2], o[3]); w.z = cvt_pk_bf16(o[4], o[5]); w.w = cvt_pk_bf16(o[6], o[7]);
            *(u32x4*)(zr + (long)tt * ZP + CSB) = w;
        }
    }
}

constexpr int L_XS = 0, L_XS_STRIDE = 136, L_YT = 17408, L_YT_STRIDE = 132, L_WV = L_YT + 64 * L_YT_STRIDE * 4, L_WV_BYTES = 2 * 16 * 68 * 4, L_CW = L_WV + 8 * L_WV_BYTES;
constexpr int L_XS2 = L_CW + 5 * 128 * 4;
static_assert(L_XS2 + 64 * L_XS_STRIDE * 2 <= MISC_OFF, "lru lds");
struct LruCtx { bf16x8 wf[2][2][4]; float pba[2], pbx[2], spl[2]; };
__device__ __forceinline__ void lru_setup(CArgs a, const Frame& F, int n, LruCtx& C) {
    const int tid = tid_opaque(F.wave_s), lane = tid & 63, wave = __builtin_amdgcn_readfirstlane(tid >> 6), fr = lane & 15, fq = lane >> 4;
    const int l = F.l, ech = wave * 16 + fr, chg = n * 128 + ech;
    const bf16_t* wt = F.W(W_LRU) + (size_t)n * 16384 + (size_t)ech * 128 + fq * 8;
#pragma unroll
    for (int d = 0; d < 2; ++d)
#pragma unroll
        for (int g = 0; g < 2; ++g)
#pragma unroll
            for (int ks = 0; ks < 4; ++ks) C.wf[d][g][ks] = *(const bf16x8*)(wt + (size_t)((d * 2 + g) * 8) * 16384 + ks * 32);
#pragma unroll
    for (int d = 0; d < 2; ++d) { C.pba[d] = a->in[18][(l * 2 + d) * DM + chg] * -1.4426950408889634f; C.pbx[d] = a->in[20][(l * 2 + d) * DM + chg] * -1.4426950408889634f;   const float lam = a->in[21][(l * 2 + d) * DM + chg];
        const float ey = __builtin_amdgcn_exp2f(-lam * 1.4426950408889634f);
        const float sp_small = ey * (1.0f + ey * (-0.5f + ey * (0.33333334f + ey * (-0.25f + ey * 0.2f))));
        const float sp_big = (lam < -15.f) ? -lam : __builtin_amdgcn_logf(1.0f + ey) * 0.6931471805599453f;
        C.spl[d] = (ey < 0.125f ? sp_small : sp_big) * (8.0f * 1.4426950408889634f); }
}
struct XRows { u32x4 r[4][2]; };
__device__ __forceinline__ void lru_load_rows(const Frame& F, int tile, int n, XRows& X) {
    const int tid = tid_opaque(F.wave_s), t = tid >> 3, c0 = (tid & 7) * 16;
    const int lrow0 = tile < 256 ? tile * 64 : CH_L + (tile - 256) * 64;
#pragma unroll
    for (int k = 0; k < 4; ++k) { int row = lrow0 + t + k - 2; row = row < 0 ? 0 : (row > CH_ROWS - 1 ? CH_ROWS - 1 : row);
        const bf16_t* zr = F.Z() + (size_t)row * ZP + CRX + n * 128 + c0; X.r[k][0] = *(const u32x4*)zr; X.r[k][1] = *(const u32x4*)(zr + 8); }
}
__device__ __forceinline__ void lru_item(CArgs a, const Frame& F, LAS unsigned char* lds, int pass, int tile, int n, const LruCtx& C, const float cy, const XRows& X, const int xbuf) {
    const int tid = tid_opaque(F.wave_s), lane = tid & 63, wave = __builtin_amdgcn_readfirstlane(tid >> 6), fr = lane & 15, fq = lane >> 4;
    const int l = F.l;
    LAS bf16_t* xs = (LAS bf16_t*)(lds + (xbuf ? L_XS2 : L_XS)); LAS float* yt = (LAS float*)(lds + L_YT);
    LAS float* wa = (LAS float*)(lds + L_WV + wave * L_WV_BYTES); LAS float* wu = wa + 16 * 68;
    int lrow0, t0, slen;
    if (tile < 256) { lrow0 = tile * 64; t0 = (tile & 63) * 64; slen = SEQ; }
    else { const int jj = tile - 256; lrow0 = CH_L + jj * 64; t0 = (jj & 3) * 64; slen = CTXL; }
    float* lsum = (float*)(F.ws + WS_LSUM);
    const int ech = wave * 16 + fr, chg = n * 128 + ech;
    u32x4 g0 = {0u, 0u, 0u, 0u}, g1 = {0u, 0u, 0u, 0u};
    if (pass == 2) { const bf16_t* zg = F.Z() + (size_t)(lrow0 + (tid >> 3)) * ZP + CRG + n * 128 + (tid & 7) * 16; g0 = *(const u32x4*)zg; g1 = *(const u32x4*)(zg + 8); }
    {
        const int t = tid >> 3, c0 = (tid & 7) * 16;
        const LAS float* cw = (const LAS float*)(lds + L_CW) + c0;
        float accv[16];
#pragma unroll
        for (int i = 0; i < 4; ++i) { const f32x4 b4 = *(const LAS f32x4*)(cw + 4 * 128 + 4 * i); accv[4 * i] = b4[0]; accv[4 * i + 1] = b4[1]; accv[4 * i + 2] = b4[2]; accv[4 * i + 3] = b4[3]; }
#pragma unroll
        for (int k = 0; k < 4; ++k) { const int ts = t0 + t + k - 2;
            if (ts >= 0 && ts < slen) { const u32x4 r0 = X.r[k][0], r1 = X.r[k][1];
                const float xv[16] = {bf_lo(r0.x), bf_hi(r0.x), bf_lo(r0.y), bf_hi(r0.y), bf_lo(r0.z), bf_hi(r0.z), bf_lo(r0.w), bf_hi(r0.w), bf_lo(r1.x), bf_hi(r1.x), bf_lo(r1.y), bf_hi(r1.y), bf_lo(r1.z), bf_hi(r1.z), bf_lo(r1.w), bf_hi(r1.w)};
#pragma unroll
                for (int i = 0; i < 4; ++i) { const f32x4 w4 = *(const LAS f32x4*)(cw + k * 128 + 4 * i);
                    accv[4 * i] += xv[4 * i] * w4[0]; accv[4 * i + 1] += xv[4 * i + 1] * w4[1]; accv[4 * i + 2] += xv[4 * i + 2] * w4[2]; accv[4 * i + 3] += xv[4 * i + 3] * w4[3]; } } }
        u32x4 w0, w1; w0.x = cvt_pk_bf16(accv[0], accv[1]); w0.y = cvt_pk_bf16(accv[2], accv[3]); w0.z = cvt_pk_bf16(accv[4], accv[5]); w0.w = cvt_pk_bf16(accv[6], accv[7]);
        w1.x = cvt_pk_bf16(accv[8], accv[9]); w1.y = cvt_pk_bf16(accv[10], accv[11]); w1.z = cvt_pk_bf16(accv[12], accv[13]); w1.w = cvt_pk_bf16(accv[14], accv[15]);
        *(LAS u32x4*)(xs + t * L_XS_STRIDE + c0) = w0; *(LAS u32x4*)(xs + t * L_XS_STRIDE + c0 + 8) = w1;
    }
    __syncthreads();
    f32x4 accg[2][2][4];
#pragma unroll
    for (int d = 0; d < 2; ++d)
#pragma unroll
        for (int g = 0; g < 2; ++g)
#pragma unroll
            for (int m = 0; m < 4; ++m) { const float b = g == 0 ? C.pba[d] : C.pbx[d]; accg[d][g][m] = (f32x4){b, b, b, b}; }
#pragma unroll
    for (int ks = 0; ks < 4; ++ks)
#pragma unroll
        for (int m = 0; m < 4; ++m) { const bf16x8 af = *(const LAS bf16x8*)(xs + (16 * m + fr) * L_XS_STRIDE + ks * 32 + fq * 8);
#pragma unroll
            for (int d = 0; d < 2; ++d)
#pragma unroll
                for (int g = 0; g < 2; ++g) accg[d][g][m] = __builtin_amdgcn_mfma_f32_16x16x32_bf16(af, C.wf[d][g][ks], accg[d][g][m], 0, 0, 0); }
    float xv[4][4];
#pragma unroll
    for (int m = 0; m < 4; ++m)
#pragma unroll
        for (int jj = 0; jj < 4; ++jj) xv[m][jj] = bf1(xs[(16 * m + 4 * fq + jj) * L_XS_STRIDE + ech]);
    float y[16];
#pragma unroll
    for (int d = 0; d < 2; ++d) {
#pragma unroll
        for (int m = 0; m < 4; ++m) { f32x4 av, uv;
#pragma unroll
            for (int jj = 0; jj < 4; ++jj) {
                const float r = __builtin_amdgcn_rcpf(1.0f + __builtin_amdgcn_exp2f(accg[d][0][m][jj])), ig = __builtin_amdgcn_rcpf(1.0f + __builtin_amdgcn_exp2f(accg[d][1][m][jj]));
                const float av1 = __builtin_amdgcn_exp2f(-r * C.spl[d]);
                const float om = __builtin_fmaf(-av1, av1, 1.0f);
                av[jj] = av1; uv[jj] = __builtin_amdgcn_sqrtf(om) * (ig * xv[m][jj]); }
            *(LAS f32x4*)(wa + fr * 68 + 16 * m + 4 * fq) = av; *(LAS f32x4*)(wu + fr * 68 + 16 * m + 4 * fq) = uv; }
        asm volatile("s_waitcnt lgkmcnt(0)" ::: "memory");
        f32x4 A4[4], U4[4];
#pragma unroll
        for (int i = 0; i < 4; ++i) { A4[i] = *(const LAS f32x4*)(wa + fr * 68 + 16 * fq + 4 * i); U4[i] = *(const LAS f32x4*)(wu + fr * 68 + 16 * fq + 4 * i); }
        asm volatile("s_waitcnt lgkmcnt(0)" ::: "memory");
        float hl[16], Pl[16]; float h = 0.f, P = 1.f;
        if (d == 0) {
#pragma unroll
            for (int s = 0; s < 16; ++s) { const float av = A4[s >> 2][s & 3], uv = U4[s >> 2][s & 3]; h = av * h + uv; P *= av; hl[s] = h; Pl[s] = P; }
        } else {
#pragma unroll
            for (int s = 15; s >= 0; --s) { const float av = A4[s >> 2][s & 3], uv = U4[s >> 2][s & 3]; h = av * h + uv; P *= av; hl[s] = h; Pl[s] = P; }
        }
        float Pk[4], Hk[4];
#pragma unroll
        for (int k = 0; k < 4; ++k) { Pk[k] = bperm(P, k * 16 + fr); Hk[k] = bperm(h, k * 16 + fr); }
        float c = (pass == 2) ? bperm(cy, d * 16 + fr) : 0.f, cin = 0.f, Pt = 1.f;
#pragma unroll
        for (int kk = 0; kk < 4; ++kk) { const int k = d == 0 ? kk : 3 - kk; if (k == fq) cin = c; c = Pk[k] * c + Hk[k]; Pt *= Pk[k]; }
        if (pass == 1) { if (fq == 0) ((f32x2*)lsum)[(size_t)tile * 2048 + d * 1024 + chg] = (f32x2){Pt, c}; }
        else {
#pragma unroll
            for (int s = 0; s < 16; ++s) { const float hv = hl[s] + Pl[s] * cin; if (d == 0) y[s] = hv; else y[s] += hv; }
        }
    }
    if (pass == 2) {
#pragma unroll
        for (int s = 0; s < 16; ++s) yt[(16 * fq + s) * L_YT_STRIDE + ech] = y[s];
        __syncthreads();
        const int t = tid >> 3, c0 = (tid & 7) * 16;
        bf16_t* zr = F.Z() + (size_t)(lrow0 + t) * ZP + CRG + n * 128 + c0;
        const float gv[16] = {bf_lo(g0.x), bf_hi(g0.x), bf_lo(g0.y), bf_hi(g0.y), bf_lo(g0.z), bf_hi(g0.z), bf_lo(g0.w), bf_hi(g0.w), bf_lo(g1.x), bf_hi(g1.x), bf_lo(g1.y), bf_hi(g1.y), bf_lo(g1.z), bf_hi(g1.z), bf_lo(g1.w), bf_hi(g1.w)};
        float o[16];
#pragma unroll
        for (int i = 0; i < 4; ++i) { const f32x4 yv = *(const LAS f32x4*)(yt + t * L_YT_STRIDE + c0 + 4 * i); o[4 * i] = yv[0] * gv[4 * i]; o[4 * i + 1] = yv[1] * gv[4 * i + 1]; o[4 * i + 2] = yv[2] * gv[4 * i + 2]; o[4 * i + 3] = yv[3] * gv[4 * i + 3]; }
        u32x4 w0, w1; w0.x = cvt_pk_bf16(o[0], o[1]); w0.y = cvt_pk_bf16(o[2], o[3]); w0.z = cvt_pk_bf16(o[4], o[5]); w0.w = cvt_pk_bf16(o[6], o[7]);
        w1.x = cvt_pk_bf16(o[8], o[9]); w1.y = cvt_pk_bf16(o[10], o[11]); w1.z = cvt_pk_bf16(o[12], o[13]); w1.w = cvt_pk_bf16(o[14], o[15]);
        *(u32x4*)(zr + (CSC - CRG)) = w0; *(u32x4*)(zr + (CSC - CRG) + 8) = w1;
    }
}

__device__ __forceinline__ void lru_phase(CArgs a, const Frame& F, LAS unsigned char* lds, int pass) {
    const int tid = tid_opaque(F.wave_s), lane = tid & 63, wave = __builtin_amdgcn_readfirstlane(tid >> 6), fr = lane & 15;
    const int d = (lane >> 4) & 1; const bool cl = (pass == 2) && lane < 32;
    for (int w = bid_opaque(); w < 256; w += gridDim.x) {
        const int bl = w >> 6, n = (w >> 3) & 7, sg = w & 7;
        LruCtx C; lru_setup(a, F, n, C);
        { LAS float* cwl = (LAS float*)(lds + L_CW);
          for (int e = tid_opaque(F.wave_s); e < 640; e += NTHREADS) cwl[e] = e < 512 ? a->in[15][(size_t)F.l * 4 * DM + (e >> 7) * DM + n * 128 + (e & 127)] : a->in[16][(size_t)F.l * DM + n * 128 + (e - 512)];
          __syncthreads(); }
        XRows xc, xn; lru_load_rows(F, bl * 64 + sg * 8, n, xc);
        const int lane1 = tid_opaque(F.wave_s) & 63;
        const int d1 = (lane1 >> 4) & 1;
        const f32x2* sp = (const f32x2*)(F.ws + WS_LSUM) + (size_t)d1 * 1024 + n * 128 + wave * 16 + (lane1 & 15);
        const int cf = 256 + bl * 4, lf = bl * 64;
        float cb = 0.f;
        if (cl) {
#pragma unroll
            for (int q = 0; q < 4; ++q) { const f32x2 s = sp[(size_t)(d1 == 0 ? cf + q : cf + 3 - q) * 2048]; cb = s.x * cb + s.y; }
            const int cnt = d1 == 0 ? sg * 8 : 56 - sg * 8, start = d1 == 0 ? lf : lf + 63, step = d1 == 0 ? 1 : -1;
#pragma unroll 8
            for (int q = 0; q < cnt; ++q) { const f32x2 s = sp[(size_t)(start + q * step) * 2048]; cb = s.x * cb + s.y; }
        }
        float cys[8];
#pragma unroll
        for (int q = 0; q < 8; ++q) cys[q] = 0.f;
        if (cl) { f32x2 ss[8];
#pragma unroll
            for (int q = 0; q < 8; ++q) ss[q] = sp[(size_t)(lf + sg * 8 + q) * 2048];
            float c = cb;
#pragma unroll
            for (int q = 0; q < 8; ++q) { const int qq = d1 == 0 ? q : 7 - q; const f32x2 sv = d1 == 0 ? ss[q] : ss[7 - q];
                if (d1 == 0) { cys[q] = c; } else { cys[7 - q] = c; } c = sv.x * c + sv.y; (void)qq; } }
        for (int jj = 0; jj < 8; ++jj) {
            const int tl = sg * 8 + jj; float cy = cys[0];
#pragma unroll
            for (int q = 1; q < 8; ++q) cy = (jj == q) ? cys[q] : cy;
            const bool has_ctx = sg < 4 && (pass == 1 || F.l == 0);
            if (jj < 7) lru_load_rows(F, lf + tl + 1, n, xn); else if (has_ctx) lru_load_rows(F, cf + sg, n, xn);
            lru_item(a, F, lds, pass, lf + tl, n, C, cy, xc, jj & 1);
            xc = xn;
        }
        if (sg < 4 && (pass == 1 || F.l == 0)) {
            float cy = 0.f;
            const int lane2 = tid_opaque(F.wave_s) & 63;
            const f32x2* sp = (const f32x2*)(F.ws + WS_LSUM) + (size_t)((lane2 >> 4) & 1) * 1024 + n * 128 + wave * 16 + (lane2 & 15);
            if (cl) { if (d == 0) { for (int q = 0; q < sg; ++q) { const f32x2 s = sp[(size_t)(cf + q) * 2048]; cy = s.x * cy + s.y; } }
                      else { for (int q = 3; q > sg; --q) { const f32x2 s = sp[(size_t)(cf + q) * 2048]; cy = s.x * cy + s.y; } } }
            lru_item(a, F, lds, pass, cf + sg, n, C, cy, xc, 0);
        }
        __syncthreads();
    }
}

constexpr int SG_KC = 512, SG_PITCH = SG_KC * 2 + 16, SG_B_OFF = 64 * SG_PITCH;
__device__ __forceinline__ void sg_accum(LAS unsigned char* lds, const bf16_t* A, int lda, const bf16_t* Bt, int K, int tid, int wave, int lane, f32x4 (&acc)[2]) {
    const int fr = lane & 15, fq = lane >> 4, rt = wave & 3, ch = wave >> 2;
    u32x4 ra[8], rb[8];
#define SG_LOADS(k0_) do { _Pragma("unroll") for (int i_ = 0; i_ < 8; ++i_) { const int p_ = tid + 512 * i_, row_ = p_ >> 6, kc_ = (p_ & 63) * 8; \
        if ((k0_) + kc_ < K) { ra[i_] = *(const u32x4*)(A + (size_t)row_ * lda + (k0_) + kc_); rb[i_] = *(const u32x4*)(Bt + (size_t)row_ * K + (k0_) + kc_); } \
        else { ra[i_] = (u32x4){0u, 0u, 0u, 0u}; rb[i_] = (u32x4){0u, 0u, 0u, 0u}; } } } while (0)
    SG_LOADS(0);
    for (int k0 = 0; k0 < K; k0 += SG_KC) {
        __syncthreads();
#pragma unroll
        for (int i = 0; i < 8; ++i) { const int p = tid + 512 * i, row = p >> 6, kc = (p & 63) * 8;
            *(LAS u32x4*)(lds + row * SG_PITCH + kc * 2) = ra[i]; *(LAS u32x4*)(lds + SG_B_OFF + row * SG_PITCH + kc * 2) = rb[i]; }
        if (k0 + SG_KC < K) SG_LOADS(k0 + SG_KC);
        __syncthreads();
        const int nks = (K - k0) >= SG_KC ? 16 : (K - k0) / 32;
        const LAS unsigned char* ap = lds + (16 * rt + fr) * SG_PITCH + fq * 16;
        const LAS unsigned char* bp = lds + SG_B_OFF + (32 * ch + fr) * SG_PITCH + fq * 16;
#pragma unroll 4
        for (int ks = 0; ks < nks; ++ks) { const bf16x8 af = *(const LAS bf16x8*)(ap + ks * 64), b0 = *(const LAS bf16x8*)(bp + ks * 64), b1 = *(const LAS bf16x8*)(bp + 16 * SG_PITCH + ks * 64);
            acc[0] = __builtin_amdgcn_mfma_f32_16x16x32_bf16(af, b0, acc[0], 0, 0, 0); acc[1] = __builtin_amdgcn_mfma_f32_16x16x32_bf16(af, b1, acc[1], 0, 0, 0); }
    }
    __syncthreads();
#undef SG_LOADS
}
__device__ __forceinline__ void ctx_g2_block(const Frame& F, LAS unsigned char* lds, int id) {
    const int tid = tid_opaque(F.wave_s), lane = tid & 63, wave = __builtin_amdgcn_readfirstlane(tid >> 6), fr = lane & 15, fq = lane >> 4, rt = wave & 3, ch = wave >> 2;
    const int rb = id >> 4, cb = id & 15;
    bf16_t* zrow = F.Z() + (size_t)(CH_L + rb * 64) * ZP;
    f32x4 total[2] = {(f32x4){0.f, 0.f, 0.f, 0.f}, (f32x4){0.f, 0.f, 0.f, 0.f}};
#pragma unroll
    for (int seg = 0; seg < 3; ++seg) {
        f32x4 acc[2] = {(f32x4){0.f, 0.f, 0.f, 0.f}, (f32x4){0.f, 0.f, 0.f, 0.f}};
        const int colA = seg == 0 ? CSX : (seg == 1 ? CSB : CSC);
        bf16_t gq[2][4];
#pragma unroll
        for (int ct = 0; ct < 2; ++ct)
#pragma unroll
            for (int j = 0; j < 4; ++j) gq[ct][j] = zrow[(size_t)(16 * rt + 4 * fq + j) * ZP + CGT + seg * 1024 + cb * 64 + 32 * ch + 16 * ct + fr];
        sg_accum(lds, zrow + colA, ZP, F.W(seg == 0 ? W_AO : (seg == 1 ? W_SO : W_LO)) + (size_t)(cb * 64) * DM, DM, tid, wave, lane, acc);
#pragma unroll
        for (int ct = 0; ct < 2; ++ct)
#pragma unroll
            for (int j = 0; j < 4; ++j) total[ct][j] += bf1(gq[ct][j]) * acc[ct][j];
    }
#pragma unroll
    for (int ct = 0; ct < 2; ++ct)
#pragma unroll
        for (int j = 0; j < 4; ++j) zrow[(size_t)(16 * rt + 4 * fq + j) * ZP + CQ + cb * 64 + 32 * ch + 16 * ct + fr] = (bf16_t)(cvt_pk_bf16(total[ct][j], total[ct][j]) & 0xffffu);
}
__device__ __forceinline__ void ctx_res_block(const Frame& F, LAS unsigned char* lds, int id, int which) {
    const int tid = tid_opaque(F.wave_s), lane = tid & 63, wave = __builtin_amdgcn_readfirstlane(tid >> 6), fr = lane & 15, fq = lane >> 4, rt = wave & 3, ch = wave >> 2;
    const int rb = id >> 4, cb = id & 15;
    f32x4 acc[2] = {(f32x4){0.f, 0.f, 0.f, 0.f}, (f32x4){0.f, 0.f, 0.f, 0.f}};
    const size_t xrow0 = which == 0 ? (size_t)F.c * CH_C + rb * 64 : (size_t)rb * 64;
    const float* base = (which == 0 && F.l == 0) ? F.ctx : F.XC();
    const float* vec = F.MOD(8) + (which == 0 ? 2048 : 5120) + cb * 64 + 32 * ch + fr;
    float bq[2][4], gv[2];
#pragma unroll
    for (int ct = 0; ct < 2; ++ct) { gv[ct] = vec[16 * ct];
#pragma unroll
        for (int j = 0; j < 4; ++j) bq[ct][j] = base[(xrow0 + 16 * rt + 4 * fq + j) * DM + cb * 64 + 32 * ch + 16 * ct + fr]; }
    if (which == 0) sg_accum(lds, F.Z() + (size_t)(CH_L + rb * 64) * ZP + CQ, ZP, F.W(W_MO) + (size_t)(cb * 64) * DM, DM, tid, wave, lane, acc);
    else sg_accum(lds, F.Z() + (size_t)(LROWS + rb * 64) * FFW, FFW, F.W(W_F2) + (size_t)(cb * 64) * FFW, FFW, tid, wave, lane, acc);
#pragma unroll
    for (int ct = 0; ct < 2; ++ct)
#pragma unroll
        for (int j = 0; j < 4; ++j) F.XC()[(xrow0 + 16 * rt + 4 * fq + j) * DM + cb * 64 + 32 * ch + 16 * ct + fr] = bq[ct][j] + gv[ct] * acc[ct][j];
}

constexpr int N_PHASES = 30;
__device__ __forceinline__ void decode_phase(int ph, int& kind, int& l, int& c) {
    if (ph == 0) { kind = K_P0; l = 0; c = 0; return; }
    if (ph == N_PHASES - 1) { kind = K_FN; l = 1; c = 0; return; }
    const int q = ph - 1; l = q / 14; const int r = q % 14; c = 0;
    if (r == 0) { kind = K_N1; }
    else if (r <= 10) { c = (r - 1) / 5; const int s = (r - 1) % 5; kind = s == 0 ? K_G1 : s == 1 ? K_M1 : s == 2 ? K_A1 : s == 3 ? K_G2 : K_G3; }
    else { kind = r == 11 ? K_N2 : (r == 12 ? K_G4 : K_G5); }
}

__global__ void __launch_bounds__(NTHREADS, 2) mk_fwd(Args a_) {
    extern __shared__ __attribute__((aligned(16))) unsigned char lds_raw[];
    LAS unsigned char* lds = (LAS unsigned char*)lds_raw;
    cg::grid_group grid = cg::this_grid();
    const int ph_lo = a_.ph_lo, ph_hi = a_.ph_hi;
    const int wave_s = __builtin_amdgcn_readfirstlane(threadIdx.x >> 6);
    volatile LAS unsigned* MISC = (volatile LAS unsigned*)(lds + MISC_OFF);
    if (threadIdx.x < 4) MISC[threadIdx.x] = 0u;
    __syncthreads();
    (void)xcd_barrier_post((unsigned*)(a_.ws + WS_CTL), MISC);
    for (int ph = ph_lo; ph < ph_hi; ++ph) {
        CArgs a; { unsigned long long kp = (unsigned long long)__builtin_amdgcn_kernarg_segment_ptr(); asm volatile("" : "+s"(kp)); a = (CArgs)kp; }
        if (ph > ph_lo) {
            if (ph_hi < 0) grid.sync();
            else { XcdBarrier bar; bar.bar = (unsigned*)(a->ws + WS_CTL); bar.x = xb_xcc_id(); bar.st = (volatile LAS unsigned*)(lds + MISC_OFF); xcd_barrier(bar, tid_opaque(wave_s) == 0); } }
        Frame F;
        F.x = a->in[0]; F.cvec = a->in[1]; F.ctx = a->in[2]; F.cctx = a->in[3]; F.out = a->out; F.ws = a->ws;
        F.G = gridDim.x; { const int bx = bid_opaque(); F.vcu = (F.G % 8 == 0) ? (bx % 8) * (F.G / 8) + bx / 8 : bx; }
        int kind, l, c; decode_phase(ph, kind, l, c);
        F.kind = kind; F.l = l; F.c = c; F.wave_s = wave_s;
        if (kind == K_P0) { phase_p0(a, F, lds); }
        else if (kind == K_N1) { for (int rep = 0; rep < ((kind == REP_KIND) ? 2 : 1); ++rep) phase_norm(a, F, 0); }
        else if (kind == K_N2) { for (int rep = 0; rep < ((kind == REP_KIND) ? 2 : 1); ++rep) phase_norm(a, F, 1); }
        else if (kind == K_FN) { phase_final(a, F); }
        else if (kind == K_M1) {
            for (int rep = 0; rep < REP_LRU1; ++rep) lru_phase(a, F, lds, 1);
            phase_qknorm(a, F);
            phase_sconv(a, F);
        } else if (kind == K_A1) {
            for (int rep = 0; rep < REP_A1; ++rep) lru_phase(a, F, lds, 2);
            const int nlat = CHB * 8 * 16, ntot = nlat + ((l == 0) ? CHB * 8 : 0);
            for (int rep = 0; rep < REP_ATT; ++rep)
            for (int i = 0;; ++i) {
                int U;
                if (F.G == 256) { if (i < 2) U = (F.vcu >> 5) * 64 + i * 32 + (F.vcu & 31); else { const int v2 = F.vcu - 128; U = (i == 2 && v2 >= 0 && v2 < 32) ? nlat + v2 : ntot; } }
                else U = i * F.G + F.vcu;
                if (U >= ntot) break;
                if (U < nlat) {
                    const int bk = U >> 6, bl = bk >> 1, kvh = bk & 1, r = U & 63, h = kvh * 4 + (r >> 4), qb = r & 15;
                    bf16_t* q = F.Z() + (size_t)(bl * SEQ + qb * 256) * ZP + CQ + h * 128;
                    att::attn_dense_body(q, F.Kb() + (size_t)bl * KVLEN * 256 + kvh * 128, F.Vb() + (size_t)bl * KVLEN * 256 + kvh * 128, q + (CSX - CQ), KVLEN, (char*)lds_raw, F.wave_s);
                } else {
                    const int V = U - nlat, bl = V >> 3, h = V & 7, kvh = h >> 2;
                    bf16_t* q = F.Z() + (size_t)(CH_L + bl * CTXL) * ZP + CQ + h * 128;
                    att::attn_dense_body(q, F.Kb() + (size_t)bl * KVLEN * 256 + kvh * 128, F.Vb() + (size_t)bl * KVLEN * 256 + kvh * 128, q + (CSX - CQ), CTXL, (char*)lds_raw, F.wave_s);
                }
            }
        } else {
            GSched S; S.F = F; GEpi E; E.F = F;
            const int K = (kind == K_G5) ? FFW : DM;
            const int lda = (kind == K_G1 || kind == K_G4) ? DM : (kind == K_G5 ? FFW : ZP);
            for (int rep = 0; rep < ((kind == REP_KIND) ? 2 : 1); ++rep)
            pg8::gemm_phase<GEpi, GSched>(lds, K, lda, S, E);
            if (l == 0) {
                if (kind == K_G2) { for (int id = F.vcu; id < 256; id += F.G) ctx_g2_block(F, lds, id); }
                else if (kind == K_G3) { for (int id = F.vcu; id < 256; id += F.G) ctx_res_block(F, lds, id, 0); }
                else if (kind == K_G5) { for (int id = F.vcu; id < 512; id += F.G) ctx_res_block(F, lds, id, 1); }
            }
        }
    }
}

extern "C" void kernel_launch(void* const* d_in, const int* in_sizes, int n_in, void* d_out, int out_size, void* d_ws, size_t ws_size, hipStream_t stream) {
    static int grid = 0;
    if (grid == 0) {
        if (n_in != 27 || out_size != LROWS * DM || ws_size < WS_END) { fprintf(stderr, "kernel_launch: bad shapes n_in %d out %d ws %zu (need %zu)\n", n_in, out_size, ws_size, (size_t)WS_END); grid = -1; return; }
        int dev = 0, cus = 0, per_cu = 0;
        hipGetDevice(&dev); hipDeviceGetAttribute(&cus, hipDeviceAttributeMultiprocessorCount, dev);
        if (hipFuncSetAttribute((const void*)mk_fwd, hipFuncAttributeMaxDynamicSharedMemorySize, LDS_BYTES) != hipSuccess) { fprintf(stderr, "kernel_launch: hipFuncSetAttribute failed\n"); grid = -1; return; }
        if (hipOccupancyMaxActiveBlocksPerMultiprocessor(&per_cu, (const void*)mk_fwd, NTHREADS, LDS_BYTES) != hipSuccess || per_cu < 1) { fprintf(stderr, "kernel_launch: occupancy query failed (%d)\n", per_cu); per_cu = 1; }
        (void)hipGetLastError();
        grid = cus * per_cu;
        fprintf(stderr, "kernel_launch: grid %d (cus %d x %d)\n", grid, cus, per_cu);
    }
    if (grid < 0) return;
    if (hipMemsetAsync((char*)d_ws + WS_CTL, 0, CTL_BYTES, stream) != hipSuccess) { fprintf(stderr, "kernel_launch: memset failed\n"); return; }
    Args a{};
    for (int i = 0; i < 27; ++i) a.in[i] = (const float*)d_in[i];
    a.out = (float*)d_out; a.ws = (unsigned char*)d_ws;
#if MK_PER_PHASE
    for (int ph = 0; ph < N_PHASES; ++ph) {
        a.ph_lo = ph; a.ph_hi = ph + 1;
        void* args[] = {&a};
        hipError_t e = hipLaunchCooperativeKernel((const void*)mk_fwd, dim3(grid), dim3(NTHREADS), args, LDS_BYTES, stream);
        if (e != hipSuccess) { fprintf(stderr, "launch %d failed: %s\n", ph, hipGetErrorString(e)); break; }
    }
#else
    a.ph_lo = 0; a.ph_hi = N_PHASES;
    void* args[] = {&a};
    hipError_t e = hipLaunchCooperativeKernel((const void*)mk_fwd, dim3(grid), dim3(NTHREADS), args, LDS_BYTES, stream);
    if (e != hipSuccess) fprintf(stderr, "cooperative launch failed: %s (grid %d)\n", hipGetErrorString(e), grid);
#endif
}
```

```cpp
#include <hip/hip_runtime.h>
#include <hip/hip_bf16.h>
#include <hip/hip_cooperative_groups.h>
#include <cstdio>
#include <cstdint>
namespace cg = cooperative_groups;

#ifndef REP_KIND
#define REP_KIND -1
#endif
#ifndef REP_LRU1
#define REP_LRU1 1
#endif
#ifndef REP_A1
#define REP_A1 1
#endif
#ifndef REP_ATT
#define REP_ATT 1
#endif
#ifndef MK_PER_PHASE
#define MK_PER_PHASE 0
#endif

#define LAS __attribute__((address_space(3)))
typedef unsigned short bf16_t;
typedef short bf16x8 __attribute__((ext_vector_type(8)));
typedef short s16x4 __attribute__((ext_vector_type(4)));
typedef float f32x2 __attribute__((ext_vector_type(2)));
typedef float f32x4 __attribute__((ext_vector_type(4)));
typedef float f32x16 __attribute__((ext_vector_type(16)));
typedef unsigned u32x4 __attribute__((ext_vector_type(4)));
typedef unsigned u32x2 __attribute__((ext_vector_type(2)));

constexpr int DM = 1024, NBATCH = 8, SEQ = 4096, CTXL = 256, NIN = 9728, FFW = 2816;
constexpr int LROWS = NBATCH * SEQ, CROWS = NBATCH * CTXL, ROWS = LROWS + CROWS;
constexpr int CHB = 4, CH_L = CHB * SEQ, CH_C = CHB * CTXL, CH_ROWS = CH_L + CH_C;
constexpr int ZP = NIN;
constexpr int CQ = 0, CK = 1024, CV = 1280, CSB = 1536, CSC = 2560, CSX = 3584, CRX = 4608, CRG = 5632, CGT = 6656;
constexpr int KVLEN = CTXL + SEQ;
constexpr float EPS = 1e-6f;
constexpr int NTHREADS = 512, NWAVES = 8;
constexpr int MISC_OFF = 143360, LDS_BYTES = MISC_OFF + 1024;

constexpr size_t MiB = 1u << 20;
constexpr size_t WS_MOD = 0, WS_ROPE = 512 * 1024, WS_CTL = 768 * 1024, CTL_BYTES = 16384, WS_LSUM = 1 * MiB, WS_XC = 6 * MiB, WS_W = 14 * MiB;
constexpr size_t W_IN = 0, W_AO = 19 * MiB, W_SO = 21 * MiB, W_LO = 23 * MiB, W_MO = 25 * MiB, W_F1 = 27 * MiB, W_F2 = 38 * MiB, W_LRU = 43 * MiB + 512 * 1024;
constexpr size_t W_LAYER = 44 * MiB + 512 * 1024;
constexpr size_t WS_H = 103 * MiB, WS_K = 171 * MiB, WS_V = WS_K + (size_t)CHB * KVLEN * 256 * 2, WS_Z = 188 * MiB, WS_END = 511 * MiB;
static_assert(WS_W + 2 * W_LAYER <= WS_H, "weights");
static_assert(WS_H + (size_t)ROWS * DM * 2 <= WS_K, "H");
static_assert(WS_V + (size_t)CHB * KVLEN * 256 * 2 <= WS_Z, "KV");
static_assert(WS_Z + (size_t)CH_ROWS * ZP * 2 <= WS_END, "Z");
static_assert((size_t)ROWS * FFW * 2 <= (size_t)CH_ROWS * ZP * 2, "HID in Z");
static_assert(W_F2 + (size_t)DM * FFW * 2 <= W_LRU && W_IN + (size_t)NIN * DM * 2 <= W_AO && W_F1 + (size_t)2 * FFW * DM * 2 <= W_F2, "w map");

struct Args { const float* in[27]; float* out; unsigned char* ws; int ph_lo, ph_hi; };
typedef const __attribute__((address_space(4))) Args* CArgs;

__device__ __forceinline__ unsigned cvt_pk_bf16(float lo, float hi) { unsigned r; asm volatile("v_cvt_pk_bf16_f32 %0, %1, %2" : "=v"(r) : "v"(lo), "v"(hi)); return r; }
typedef __bf16 bf16x2_t __attribute__((ext_vector_type(2)));
__device__ __forceinline__ unsigned cvtpk_nv(float lo, float hi) { f32x2 v = {lo, hi}; bf16x2_t b = __builtin_convertvector(v, bf16x2_t); return __builtin_bit_cast(unsigned, b); }
__device__ __forceinline__ float bf_lo(unsigned u) { return __uint_as_float(u << 16); }
__device__ __forceinline__ float bf_hi(unsigned u) { return __uint_as_float(u & 0xffff0000u); }
__device__ __forceinline__ float bf1(bf16_t b) { return __uint_as_float((unsigned)b << 16); }
__device__ __forceinline__ int tid_opaque(int wave_s) { int t = wave_s * 64 + (int)__builtin_amdgcn_mbcnt_hi(~0u, __builtin_amdgcn_mbcnt_lo(~0u, 0u)); asm volatile("" : "+v"(t)); return t; }
__device__ __forceinline__ int bid_opaque() { int b = blockIdx.x; asm volatile("" : "+s"(b)); return b; }
template <int M> __device__ __forceinline__ float swz_xor(float v) { return __int_as_float(__builtin_amdgcn_ds_swizzle(__float_as_int(v), (M << 10) | 0x1f)); }
__device__ __forceinline__ float bperm(float v, int src_lane) { return __int_as_float(__builtin_amdgcn_ds_bpermute(src_lane << 2, __float_as_int(v))); }
__device__ __forceinline__ float wave_sum(float v) {
    v += swz_xor<1>(v); v += swz_xor<2>(v); v += swz_xor<4>(v); v += swz_xor<8>(v); v += swz_xor<16>(v);
    auto rr = __builtin_amdgcn_permlane32_swap(__float_as_uint(v), __float_as_uint(v), false, false);
    return __uint_as_float(rr[0]) + __uint_as_float(rr[1]);
}
__device__ __forceinline__ float fast_sigmoid(float y) { return __builtin_amdgcn_rcpf(1.0f + __builtin_amdgcn_exp2f(-1.4426950408889634f * y)); }
__device__ __forceinline__ float gelu_tanh(float x) { const float y = 1.5957691216057308f * (x + 0.044715f * x * x * x); return x * fast_sigmoid(y); }
__device__ __forceinline__ float silu_f(float x) { return x * fast_sigmoid(x); }

#define XB_TMO      128
#define XB_XCNT(j)  (256  + 64 * (j))
#define XB_XSUB(j)  (1280 + 64 * (j))
#define XB_XGEN(j)  (2304 + 64 * (j))
#define XB_TOP      3328
#define XB_TOPGEN   3392
#define XCD_BAR_WORDS 3456
#define XB_SPIN_CAP (1u << 18)

__device__ __forceinline__ unsigned xb_ld(unsigned* p)              { return __hip_atomic_load(p, __ATOMIC_RELAXED, __HIP_MEMORY_SCOPE_AGENT); }
__device__ __forceinline__ unsigned xb_add(unsigned* p, unsigned v) { return __hip_atomic_fetch_add(p, v, __ATOMIC_RELAXED, __HIP_MEMORY_SCOPE_AGENT); }
__device__ __forceinline__ unsigned xb_xcc_id() { return (unsigned)__builtin_amdgcn_s_getreg((3 << 11) | 20) & 0xFu; }
#define XB_SPIN(cond, bar) do { unsigned _sp = 0; while (cond) { __builtin_amdgcn_s_sleep(1); \
    if ((++_sp & 255u) == 0u) { if (xb_ld(&(bar)[XB_TMO])) break; if (_sp > XB_SPIN_CAP) { atomicAdd(&(bar)[XB_TMO], 1u); break; } } } } while (0)

struct XcdBarrier {
    unsigned* bar; unsigned x;
    volatile LAS unsigned* st;
};

__device__ __forceinline__ XcdBarrier xcd_barrier_post(unsigned* bar, volatile LAS unsigned* st) {
    XcdBarrier b; b.bar = bar; b.x = xb_xcc_id(); b.st = st;
    if (threadIdx.x == 0) (void)xb_add(&bar[XB_XCNT(b.x)], 1u);
    return b;
}
__device__ __forceinline__ void xcd_barrier_complete(unsigned* bar, unsigned x, unsigned& nloc, unsigned& nx) {
    const unsigned G = gridDim.x * gridDim.y * gridDim.z;
    unsigned sum, cnt, mine, sp = 0u;
    for (;;) {
        sum = 0u; cnt = 0u; mine = 0u;
#pragma unroll
        for (unsigned j = 0; j < 16; ++j) { const unsigned c = xb_ld(&bar[XB_XCNT(j)]); sum += c; cnt += (c > 0u) ? 1u : 0u; mine = (j == x) ? c : mine; }
        if (sum == G) break;
        __builtin_amdgcn_s_sleep(1);
        if ((++sp & 255u) == 0u) { if (xb_ld(&bar[XB_TMO])) break; if (sp > XB_SPIN_CAP) { atomicAdd(&bar[XB_TMO], 1u); break; } }
    }
    nloc = mine > 0u ? mine : 1u; nx = cnt > 0u ? cnt : 1u;
}

__device__ __forceinline__ void xcd_barrier(const XcdBarrier& b, const bool leader_thread) {
    asm volatile("s_waitcnt vmcnt(0)" ::: "memory");
    __syncthreads();
    if (leader_thread) {
        unsigned* bar = b.bar;
        __builtin_amdgcn_s_waitcnt(0);
        unsigned nloc = b.st[0], nx = b.st[1];
        if (nloc == 0u) { xcd_barrier_complete(bar, b.x, nloc, nx); b.st[0] = nloc; b.st[1] = nx; }
        const unsigned old = xb_add(&bar[XB_XSUB(b.x)], 1u);
        const unsigned gen = old / nloc;
        if (old + 1u == (gen + 1u) * nloc) {
            __builtin_amdgcn_fence(__ATOMIC_RELEASE, "agent");
            asm volatile("s_waitcnt vmcnt(0)" ::: "memory");
            const unsigned og = xb_add(&bar[XB_TOP], 1u);
            const unsigned tg = og / nx;
            if (og + 1u == (tg + 1u) * nx) xb_add(&bar[XB_TOPGEN], 1u);
            else XB_SPIN(xb_ld(&bar[XB_TOPGEN]) == tg, bar);
            __builtin_amdgcn_fence(__ATOMIC_ACQUIRE, "agent");
            xb_add(&bar[XB_XGEN(b.x)], 1u);
            asm volatile("s_waitcnt vmcnt(0)" ::: "memory");
        } else {
            XB_SPIN(xb_ld(&bar[XB_XGEN(b.x)]) == gen, bar);
            __builtin_amdgcn_fence(__ATOMIC_ACQUIRE, "agent");
            asm volatile("s_waitcnt vmcnt(0)" ::: "memory");
        }
    }
    __syncthreads();
}


namespace pg8 {
constexpr int BM = 256, BK = 64, HALF = 128, HTB = HALF * BK * 2, STAGE_BYTES = 8 * HTB;
__host__ __device__ __forceinline__ int lds_byte(int r, int c) { const int st = (r >> 4) * 2 + (c >> 5), rr = r & 15, cc = c & 31, ob = rr * 64 + cc * 2; return st * 1024 + (ob ^ (((ob >> 9) & 1) << 5)); }
__host__ __device__ __forceinline__ void stage_rc(int b, int& R, int& C) { const int st = b / 1024, sb = b % 1024, swz = sb ^ (((sb >> 9) & 1) << 5); R = (st >> 1) * 16 + swz / 64; C = (st & 1) * 32 + (swz % 64) / 2; }
__host__ __device__ __forceinline__ int perm32(int rho) { const int n = rho >> 4, i = rho & 15; return 8 * (i >> 2) + 4 * n + (i & 3); }

struct Unit { const char* A; const char* B; int pm, pn, seg; };

template <class Epi, class Sched>
__device__ __forceinline__ void gemm_phase(LAS unsigned char* lds, const int K, const int lda, const Sched& S, const Epi& E) {
    const int tid = tid_opaque(S.F.wave_s), wid = __builtin_amdgcn_readfirstlane(tid >> 6), lane = tid & 63, wr = wid >> 2, wc = wid & 3, fr = lane & 15, fq = lane >> 4;
    const int nt = K / BK;
    unsigned voffA[2], voffB[2];
#pragma unroll
    for (int i = 0; i < 2; ++i) { int R, C; stage_rc(tid * 16 + i * 8192, R, C); const int Rb = (R & ~31) + perm32(R & 31);
        voffA[i] = (unsigned)(R * lda + C) * 2u; voffB[i] = (unsigned)(Rb * K + C) * 2u; }
    const size_t kstep = (size_t)(BK * 2);
    const size_t hstepA = (size_t)HALF * lda * 2, hstepB = (size_t)HALF * K * 2;
    const unsigned ldsw = (unsigned)wid * 1024u;
    const int aoff = lds_byte(wr * 64 + fr, fq * 8), boff = lds_byte(wc * 32 + fr, fq * 8);
#define PG8_SA(b, h) (((b) * 2 + (h)) * HTB)
#define PG8_SB(b, h) ((4 + (b) * 2 + (h)) * HTB)
#define PG8_STAGE(bufoff, gbase, voff) do { _Pragma("unroll") for (int _i = 0; _i < 2; ++_i) \
        __builtin_amdgcn_global_load_lds((const unsigned*)((const char*)(gbase) + (voff)[_i]), (LAS unsigned*)(lds + (bufoff) + ldsw + _i * 8192), 16, 0, 0); } while (0)
#define PG8_LDA(dst, b, h) do { _Pragma("unroll") for (int m = 0; m < 4; ++m) _Pragma("unroll") for (int k = 0; k < 2; ++k) dst[m][k] = *(const LAS bf16x8*)(lds + PG8_SA(b, h) + aoff + m * 2048 + k * 1024); } while (0)
#define PG8_LDB(dst, b, h) do { _Pragma("unroll") for (int n = 0; n < 2; ++n) _Pragma("unroll") for (int k = 0; k < 2; ++k) dst[n][k] = *(const LAS bf16x8*)(lds + PG8_SB(b, h) + boff + n * 2048 + k * 1024); } while (0)
#define PG8_MMA(ai, bj, At, Bt) do { __builtin_amdgcn_s_setprio(1); _Pragma("unroll") for (int m = 0; m < 4; ++m) _Pragma("unroll") for (int n = 0; n < 2; ++n) _Pragma("unroll") for (int k = 0; k < 2; ++k) \
        acc[ai][bj][m][n] = __builtin_amdgcn_mfma_f32_16x16x32_bf16(Bt[n][k], At[m][k], acc[ai][bj][m][n], 0, 0, 0); __builtin_amdgcn_s_setprio(0); } while (0)
#define PG8_WAIT_V(n) asm volatile("s_waitcnt vmcnt(" #n ")" ::: "memory")
#define PG8_WAIT_L(n) asm volatile("s_waitcnt lgkmcnt(" #n ")" ::: "memory")
#define PG8_BAR __builtin_amdgcn_s_barrier()
#define PG8_SCHED __builtin_amdgcn_sched_barrier(0)
    Unit cur, nxt; int ui = 0;
    if (!S.next(0, cur)) return;
    f32x4 acc[2][2][4][2];
#pragma unroll
    for (int a = 0; a < 2; ++a)
#pragma unroll
        for (int b = 0; b < 2; ++b)
#pragma unroll
            for (int m = 0; m < 4; ++m)
#pragma unroll
                for (int n = 0; n < 2; ++n) acc[a][b][m][n] = (f32x4){0.f, 0.f, 0.f, 0.f};
    bf16x8 At[4][2], B0[2][2], B1[2][2];
    const char* cA = cur.A; const char* cB = cur.B;
    PG8_STAGE(PG8_SB(0, 0), cB, voffB); PG8_STAGE(PG8_SB(0, 1), cB + hstepB, voffB); PG8_STAGE(PG8_SA(0, 0), cA, voffA); PG8_STAGE(PG8_SA(0, 1), cA + hstepA, voffA);
    if (wr == 1) PG8_BAR;
    PG8_WAIT_V(2); PG8_BAR;
    PG8_STAGE(PG8_SB(1, 0), cB + kstep, voffB); PG8_STAGE(PG8_SA(1, 0), cA + kstep, voffA); PG8_STAGE(PG8_SB(1, 1), cB + hstepB + kstep, voffB);
    PG8_WAIT_V(6); PG8_BAR;
    for (;;) {
        const bool has_next = S.next(ui + 1, nxt);
        const char* nA = has_next ? nxt.A : cA; const char* nB = has_next ? nxt.B : cB;
        for (int t = 0; t < nt; t += 2) {
            const bool last = (t == nt - 2);
            const char* a1 = cA + (size_t)(t + 1) * kstep;
            const char* a2 = last ? nA : cA + (size_t)(t + 2) * kstep; const char* b2 = last ? nB : cB + (size_t)(t + 2) * kstep;
            const char* a3 = a2 + kstep; const char* b3 = b2 + kstep;
            PG8_LDB(B0, 0, 0); PG8_LDB(B1, 0, 1); PG8_SCHED; PG8_LDA(At, 0, 0); PG8_STAGE(PG8_SA(1, 1), a1 + hstepA, voffA);
            PG8_WAIT_V(8); PG8_WAIT_L(0); PG8_BAR; PG8_MMA(0, 0, At, B0); PG8_MMA(0, 1, At, B1); PG8_BAR; PG8_SCHED;
            PG8_LDA(At, 0, 1); PG8_STAGE(PG8_SB(0, 0), b2, voffB); PG8_STAGE(PG8_SB(0, 1), b2 + hstepB, voffB); PG8_STAGE(PG8_SA(0, 0), a2, voffA);
            PG8_WAIT_V(8); PG8_WAIT_L(0); PG8_BAR; PG8_MMA(1, 0, At, B0); PG8_MMA(1, 1, At, B1); PG8_BAR; PG8_SCHED;
            PG8_LDB(B0, 1, 0); PG8_LDB(B1, 1, 1); PG8_SCHED; PG8_LDA(At, 1, 0); PG8_STAGE(PG8_SA(0, 1), a2 + hstepA, voffA);
            PG8_WAIT_V(8); PG8_WAIT_L(0); PG8_BAR; PG8_MMA(0, 0, At, B0); PG8_MMA(0, 1, At, B1); PG8_BAR; PG8_SCHED;
            PG8_LDA(At, 1, 1); PG8_STAGE(PG8_SB(1, 0), b3, voffB); PG8_STAGE(PG8_SB(1, 1), b3 + hstepB, voffB); PG8_STAGE(PG8_SA(1, 0), a3, voffA);
            PG8_WAIT_V(8); PG8_WAIT_L(0); PG8_BAR; PG8_MMA(1, 0, At, B0); PG8_MMA(1, 1, At, B1); PG8_BAR; PG8_SCHED;
        }
        if (wr == 0) PG8_BAR;
        E(acc, cur, wr, wc, fr, fq);
        if (!has_next) break;
#pragma unroll
        for (int a = 0; a < 2; ++a)
#pragma unroll
            for (int b = 0; b < 2; ++b)
#pragma unroll
                for (int m = 0; m < 4; ++m)
#pragma unroll
                    for (int n = 0; n < 2; ++n) acc[a][b][m][n] = (f32x4){0.f, 0.f, 0.f, 0.f};
        cur = nxt; cA = nA; cB = nB; ++ui;
        if (wr == 1) PG8_BAR;
    }
    PG8_WAIT_V(0);
    PG8_BAR;
#undef PG8_SA
#undef PG8_SB
#undef PG8_STAGE
#undef PG8_LDA
#undef PG8_LDB
#undef PG8_MMA
#undef PG8_WAIT_V
#undef PG8_WAIT_L
#undef PG8_BAR
#undef PG8_SCHED
}
}

enum PhaseKind { K_P0 = 0, K_N1, K_G1, K_M1, K_A1, K_G2, K_G3, K_N2, K_G4, K_G5, K_FN };

struct Frame {
    const float* x; const float* cvec; const float* ctx; const float* cctx;
    float* out; unsigned char* ws;
    int vcu, G, l, c, kind, wave_s;
    __device__ __forceinline__ const bf16_t* W(size_t off) const { return (const bf16_t*)(ws + WS_W + (size_t)l * W_LAYER + off); }
    __device__ __forceinline__ bf16_t* Z() const { return (bf16_t*)(ws + WS_Z); }
    __device__ __forceinline__ bf16_t* H() const { return (bf16_t*)(ws + WS_H); }
    __device__ __forceinline__ bf16_t* Kb() const { return (bf16_t*)(ws + WS_K); }
    __device__ __forceinline__ bf16_t* Vb() const { return (bf16_t*)(ws + WS_V); }
    __device__ __forceinline__ float* XC() const { return (float*)(ws + WS_XC); }
    __device__ __forceinline__ const float* MOD(int b) const { return (const float*)(ws + WS_MOD) + (size_t)(l * 9 + b) * 6144; }
};

struct GSched {
    Frame F;
    __device__ __forceinline__ static void tile_map(int T, int nM, int nN, int& pm, int& pn) {
        const int nig = 8 * nN, gid = T / nig, fm = gid * 8, gsz = (nM - fm) < 8 ? (nM - fm) : 8, w = T % nig; pm = fm + w % gsz; pn = w / gsz;
    }
    __device__ __forceinline__ bool next(int i, pg8::Unit& u) const {
        const int kind = F.kind, l = F.l, c = F.c;
        if (kind == K_G1) {
            const int L = i * F.G + F.vcu, NL = 64 * 38, ncc = (l == 0) ? 38 : 6;
            if (L >= NL + 4 * ncc) return false;
            int lt, pn;
            if (L < NL) { tile_map(L, 64, 38, lt, pn); }
            else { const int q = L - NL; lt = 64 + (q & 3); const int ci = q >> 2; pn = (l == 0) ? ci : (ci < 2 ? 4 + ci : 16 + ci); }
            const size_t grow0 = lt < 64 ? (size_t)(64 * c + lt) * 256 : (size_t)LROWS + (size_t)(4 * c + lt - 64) * 256;
            u.A = (const char*)(F.H() + grow0 * DM); u.B = (const char*)(F.W(W_IN) + (size_t)pn * 256 * DM); u.pm = lt; u.pn = pn; u.seg = 0; return true;
        } else if (kind == K_G2) {
            const int T = (i / 3) * F.G + F.vcu, seg = i % 3, nM = 64;
            if (T >= nM * 4) return false;
            int lt, pn; tile_map(T, nM, 4, lt, pn);
            const int colA = seg == 0 ? CSX : (seg == 1 ? CSB : CSC);
            u.A = (const char*)(F.Z() + (size_t)lt * 256 * ZP + colA);
            u.B = (const char*)(F.W(seg == 0 ? W_AO : (seg == 1 ? W_SO : W_LO)) + (size_t)pn * 256 * DM); u.pm = lt; u.pn = pn; u.seg = seg; return true;
        } else if (kind == K_G3) {
            const int T = i * F.G + F.vcu, nM = 64;
            if (T >= nM * 4) return false;
            int lt, pn; tile_map(T, nM, 4, lt, pn);
            u.A = (const char*)(F.Z() + (size_t)lt * 256 * ZP + CQ); u.B = (const char*)(F.W(W_MO) + (size_t)pn * 256 * DM); u.pm = lt; u.pn = pn; u.seg = 0; return true;
        } else if (kind == K_G4) {
            const int T = i * F.G + F.vcu, nM = (l == 0) ? 136 : 128;
            if (T >= nM * 22) return false;
            int pm, pn; tile_map(T, nM, 22, pm, pn);
            u.A = (const char*)(F.H() + (size_t)pm * 256 * DM); u.B = (const char*)(F.W(W_F1) + (size_t)pn * 256 * DM); u.pm = pm; u.pn = pn; u.seg = 0; return true;
        } else {
            const int T = i * F.G + F.vcu, nM = 128;
            if (T >= nM * 4) return false;
            int pm, pn; tile_map(T, nM, 4, pm, pn);
            u.A = (const char*)(F.Z() + (size_t)pm * 256 * FFW); u.B = (const char*)(F.W(W_F2) + (size_t)pn * 256 * FFW); u.pm = pm; u.pn = pn; u.seg = 0; return true;
        }
    }
};

#ifndef EPI_MASK
#define EPI_MASK 30
#endif
#define EPI_EN(k) ((EPI_MASK >> (k)) & 1)
struct GEpi {
    Frame F;
    __device__ __forceinline__ void operator()(const f32x4 (&acc)[2][2][4][2], const pg8::Unit& u, int wr, int wc, int fr, int fq) const {
        const int kind = F.kind, l = F.l, c = F.c;
        asm volatile("" : "+v"(fr), "+v"(fq));
        const int row0 = wr * 64 + fr, col0 = wc * 32 + 8 * fq;
        if (EPI_EN(1) && kind == K_G1) {
            const int lt = u.pm, pn = u.pn;
            bf16_t* dst; int ldo;
            if (pn == 4 || pn == 5) { const int kvrow0 = lt < 64 ? (lt >> 4) * KVLEN + CTXL + (lt & 15) * 256 : (lt - 64) * KVLEN; dst = (pn == 4 ? F.Kb() : F.Vb()) + (size_t)kvrow0 * 256; ldo = 256; }
            else { dst = F.Z() + (size_t)lt * 256 * ZP + pn * 256; ldo = ZP; }
            const int act = pn >= 26 ? 2 : (pn >= 22 ? 1 : 0);
            if (pn >= 10 && pn < 18) {
                bf16_t* ud = F.Z() + (size_t)lt * 256 * ZP + CSC + (pn - 10) * 128;
#pragma unroll
                for (int ai = 0; ai < 2; ++ai)
#pragma unroll
                    for (int m = 0; m < 4; ++m) { const f32x4 c0 = acc[ai][0][m][0], c1 = acc[ai][0][m][1], x0 = acc[ai][1][m][0], x1 = acc[ai][1][m][1];
                        u32x4 w; w.x = cvt_pk_bf16(c0[0] * x0[0], c0[1] * x0[1]); w.y = cvt_pk_bf16(c0[2] * x0[2], c0[3] * x0[3]); w.z = cvt_pk_bf16(c1[0] * x1[0], c1[1] * x1[1]); w.w = cvt_pk_bf16(c1[2] * x1[2], c1[3] * x1[3]);
                        *(u32x4*)(ud + (size_t)(row0 + ai * 128 + m * 16) * ZP + col0) = w; }
                return;
            }
#pragma unroll
            for (int ai = 0; ai < 2; ++ai)
#pragma unroll
                for (int m = 0; m < 4; ++m) { bf16_t* rowp = dst + (size_t)(row0 + ai * 128 + m * 16) * ldo + col0;
#pragma unroll
                    for (int bj = 0; bj < 2; ++bj) { f32x4 v0 = acc[ai][bj][m][0], v1 = acc[ai][bj][m][1];
                        if (act == 1) { _Pragma("unroll") for (int e = 0; e < 4; ++e) { v0[e] = gelu_tanh(v0[e]); v1[e] = gelu_tanh(v1[e]); } }
                        else if (act == 2) { _Pragma("unroll") for (int e = 0; e < 4; ++e) { v0[e] = fast_sigmoid(v0[e]); v1[e] = fast_sigmoid(v1[e]); } }
                        u32x4 w; w.x = cvt_pk_bf16(v0[0], v0[1]); w.y = cvt_pk_bf16(v0[2], v0[3]); w.z = cvt_pk_bf16(v1[0], v1[1]); w.w = cvt_pk_bf16(v1[2], v1[3]);
                        *(u32x4*)(rowp + bj * 128) = w; } }
        } else if (EPI_EN(2) && kind == K_G2) {
            const int lt = u.pm, pn = u.pn, seg = u.seg;
            const bf16_t* gate = F.Z() + (size_t)lt * 256 * ZP + CGT + seg * 1024 + pn * 256;
            bf16_t* mg = F.Z() + (size_t)lt * 256 * ZP + CQ + pn * 256;
#pragma unroll
            for (int ai = 0; ai < 2; ++ai) {
                u32x4 gq[4][2], pq[4][2];
#pragma unroll
                for (int m = 0; m < 4; ++m)
#pragma unroll
                    for (int bj = 0; bj < 2; ++bj) { const size_t off = (size_t)(row0 + ai * 128 + m * 16) * ZP + col0 + bj * 128;
                        gq[m][bj] = *(const u32x4*)(gate + off); if (seg > 0) pq[m][bj] = *(const u32x4*)(mg + off); }
#pragma unroll
                for (int m = 0; m < 4; ++m)
#pragma unroll
                    for (int bj = 0; bj < 2; ++bj) { const size_t off = (size_t)(row0 + ai * 128 + m * 16) * ZP + col0 + bj * 128;
                        const u32x4 g = gq[m][bj]; const f32x4 a0 = acc[ai][bj][m][0], a1 = acc[ai][bj][m][1];
                        float v[8] = {a0[0] * bf_lo(g.x), a0[1] * bf_hi(g.x), a0[2] * bf_lo(g.y), a0[3] * bf_hi(g.y), a1[0] * bf_lo(g.z), a1[1] * bf_hi(g.z), a1[2] * bf_lo(g.w), a1[3] * bf_hi(g.w)};
                        if (seg > 0) { const u32x4 p = pq[m][bj];
                            v[0] += bf_lo(p.x); v[1] += bf_hi(p.x); v[2] += bf_lo(p.y); v[3] += bf_hi(p.y); v[4] += bf_lo(p.z); v[5] += bf_hi(p.z); v[6] += bf_lo(p.w); v[7] += bf_hi(p.w); }
                        u32x4 w; w.x = cvt_pk_bf16(v[0], v[1]); w.y = cvt_pk_bf16(v[2], v[3]); w.z = cvt_pk_bf16(v[4], v[5]); w.w = cvt_pk_bf16(v[6], v[7]);
                        *(u32x4*)(mg + off) = w; }
                asm volatile("" ::: "memory");
            }
        } else if (EPI_EN(3) && (kind == K_G3 || kind == K_G5)) {
            const int pn = u.pn; const bool g3 = (kind == K_G3);
            bool lat; size_t r0; int b;
            if (g3) { const int lt = u.pm; lat = lt < 64; r0 = lat ? (size_t)(64 * c + lt) * 256 : (size_t)(4 * c + lt - 64) * 256; b = lat ? 4 * c + (lt >> 4) : 8; }
            else { const int pm = u.pm; lat = pm < 128; r0 = lat ? (size_t)pm * 256 : (size_t)(pm - 128) * 256; b = lat ? (pm >> 4) : 8; }
            const float* base = lat ? ((g3 && l == 0) ? F.x : F.out) : ((g3 && l == 0) ? F.ctx : F.XC());
            float* fout = lat ? F.out : F.XC();
            base += r0 * DM + pn * 256; fout += r0 * DM + pn * 256;
            const float* vec = F.MOD(b) + (g3 ? 2048 : 5120) + pn * 256 + col0;
            f32x4 vv[2][2];
#pragma unroll
            for (int bj = 0; bj < 2; ++bj) { vv[bj][0] = *(const f32x4*)(vec + bj * 128); vv[bj][1] = *(const f32x4*)(vec + bj * 128 + 4); }
#pragma unroll
            for (int ai = 0; ai < 2; ++ai) {
                f32x4 bq0[4][2], bq1[4][2];
#pragma unroll
                for (int m = 0; m < 4; ++m)
#pragma unroll
                    for (int bj = 0; bj < 2; ++bj) { const size_t off = (size_t)(row0 + ai * 128 + m * 16) * DM + col0 + bj * 128;
                        bq0[m][bj] = *(const f32x4*)(base + off); bq1[m][bj] = *(const f32x4*)(base + off + 4); }
#pragma unroll
                for (int m = 0; m < 4; ++m)
#pragma unroll
                    for (int bj = 0; bj < 2; ++bj) { const size_t off = (size_t)(row0 + ai * 128 + m * 16) * DM + col0 + bj * 128;
                        *(f32x4*)(fout + off) = bq0[m][bj] + vv[bj][0] * acc[ai][bj][m][0]; *(f32x4*)(fout + off + 4) = bq1[m][bj] + vv[bj][1] * acc[ai][bj][m][1]; }
                asm volatile("" ::: "memory");
            }
        } else if (EPI_EN(4)) {
            bf16_t* dst = F.Z() + (size_t)u.pm * 256 * FFW + u.pn * 128;
#pragma unroll
            for (int ai = 0; ai < 2; ++ai)
#pragma unroll
                for (int m = 0; m < 4; ++m) { bf16_t* rowp = dst + (size_t)(row0 + ai * 128 + m * 16) * FFW + col0;
                    const f32x4 g0 = acc[ai][0][m][0], g1 = acc[ai][0][m][1], u0 = acc[ai][1][m][0], u1 = acc[ai][1][m][1];
                    u32x4 w; w.x = cvt_pk_bf16(silu_f(g0[0]) * u0[0], silu_f(g0[1]) * u0[1]); w.y = cvt_pk_bf16(silu_f(g0[2]) * u0[2], silu_f(g0[3]) * u0[3]);
                    w.z = cvt_pk_bf16(silu_f(g1[0]) * u1[0], silu_f(g1[1]) * u1[1]); w.w = cvt_pk_bf16(silu_f(g1[2]) * u1[2], silu_f(g1[3]) * u1[3]);
                    *(u32x4*)rowp = w; }
        }
    }
};

namespace att {
constexpr int D = 128, NW = 8, QBLK = 32, KVBLK = 64;
constexpr float SCALE = 0.088388347648318440f;
constexpr float THR = 8.f;
constexpr int LDQ = ZP, LDK = 256, LDO = ZP;
constexpr size_t SHM_V = KVBLK * D * 2, SHM_K = KVBLK * D * 2, SHM_ATTN = 2 * SHM_V + 2 * SHM_K + NW * 64 * 4;
constexpr int OST_OFF = (int)SHM_ATTN;
static_assert(SHM_ATTN + NW * 32 * 272 <= MISC_OFF, "attention lds");
#define KSWZ(row, colB) ((row) * 256 + ((colB) ^ (((row) & 7) << 4)))
#define SBAR() __builtin_amdgcn_sched_barrier(0)
__device__ __forceinline__ int crow(int r, int hi) { return (r & 3) + 8 * (r >> 2) + 4 * hi; }
__device__ __forceinline__ void partialSM(f32x16& p0, f32x16& p1, float& m_reg, float& mn, float& alpha) {
  constexpr float C = SCALE * 1.4426950408889634f;
  float pmax = p0[0]; for (int r = 1; r < 16; ++r) pmax = fmaxf(pmax, p0[r]); for (int r = 0; r < 16; ++r) pmax = fmaxf(pmax, p1[r]);
  { auto rr = __builtin_amdgcn_permlane32_swap(__float_as_uint(pmax), __float_as_uint(pmax), false, false);
    pmax = fmaxf(__uint_as_float(rr[0]), __uint_as_float(rr[1])); }
  if (__builtin_expect(__all(pmax - m_reg <= THR / SCALE), 1)) { mn = m_reg; alpha = 1.f; }
  else { mn = fmaxf(m_reg, pmax); alpha = __builtin_amdgcn_exp2f((m_reg - mn) * C); m_reg = mn; }
  float mnC = -mn * C;
  for (int r = 0; r < 16; ++r) p0[r] = fmaf(p0[r], C, mnC); for (int r = 0; r < 16; ++r) p1[r] = fmaf(p1[r], C, mnC);
  for (int r = 0; r < 16; ++r) p0[r] = __builtin_amdgcn_exp2f(p0[r]);
}
__device__ __forceinline__ void finishSM(f32x16& p0, f32x16& p1, float alpha, float& l_reg, bf16x8& pa0, bf16x8& pa1, bf16x8& pa2, bf16x8& pa3) {
  for (int r = 0; r < 16; ++r) p1[r] = __builtin_amdgcn_exp2f(p1[r]);
  float ps = 0; for (int r = 0; r < 16; ++r) ps += p0[r]; for (int r = 0; r < 16; ++r) ps += p1[r];
  { auto rr = __builtin_amdgcn_permlane32_swap(__float_as_uint(ps), __float_as_uint(ps), false, false);
    ps = __uint_as_float(rr[0]) + __uint_as_float(rr[1]); }
  l_reg = l_reg * alpha + ps;
#define PK4(P, BASE, OUT) do { unsigned a0 = cvt_pk_bf16(P[BASE + 0], P[BASE + 1]), a1 = cvt_pk_bf16(P[BASE + 2], P[BASE + 3]);   \
    unsigned b0 = cvt_pk_bf16(P[BASE + 4], P[BASE + 5]), b1 = cvt_pk_bf16(P[BASE + 6], P[BASE + 7]);                              \
    auto r0 = __builtin_amdgcn_permlane32_swap(a0, b0, false, false); auto r1 = __builtin_amdgcn_permlane32_swap(a1, b1, false, false); \
    u32x4 w = {r0[0], r1[0], r0[1], r1[1]}; OUT = *reinterpret_cast<bf16x8*>(&w); } while (0)
  PK4(p0, 0, pa0); PK4(p0, 8, pa1); PK4(p1, 0, pa2); PK4(p1, 8, pa3);
#undef PK4
}
__device__ __forceinline__ void qkt(f32x16& p0, f32x16& p1, const bf16_t* Ks, const bf16x8* qr, int r32, int hi) {
  p0 = f32x16{}; p1 = f32x16{};
#pragma unroll
  for (int d0 = 0; d0 < 8; ++d0) { int cb = (d0 * 16 + hi * 8) * 2;
    bf16x8 b0 = *reinterpret_cast<const bf16x8*>((const char*)Ks + KSWZ(r32, cb));
    bf16x8 b1 = *reinterpret_cast<const bf16x8*>((const char*)Ks + KSWZ(32 + r32, cb));
    p0 = __builtin_amdgcn_mfma_f32_32x32x16_bf16(b0, qr[d0], p0, 0, 0, 0);
    p1 = __builtin_amdgcn_mfma_f32_32x32x16_bf16(b1, qr[d0], p1, 0, 0, 0); }
}
__device__ __forceinline__ int v_st(int k, int c) { const int kk = (k & ~0xC) | ((k & 4) << 1) | ((k & 8) >> 1); return ((kk >> 3) * 4 + (c >> 5)) * 512 + ((kk & 7) * 32 + (c & 31)) * 2; }
__device__ __forceinline__ int v_rd_base(int lane) { return ((lane & 3) << 3) | (((lane >> 2) & 3) << 6) | (((lane >> 4) & 1) << 5) | (((lane >> 5) & 1) << 8); }
constexpr int v_rd_off(int d0, int ks, int half) { return d0 * 512 + ks * 4096 + half * 2048; }
template <int OFF> __device__ __forceinline__ s16x4 tr_read(int vb) {
  s16x4 r; asm volatile("ds_read_b64_tr_b16 %0, %1 offset:%2" : "=&v"(r) : "v"(vb), "i"(OFF) : "memory"); return r;
}
template <int D0> __device__ __forceinline__ void pv_one(f32x16& od, int vb, bf16x8 pa0, bf16x8 pa1, bf16x8 pa2, bf16x8 pa3) {
  const s16x4 l0 = tr_read<v_rd_off(D0, 0, 0)>(vb), h0 = tr_read<v_rd_off(D0, 0, 1)>(vb), l1 = tr_read<v_rd_off(D0, 1, 0)>(vb), h1 = tr_read<v_rd_off(D0, 1, 1)>(vb);
  const s16x4 l2 = tr_read<v_rd_off(D0, 2, 0)>(vb), h2 = tr_read<v_rd_off(D0, 2, 1)>(vb), l3 = tr_read<v_rd_off(D0, 3, 0)>(vb), h3 = tr_read<v_rd_off(D0, 3, 1)>(vb);
  asm volatile("s_waitcnt lgkmcnt(0)" ::: "memory"); SBAR();
#define PK(L, H) (bf16x8){L[0], L[1], L[2], L[3], H[0], H[1], H[2], H[3]}
  od = __builtin_amdgcn_mfma_f32_32x32x16_bf16(pa0, PK(l0, h0), od, 0, 0, 0);
  od = __builtin_amdgcn_mfma_f32_32x32x16_bf16(pa1, PK(l1, h1), od, 0, 0, 0);
  od = __builtin_amdgcn_mfma_f32_32x32x16_bf16(pa2, PK(l2, h2), od, 0, 0, 0);
  od = __builtin_amdgcn_mfma_f32_32x32x16_bf16(pa3, PK(l3, h3), od, 0, 0, 0);
#undef PK
}
__device__ __forceinline__ void pv_d0(f32x16* o, int vb, bf16x8 pa0, bf16x8 pa1, bf16x8 pa2, bf16x8 pa3) {
  pv_one<0>(o[0], vb, pa0, pa1, pa2, pa3); pv_one<1>(o[1], vb, pa0, pa1, pa2, pa3); pv_one<2>(o[2], vb, pa0, pa1, pa2, pa3); pv_one<3>(o[3], vb, pa0, pa1, pa2, pa3);
}
__device__ __forceinline__ void attn_dense_body(const bf16_t* Qb, const bf16_t* __restrict__ Kh, const bf16_t* __restrict__ Vh, bf16_t* Ob, int seq, char* lds, int wave_s, const float* qg, const f32x2* rope, int tok0) {
  const int tid = tid_opaque(wave_s), wid = __builtin_amdgcn_readfirstlane(tid >> 6), lane = tid & 63, r32 = lane & 31, hi = lane >> 5;
  bf16_t* V_lds = (bf16_t*)lds; bf16_t* K_lds = (bf16_t*)(lds + 2 * SHM_V);
  float* ws = (float*)(lds + 2 * SHM_V + 2 * SHM_K) + wid * 64; float* li_l = ws; float* al_l = ws + 32;
  float m_reg = -1e30f, l_reg = 0; f32x16 o[4] = {}; bf16x8 qr[8];
  const bf16_t* Qw = Qb + (long)(wid * QBLK + r32) * LDQ + hi * 8;
#pragma unroll
  for (int d0 = 0; d0 < 8; ++d0) qr[d0] = *reinterpret_cast<const bf16x8*>(Qw + d0 * 16);
  {
    float qf[8][8]; float ss = 0.f;
#pragma unroll
    for (int d0 = 0; d0 < 8; ++d0) { const u32x4 w = __builtin_bit_cast(u32x4, qr[d0]);
      qf[d0][0] = bf_lo(w.x); qf[d0][1] = bf_hi(w.x); qf[d0][2] = bf_lo(w.y); qf[d0][3] = bf_hi(w.y); qf[d0][4] = bf_lo(w.z); qf[d0][5] = bf_hi(w.z); qf[d0][6] = bf_lo(w.w); qf[d0][7] = bf_hi(w.w);
#pragma unroll
      for (int e = 0; e < 8; ++e) ss += qf[d0][e] * qf[d0][e]; }
    { auto rr = __builtin_amdgcn_permlane32_swap(__float_as_uint(ss), __float_as_uint(ss), false, false); ss = __uint_as_float(rr[0]) + __uint_as_float(rr[1]); }
    const float rstd = rsqrtf(ss * (1.f / 128.f) + EPS);
#pragma unroll
    for (int d0 = 0; d0 < 8; ++d0) { const f32x4 g0 = *(const f32x4*)(qg + d0 * 16 + hi * 8), g1 = *(const f32x4*)(qg + d0 * 16 + hi * 8 + 4);
      qf[d0][0] *= rstd * g0.x; qf[d0][1] *= rstd * g0.y; qf[d0][2] *= rstd * g0.z; qf[d0][3] *= rstd * g0.w; qf[d0][4] *= rstd * g1.x; qf[d0][5] *= rstd * g1.y; qf[d0][6] *= rstd * g1.z; qf[d0][7] *= rstd * g1.w; }
    if (tok0 >= 0) { const int t = tok0 + wid * QBLK + r32, prow = t >> 6, pcol = t & 63;
#pragma unroll
      for (int h = 0; h < 2; ++h) { const f32x2* rp = rope + (h == 0 ? prow : pcol) * 32 + hi * 8;
#pragma unroll
        for (int dd = 0; dd < 2; ++dd)
#pragma unroll
          for (int e = 0; e < 8; ++e) { const f32x2 cs = rp[16 * dd + e]; const float x1 = qf[4 * h + dd][e], x2 = qf[4 * h + dd + 2][e];
            qf[4 * h + dd][e] = x1 * cs.x - x2 * cs.y; qf[4 * h + dd + 2][e] = x2 * cs.x + x1 * cs.y; } } }
#pragma unroll
    for (int d0 = 0; d0 < 8; ++d0) { u32x4 w; w.x = cvtpk_nv(qf[d0][0], qf[d0][1]); w.y = cvtpk_nv(qf[d0][2], qf[d0][3]); w.z = cvtpk_nv(qf[d0][4], qf[d0][5]); w.w = cvtpk_nv(qf[d0][6], qf[d0][7]); qr[d0] = __builtin_bit_cast(bf16x8, w); }
  }
  const int sr = tid >> 4, sc = (tid & 15) * 8, vst0 = v_st(sr, sc), vst1 = v_st(32 + sr, sc);
  const int vb0 = (int)(uintptr_t)V_lds + v_rd_base(lane);
  struct { bf16x8 vs0, vs1, ks0, ks1; } sr_[2];
#define SLOAD(i, k0) do { sr_[i].vs0 = *reinterpret_cast<const bf16x8*>(&Vh[(long)((k0) + sr) * LDK + sc]); sr_[i].vs1 = *reinterpret_cast<const bf16x8*>(&Vh[(long)((k0) + 32 + sr) * LDK + sc]); \
    sr_[i].ks0 = *reinterpret_cast<const bf16x8*>(&Kh[(long)((k0) + sr) * LDK + sc]); sr_[i].ks1 = *reinterpret_cast<const bf16x8*>(&Kh[(long)((k0) + 32 + sr) * LDK + sc]); } while (0)
#define SWRITE(b, i) do { *(bf16x8*)((char*)V_lds + (b) * SHM_V + vst0) = sr_[i].vs0;          \
    *(bf16x8*)((char*)V_lds + (b) * SHM_V + vst1) = sr_[i].vs1; int kc = sc * 2;               \
    *(bf16x8*)((char*)K_lds + (b) * SHM_K + KSWZ(sr, kc)) = sr_[i].ks0;                       \
    *(bf16x8*)((char*)K_lds + (b) * SHM_K + KSWZ(32 + sr, kc)) = sr_[i].ks1; } while (0)
#define SWAIT() asm volatile("s_waitcnt vmcnt(4)" ::: "memory")
#define RESC(a) do { if (__any((a) < 1.f)) { if (hi == 0) al_l[r32] = (a); asm volatile("s_waitcnt lgkmcnt(0)" ::: "memory"); \
    for (int d = 0; d < 4; ++d) for (int r = 0; r < 16; ++r) o[d][r] *= al_l[crow(r, hi)]; } } while (0)
  f32x16 pA0, pA1, pB0, pB1; float mnA, mnB, alA, alB; bf16x8 pa0, pa1, pa2, pa3; const int NT = seq / KVBLK;
  constexpr int SE = 0, SO = 1;
  SLOAD(SE, 0); asm volatile("s_waitcnt vmcnt(0)" ::: "memory"); SWRITE(0, SE); __syncthreads();
  qkt(pA0, pA1, K_lds, qr, r32, hi); partialSM(pA0, pA1, m_reg, mnA, alA);
  SLOAD(SO, KVBLK); if (2 < NT) SLOAD(SE, 2 * KVBLK);
  SWAIT(); SWRITE(1, SO); __syncthreads();
  for (int j = 1; j + 1 < NT; j += 2) {
    SBAR(); qkt(pB0, pB1, (bf16_t*)((char*)K_lds + SHM_K), qr, r32, hi);
    finishSM(pA0, pA1, alA, l_reg, pa0, pa1, pa2, pa3); SBAR();
    SLOAD(SO, (j + 2) * KVBLK); SBAR();
    pv_d0(o, vb0, pa0, pa1, pa2, pa3); partialSM(pB0, pB1, m_reg, mnB, alB);
    __syncthreads(); SWAIT(); SWRITE(0, SE);
    RESC(alB); __syncthreads();
    SBAR(); qkt(pA0, pA1, K_lds, qr, r32, hi);
    finishSM(pB0, pB1, alB, l_reg, pa0, pa1, pa2, pa3); SBAR();
    if (j + 3 < NT) SLOAD(SE, (j + 3) * KVBLK); SBAR();
    pv_d0(o, vb0 + (int)SHM_V, pa0, pa1, pa2, pa3); partialSM(pA0, pA1, m_reg, mnA, alA);
    __syncthreads(); SWAIT(); SWRITE(1, SO);
    RESC(alA); __syncthreads();
  }
  SBAR(); qkt(pB0, pB1, (bf16_t*)((char*)K_lds + SHM_K), qr, r32, hi);
  finishSM(pA0, pA1, alA, l_reg, pa0, pa1, pa2, pa3); SBAR();
  pv_d0(o, vb0, pa0, pa1, pa2, pa3); partialSM(pB0, pB1, m_reg, mnB, alB);
  __syncthreads(); RESC(alB);
  finishSM(pB0, pB1, alB, l_reg, pa0, pa1, pa2, pa3); SBAR();
  pv_d0(o, vb0 + (int)SHM_V, pa0, pa1, pa2, pa3);
  if (hi == 0) li_l[r32] = l_reg; asm volatile("s_waitcnt lgkmcnt(0)" ::: "memory");
  float rli[16];
#pragma unroll
  for (int r = 0; r < 16; ++r) rli[r] = __builtin_amdgcn_rcpf(li_l[crow(r, hi)]);
  bf16_t* Ow = Ob + (long)(wid * QBLK) * LDO;
  {
    bf16_t* stg = (bf16_t*)(lds + OST_OFF) + wid * (32 * 136);
#pragma unroll
    for (int r = 0; r < 16; ++r) { const int orow = crow(r, hi);
#pragma unroll
      for (int d0 = 0; d0 < 4; ++d0) { const float v = o[d0][r] * rli[r]; stg[orow * 136 + d0 * 32 + r32] = (bf16_t)(cvtpk_nv(v, v) & 0xffffu); } }
    asm volatile("s_waitcnt lgkmcnt(0)" ::: "memory");
#pragma unroll
    for (int i = 0; i < 8; ++i) { const int row = i * 4 + (lane >> 4), chn = lane & 15; const u32x4 v = *(const u32x4*)(stg + row * 136 + chn * 8); *(u32x4*)(Ow + (long)row * LDO + chn * 8) = v; }
  }
  __syncthreads();
#undef SLOAD
#undef SWRITE
#undef SWAIT
#undef RESC
}
#undef KSWZ
#undef SBAR
}

__device__ __forceinline__ void p0_transpose_item(const float* W, int K, int N, bf16_t* WT, int mode, LAS float* scr, int item, int lane) {
    const int nblk = N / 32, kb = item / nblk, nb = item % nblk, k0 = 64 * kb, n0 = 32 * nb;
    const float wscale = (mode == 2) ? -1.4426950408889634f : 1.0f;
#pragma unroll 8
    for (int i = 0; i < 32; ++i) { const int kk = 2 * i + (lane >> 5); scr[kk * 33 + (lane & 31)] = W[(size_t)(k0 + kk) * N + n0 + (lane & 31)] * wscale; }
    asm volatile("s_waitcnt lgkmcnt(0)" ::: "memory");
    int r0 = n0;
    if (mode == 1) r0 = n0 < FFW ? 256 * (n0 / 128) + (n0 % 128) : 256 * ((n0 - FFW) / 128) + 128 + ((n0 - FFW) % 128);
    if (mode == 3 && n0 >= CSC && n0 < CSC + 2048) { const int rel = n0 - CSC;
        r0 = rel < 1024 ? CSC + 256 * (rel / 128) + (rel % 128) : CSC + 256 * ((rel - 1024) / 128) + 128 + ((rel - 1024) % 128); }
    const int c = lane & 7;
#pragma unroll
    for (int j = 0; j < 4; ++j) { const int n = (lane >> 3) + 8 * j; const LAS float* s = scr + (8 * c) * 33 + n;
        u32x4 o; o.x = cvt_pk_bf16(s[0 * 33], s[1 * 33]); o.y = cvt_pk_bf16(s[2 * 33], s[3 * 33]); o.z = cvt_pk_bf16(s[4 * 33], s[5 * 33]); o.w = cvt_pk_bf16(s[6 * 33], s[7 * 33]);
        *(u32x4*)(WT + (size_t)(r0 + n) * K + k0 + 8 * c) = o; }
    asm volatile("s_waitcnt lgkmcnt(0)" ::: "memory");
}

__device__ __forceinline__ void phase_p0(CArgs a, const Frame& F, LAS unsigned char* lds) {
    const int tid = tid_opaque(F.wave_s), lane = tid & 63, wave = __builtin_amdgcn_readfirstlane(tid >> 6);
    for (int it = bid_opaque(); it < 96; it += gridDim.x) {
        const int l = it / 48, cg0 = (it % 48) * 128;
        LAS float* sv = (LAS float*)lds;
        LAS float* red = (LAS float*)(lds + 9 * 1024 * 4);
        for (int e = tid; e < 9 * 1024; e += NTHREADS) { const int b = e >> 10, k = e & 1023; const float v = b < 8 ? a->in[1][b * 1024 + k] : a->in[3][k]; sv[e] = v * fast_sigmoid(v); }
        __syncthreads();
        const int kq = tid >> 7, col = tid & 127;
        float accv[9];
#pragma unroll
        for (int b = 0; b < 9; ++b) accv[b] = 0.f;
        const float* wp = a->in[4] + ((size_t)l * 1024 + kq * 256) * 6144 + cg0 + col;
#pragma unroll 4
        for (int k = 0; k < 256; ++k) { const float w = wp[(size_t)k * 6144];
#pragma unroll
            for (int b = 0; b < 9; ++b) accv[b] += sv[b * 1024 + kq * 256 + k] * w; }
#pragma unroll
        for (int b = 0; b < 9; ++b) red[(kq * 9 + b) * 128 + col] = accv[b];
        __syncthreads();
        if (tid < 128) {
#pragma unroll
            for (int b = 0; b < 9; ++b) { const float s = red[(0 * 9 + b) * 128 + tid] + red[(1 * 9 + b) * 128 + tid] + red[(2 * 9 + b) * 128 + tid] + red[(3 * 9 + b) * 128 + tid];
                ((float*)(a->ws + WS_MOD))[(size_t)(l * 9 + b) * 6144 + cg0 + tid] = s + a->in[5][l * 6144 + cg0 + tid]; }
        }
        __syncthreads();
    }
    if (bid_opaque() == gridDim.x - 1) {
        for (int e = tid; e < 2048; e += NTHREADS) { const int pos = e >> 5, f = e & 31; const float inv = __builtin_amdgcn_exp2f(-(float)f * (13.287712379549449f / 32.0f)); const float rev = (float)pos * inv * 0.15915494309189535f;
            const float fr_ = rev - floorf(rev);
            ((f32x2*)(a->ws + WS_ROPE))[e] = (f32x2){__builtin_amdgcn_cosf(fr_), __builtin_amdgcn_sinf(fr_)}; }
    }
    LAS float* scr = (LAS float*)(lds + 57344 + wave * 8704);
    const int gw = bid_opaque() * NWAVES + wave, NGW = gridDim.x * NWAVES;
    constexpr int I_IN = 16 * 304, I_SQ = 16 * 32, I_F1 = 16 * 176, I_F2 = 44 * 32, I_LRU = 256, I_LAYER = I_IN + 4 * I_SQ + I_F1 + I_F2 + I_LRU;
    for (int it = gw; it < 2 * I_LAYER; it += NGW) {
        const int l = it / I_LAYER; int r = it % I_LAYER;
        unsigned char* wl = a->ws + WS_W + (size_t)l * W_LAYER;
        if (r < I_IN) { p0_transpose_item(a->in[8] + (size_t)l * DM * NIN, DM, NIN, (bf16_t*)(wl + W_IN), 3, scr, r, lane); continue; } r -= I_IN;
        if (r < I_SQ) { p0_transpose_item(a->in[11] + (size_t)l * DM * DM, DM, DM, (bf16_t*)(wl + W_AO), 0, scr, r, lane); continue; } r -= I_SQ;
        if (r < I_SQ) { p0_transpose_item(a->in[14] + (size_t)l * DM * DM, DM, DM, (bf16_t*)(wl + W_SO), 0, scr, r, lane); continue; } r -= I_SQ;
        if (r < I_SQ) { p0_transpose_item(a->in[22] + (size_t)l * DM * DM, DM, DM, (bf16_t*)(wl + W_LO), 0, scr, r, lane); continue; } r -= I_SQ;
        if (r < I_SQ) { p0_transpose_item(a->in[23] + (size_t)l * DM * DM, DM, DM, (bf16_t*)(wl + W_MO), 0, scr, r, lane); continue; } r -= I_SQ;
        if (r < I_F1) { p0_transpose_item(a->in[24] + (size_t)l * DM * 2 * FFW, DM, 2 * FFW, (bf16_t*)(wl + W_F1), 1, scr, r, lane); continue; } r -= I_F1;
        if (r < I_F2) { p0_transpose_item(a->in[25] + (size_t)l * FFW * DM, FFW, DM, (bf16_t*)(wl + W_F2), 0, scr, r, lane); continue; } r -= I_F2;
        { const int mat = r >> 3, d = mat >> 4, g = (mat >> 3) & 1, n = mat & 7;
          const float* src = (g == 0 ? a->in[17] : a->in[19]) + (size_t)((l * 2 + d) * 8 + n) * 16384;
          p0_transpose_item(src, 128, 128, (bf16_t*)(wl + W_LRU) + (size_t)((d * 2 + g) * 8 + n) * 16384, 2, scr, r & 7, lane); }
    }
}

__device__ __forceinline__ void phase_norm(CArgs a, const Frame& F, int which) {
    const int tid_ = tid_opaque(F.wave_s); const int lane = tid_ & 63, wave = __builtin_amdgcn_readfirstlane(tid_ >> 6);
    const int gw = bid_opaque() * NWAVES + wave, NGW = gridDim.x * NWAVES;
    const bool first = (which == 0 && F.l == 0);
    const int nrows = (which == 1 && F.l == 1) ? LROWS : ROWS;
    const float* g = (which == 0 ? a->in[6] : a->in[7]) + F.l * DM;
    for (int m = gw; m < nrows; m += NGW) {
        const bool lat = m < LROWS;
        const float* src = lat ? (first ? F.x : F.out) + (size_t)m * DM : (first ? F.ctx : F.XC()) + (size_t)(m - LROWS) * DM;
        const int b = lat ? (m >> 12) : 8;
        const float* md = F.MOD(b) + (which == 0 ? 0 : 3072);
        f32x4 v[4]; float s = 0.f;
#pragma unroll
        for (int j = 0; j < 4; ++j) { v[j] = *(const f32x4*)(src + 4 * lane + 256 * j); s += (v[j].x * v[j].x + v[j].y * v[j].y) + (v[j].z * v[j].z + v[j].w * v[j].w); }
        const float rstd = rsqrtf(wave_sum(s) * (1.f / DM) + EPS);
        bf16_t* dst = F.H() + (size_t)m * DM;
#pragma unroll
        for (int j = 0; j < 4; ++j) { const int col = 4 * lane + 256 * j;
            const f32x4 gg = *(const f32x4*)(g + col), sh = *(const f32x4*)(md + col), sc = *(const f32x4*)(md + 1024 + col);
            const f32x4 h = (v[j] * rstd * gg) * (sc + 1.0f) + sh;
            u32x2 w; w.x = cvt_pk_bf16(h.x, h.y); w.y = cvt_pk_bf16(h.z, h.w); *(u32x2*)(dst + col) = w; }
    }
}
__device__ __forceinline__ void phase_final(CArgs a, const Frame& F) {
    const int tid_ = tid_opaque(F.wave_s); const int lane = tid_ & 63, wave = __builtin_amdgcn_readfirstlane(tid_ >> 6);
    const int gw = bid_opaque() * NWAVES + wave, NGW = gridDim.x * NWAVES;
    const float* g = a->in[26];
    for (int m = gw; m < LROWS; m += NGW) {
        float* p = F.out + (size_t)m * DM;
        f32x4 v[4]; float s = 0.f;
#pragma unroll
        for (int j = 0; j < 4; ++j) { v[j] = *(const f32x4*)(p + 4 * lane + 256 * j); s += (v[j].x * v[j].x + v[j].y * v[j].y) + (v[j].z * v[j].z + v[j].w * v[j].w); }
        const float rstd = rsqrtf(wave_sum(s) * (1.f / DM) + EPS);
#pragma unroll
        for (int j = 0; j < 4; ++j) { const int col = 4 * lane + 256 * j; *(f32x4*)(p + col) = v[j] * rstd * *(const f32x4*)(g + col); }
    }
}

struct QkRow { u32x4 raw[3]; bf16_t* p[3]; bool act[3]; bool lat; int pos; };
__device__ __forceinline__ void qk_load(const Frame& F, int lr, int s, int i, int qd, QkRow& R) {
    const bool lat = lr < CH_L; R.lat = lat;
    int kvrow, prow = 0, pcol = 0;
    if (lat) { const int bl = lr >> 12, t = lr & 4095; kvrow = bl * KVLEN + CTXL + t; prow = t >> 6; pcol = t & 63; }
    else { const int lc = lr - CH_L; kvrow = (lc >> 8) * KVLEN + (lc & 255); }
    R.pos = qd < 2 ? prow : pcol;
#pragma unroll
    for (int it = 0; it < 3; ++it) { const int hs = 4 * it + s;
        R.act[it] = hs >= 8 && hs < 10 && lr < CH_ROWS;
        R.p[it] = hs < 8 ? F.Z() + (size_t)lr * ZP + hs * 128 + 8 * i : F.Kb() + (size_t)kvrow * 256 + (hs - 8) * 128 + 8 * i;
        if (R.act[it]) R.raw[it] = *(const u32x4*)R.p[it]; }
}
__device__ __forceinline__ void qk_finish(const Frame& F, const float* qg, const float* kg, const f32x2* rope, int s, int i, int qd, const QkRow& R) {
#pragma unroll
    for (int it = 0; it < 3; ++it) {
        if (R.act[it]) {
            const int hs = 4 * it + s; const float* gp = hs < 8 ? qg : kg; const u32x4 raw = R.raw[it];
            float v[8] = {bf_lo(raw.x), bf_hi(raw.x), bf_lo(raw.y), bf_hi(raw.y), bf_lo(raw.z), bf_hi(raw.z), bf_lo(raw.w), bf_hi(raw.w)};
            float ss = 0.f;
#pragma unroll
            for (int e = 0; e < 8; ++e) ss += v[e] * v[e];
            ss += swz_xor<1>(ss); ss += swz_xor<2>(ss); ss += swz_xor<4>(ss); ss += swz_xor<8>(ss);
            const float rstd = rsqrtf(ss * (1.f / 128.f) + EPS);
            const f32x4 g0 = *(const f32x4*)gp, g1 = *(const f32x4*)(gp + 4);
            v[0] *= rstd * g0.x; v[1] *= rstd * g0.y; v[2] *= rstd * g0.z; v[3] *= rstd * g0.w; v[4] *= rstd * g1.x; v[5] *= rstd * g1.y; v[6] *= rstd * g1.z; v[7] *= rstd * g1.w;
            if (R.lat) {
                const f32x2* rp = rope + R.pos * 32 + 8 * (i & 3);
#pragma unroll
                for (int e = 0; e < 8; ++e) { const float pv = swz_xor<4>(v[e]); const f32x2 cs = rp[e]; v[e] = (qd & 1) ? v[e] * cs.x + pv * cs.y : v[e] * cs.x - pv * cs.y; }
            }
            u32x4 w; w.x = cvt_pk_bf16(v[0], v[1]); w.y = cvt_pk_bf16(v[2], v[3]); w.z = cvt_pk_bf16(v[4], v[5]); w.w = cvt_pk_bf16(v[6], v[7]);
            *(u32x4*)R.p[it] = w;
        }
    }
}
__device__ __forceinline__ void phase_qknorm(CArgs a, const Frame& F) {
    const int tid_ = tid_opaque(F.wave_s); const int lane = tid_ & 63, wave = __builtin_amdgcn_readfirstlane(tid_ >> 6);
    const int gw = bid_opaque() * NWAVES + wave, NGW = gridDim.x * NWAVES;
    const int s = lane >> 4, i = lane & 15, qd = i >> 2;
    const float* qg = a->in[9] + F.l * 128 + 8 * i; const float* kg = a->in[10] + F.l * 128 + 8 * i;
    const f32x2* rope = (const f32x2*)(F.ws + WS_ROPE);
    for (int lr = gw; lr < CH_ROWS; lr += 2 * NGW) {
        QkRow R0, R1;
        qk_load(F, lr, s, i, qd, R0); qk_load(F, lr + NGW, s, i, qd, R1);
        qk_finish(F, qg, kg, rope, s, i, qd, R0); qk_finish(F, qg, kg, rope, s, i, qd, R1);
    }
}

__device__ __forceinline__ void phase_sconv(CArgs a, const Frame& F) {
    const int tid_ = tid_opaque(F.wave_s); const int lane = tid_ & 63, wave = __builtin_amdgcn_readfirstlane(tid_ >> 6);
    const int gw = bid_opaque() * NWAVES + wave, NGW = gridDim.x * NWAVES;
    const int nrows = (F.l == 0) ? CH_ROWS : CH_L;
    const float* wsc = a->in[12] + (size_t)F.l * 3 * DM; const float* bsc = a->in[13] + (size_t)F.l * DM;
    for (int it = gw; it < (nrows / 16) * 2; it += NGW) {
        const int run = it >> 1, ch0 = (it & 1) * 512 + lane * 8, lr0 = run * 16;
        int t0, slen;
        if (lr0 < CH_L) { t0 = lr0 & 4095; slen = SEQ; } else { t0 = (lr0 - CH_L) & 255; slen = CTXL; }
        float w0[8], w1[8], w2[8], bb[8];
#pragma unroll
        for (int e = 0; e < 8; ++e) { w0[e] = wsc[ch0 + e]; w1[e] = wsc[DM + ch0 + e]; w2[e] = wsc[2 * DM + ch0 + e]; bb[e] = bsc[ch0 + e]; }
        bf16_t* zr = F.Z() + (size_t)lr0 * ZP + ch0;
        float up[8], uc[8], un[8];
        auto loadu = [&](int dt, float* u, bool valid) {
            if (valid) { const u32x4 cc = *(const u32x4*)(zr + (long)dt * ZP + CSC);
                u[0] = bf_lo(cc.x); u[1] = bf_hi(cc.x); u[2] = bf_lo(cc.y); u[3] = bf_hi(cc.y); u[4] = bf_lo(cc.z); u[5] = bf_hi(cc.z); u[6] = bf_lo(cc.w); u[7] = bf_hi(cc.w); }
            else {
#pragma unroll
                for (int e = 0; e < 8; ++e) u[e] = 0.f; } };
        loadu(-1, up, t0 > 0); loadu(0, uc, true);
#pragma unroll 8
        for (int tt = 0; tt < 16; ++tt) {
            loadu(tt + 1, un, t0 + tt + 1 < slen);
            const u32x4 bq = *(const u32x4*)(zr + (long)tt * ZP + CSB);
            const float bv[8] = {bf_lo(bq.x), bf_hi(bq.x), bf_lo(bq.y), bf_hi(bq.y), bf_lo(bq.z), bf_hi(bq.z), bf_lo(bq.w), bf_hi(bq.w)};
            float o[8];
#pragma unroll
            for (int e = 0; e < 8; ++e) { o[e] = bv[e] * (bb[e] + w0[e] * up[e] + w1[e] * uc[e] + w2[e] * un[e]); up[e] = uc[e]; uc[e] = un[e]; }
            u32x4 w; w.x = cvt_pk_bf16(o[0], o[1]); w.y = cvt_pk_bf16(o[2], o[3]); w.z = cvt_pk_bf16(o[4], o[5]); w.w = cvt_pk_bf16(o[6], o[7]);
            *(u32x4*)(zr + (long)tt * ZP + CSB) = w;
        }
    }
}

constexpr int L_XS = 0, L_XS_STRIDE = 136, L_YT = 17408, L_YT_STRIDE = 132, L_WV = L_YT + 64 * L_YT_STRIDE * 4, L_WV_BYTES = 2 * 16 * 68 * 4, L_CW = L_WV + 8 * L_WV_BYTES;
constexpr int L_XS2 = L_CW + 5 * 128 * 4;
static_assert(L_XS2 + 64 * L_XS_STRIDE * 2 <= MISC_OFF, "lru lds");
struct LruCtx { bf16x8 wf[2][2][4]; float pba[2], pbx[2], spl[2]; };
__device__ __forceinline__ void lru_setup(CArgs a, const Frame& F, int n, LruCtx& C) {
    const int tid = tid_opaque(F.wave_s), lane = tid & 63, wave = __builtin_amdgcn_readfirstlane(tid >> 6), fr = lane & 15, fq = lane >> 4;
    const int l = F.l, ech = wave * 16 + fr, chg = n * 128 + ech;
    const bf16_t* wt = F.W(W_LRU) + (size_t)n * 16384 + (size_t)ech * 128 + fq * 8;
#pragma unroll
    for (int d = 0; d < 2; ++d)
#pragma unroll
        for (int g = 0; g < 2; ++g)
#pragma unroll
            for (int ks = 0; ks < 4; ++ks) C.wf[d][g][ks] = *(const bf16x8*)(wt + (size_t)((d * 2 + g) * 8) * 16384 + ks * 32);
#pragma unroll
    for (int d = 0; d < 2; ++d) { C.pba[d] = a->in[18][(l * 2 + d) * DM + chg] * -1.4426950408889634f; C.pbx[d] = a->in[20][(l * 2 + d) * DM + chg] * -1.4426950408889634f;   const float lam = a->in[21][(l * 2 + d) * DM + chg];
        const float ey = __builtin_amdgcn_exp2f(-lam * 1.4426950408889634f);
        const float sp_small = ey * (1.0f + ey * (-0.5f + ey * (0.33333334f + ey * (-0.25f + ey * 0.2f))));
        const float sp_big = (lam < -15.f) ? -lam : __builtin_amdgcn_logf(1.0f + ey) * 0.6931471805599453f;
        C.spl[d] = (ey < 0.125f ? sp_small : sp_big) * (8.0f * 1.4426950408889634f); }
}
struct XRows { u32x4 r[4][2]; };
__device__ __forceinline__ void lru_load_rows(const Frame& F, int tile, int n, XRows& X) {
    const int tid = tid_opaque(F.wave_s), t = tid >> 3, c0 = (tid & 7) * 16;
    const int lrow0 = tile < 256 ? tile * 64 : CH_L + (tile - 256) * 64;
#pragma unroll
    for (int k = 0; k < 4; ++k) { int row = lrow0 + t + k - 2; row = row < 0 ? 0 : (row > CH_ROWS - 1 ? CH_ROWS - 1 : row);
        const bf16_t* zr = F.Z() + (size_t)row * ZP + CRX + n * 128 + c0; X.r[k][0] = *(const u32x4*)zr; X.r[k][1] = *(const u32x4*)(zr + 8); }
}
__device__ __forceinline__ void lru_item(CArgs a, const Frame& F, LAS unsigned char* lds, int pass, int tile, int n, const LruCtx& C, const float cy, const XRows& X, const int xbuf) {
    const int tid = tid_opaque(F.wave_s), lane = tid & 63, wave = __builtin_amdgcn_readfirstlane(tid >> 6), fr = lane & 15, fq = lane >> 4;
    const int l = F.l;
    LAS bf16_t* xs = (LAS bf16_t*)(lds + (xbuf ? L_XS2 : L_XS)); LAS float* yt = (LAS float*)(lds + L_YT);
    LAS float* wa = (LAS float*)(lds + L_WV + wave * L_WV_BYTES); LAS float* wu = wa + 16 * 68;
    int lrow0, t0, slen;
    if (tile < 256) { lrow0 = tile * 64; t0 = (tile & 63) * 64; slen = SEQ; }
    else { const int jj = tile - 256; lrow0 = CH_L + jj * 64; t0 = (jj & 3) * 64; slen = CTXL; }
    float* lsum = (float*)(F.ws + WS_LSUM);
    const int ech = wave * 16 + fr, chg = n * 128 + ech;
    u32x4 g0 = {0u, 0u, 0u, 0u}, g1 = {0u, 0u, 0u, 0u};
    if (pass == 2) { const bf16_t* zg = F.Z() + (size_t)(lrow0 + (tid >> 3)) * ZP + CRG + n * 128 + (tid & 7) * 16; g0 = *(const u32x4*)zg; g1 = *(const u32x4*)(zg + 8); }
    {
        const int t = tid >> 3, c0 = (tid & 7) * 16;
        const LAS float* cw = (const LAS float*)(lds + L_CW) + c0;
        float accv[16];
#pragma unroll
        for (int i = 0; i < 4; ++i) { const f32x4 b4 = *(const LAS f32x4*)(cw + 4 * 128 + 4 * i); accv[4 * i] = b4[0]; accv[4 * i + 1] = b4[1]; accv[4 * i + 2] = b4[2]; accv[4 * i + 3] = b4[3]; }
#pragma unroll
        for (int k = 0; k < 4; ++k) { const int ts = t0 + t + k - 2;
            if (ts >= 0 && ts < slen) { const u32x4 r0 = X.r[k][0], r1 = X.r[k][1];
                const float xv[16] = {bf_lo(r0.x), bf_hi(r0.x), bf_lo(r0.y), bf_hi(r0.y), bf_lo(r0.z), bf_hi(r0.z), bf_lo(r0.w), bf_hi(r0.w), bf_lo(r1.x), bf_hi(r1.x), bf_lo(r1.y), bf_hi(r1.y), bf_lo(r1.z), bf_hi(r1.z), bf_lo(r1.w), bf_hi(r1.w)};
#pragma unroll
                for (int i = 0; i < 4; ++i) { const f32x4 w4 = *(const LAS f32x4*)(cw + k * 128 + 4 * i);
                    accv[4 * i] += xv[4 * i] * w4[0]; accv[4 * i + 1] += xv[4 * i + 1] * w4[1]; accv[4 * i + 2] += xv[4 * i + 2] * w4[2]; accv[4 * i + 3] += xv[4 * i + 3] * w4[3]; } } }
        u32x4 w0, w1; w0.x = cvt_pk_bf16(accv[0], accv[1]); w0.y = cvt_pk_bf16(accv[2], accv[3]); w0.z = cvt_pk_bf16(accv[4], accv[5]); w0.w = cvt_pk_bf16(accv[6], accv[7]);
        w1.x = cvt_pk_bf16(accv[8], accv[9]); w1.y = cvt_pk_bf16(accv[10], accv[11]); w1.z = cvt_pk_bf16(accv[12], accv[13]); w1.w = cvt_pk_bf16(accv[14], accv[15]);
        *(LAS u32x4*)(xs + t * L_XS_STRIDE + c0) = w0; *(LAS u32x4*)(xs + t * L_XS_STRIDE + c0 + 8) = w1;
    }
    __syncthreads();
    f32x4 accg[2][2][4];
#pragma unroll
    for (int d = 0; d < 2; ++d)
#pragma unroll
        for (int g = 0; g < 2; ++g)
#pragma unroll
            for (int m = 0; m < 4; ++m) { const float b = g == 0 ? C.pba[d] : C.pbx[d]; accg[d][g][m] = (f32x4){b, b, b, b}; }
#pragma unroll
    for (int ks = 0; ks < 4; ++ks)
#pragma unroll
        for (int m = 0; m < 4; ++m) { const bf16x8 af = *(const LAS bf16x8*)(xs + (16 * m + fr) * L_XS_STRIDE + ks * 32 + fq * 8);
#pragma unroll
            for (int d = 0; d < 2; ++d)
#pragma unroll
                for (int g = 0; g < 2; ++g) accg[d][g][m] = __builtin_amdgcn_mfma_f32_16x16x32_bf16(af, C.wf[d][g][ks], accg[d][g][m], 0, 0, 0); }
    float xv[4][4];
#pragma unroll
    for (int m = 0; m < 4; ++m)
#pragma unroll
        for (int jj = 0; jj < 4; ++jj) xv[m][jj] = bf1(xs[(16 * m + 4 * fq + jj) * L_XS_STRIDE + ech]);
    float y[16];
#pragma unroll
    for (int d = 0; d < 2; ++d) {
#pragma unroll
        for (int m = 0; m < 4; ++m) { f32x4 av, uv;
#pragma unroll
            for (int jj = 0; jj < 4; ++jj) {
                const float r = __builtin_amdgcn_rcpf(1.0f + __builtin_amdgcn_exp2f(accg[d][0][m][jj])), ig = __builtin_amdgcn_rcpf(1.0f + __builtin_amdgcn_exp2f(accg[d][1][m][jj]));
                const float av1 = __builtin_amdgcn_exp2f(-r * C.spl[d]);
                const float om = __builtin_fmaf(-av1, av1, 1.0f);
                av[jj] = av1; uv[jj] = __builtin_amdgcn_sqrtf(om) * (ig * xv[m][jj]); }
            *(LAS f32x4*)(wa + fr * 68 + 16 * m + 4 * fq) = av; *(LAS f32x4*)(wu + fr * 68 + 16 * m + 4 * fq) = uv; }
        asm volatile("s_waitcnt lgkmcnt(0)" ::: "memory");
        f32x4 A4[4], U4[4];
#pragma unroll
        for (int i = 0; i < 4; ++i) { A4[i] = *(const LAS f32x4*)(wa + fr * 68 + 16 * fq + 4 * i); U4[i] = *(const LAS f32x4*)(wu + fr * 68 + 16 * fq + 4 * i); }
        asm volatile("s_waitcnt lgkmcnt(0)" ::: "memory");
        float hl[16], Pl[16]; float h = 0.f, P = 1.f;
        if (d == 0) {
#pragma unroll
            for (int s = 0; s < 16; ++s) { const float av = A4[s >> 2][s & 3], uv = U4[s >> 2][s & 3]; h = av * h + uv; P *= av; hl[s] = h; Pl[s] = P; }
        } else {
#pragma unroll
            for (int s = 15; s >= 0; --s) { const float av = A4[s >> 2][s & 3], uv = U4[s >> 2][s & 3]; h = av * h + uv; P *= av; hl[s] = h; Pl[s] = P; }
        }
        float Pk[4], Hk[4];
#pragma unroll
        for (int k = 0; k < 4; ++k) { Pk[k] = bperm(P, k * 16 + fr); Hk[k] = bperm(h, k * 16 + fr); }
        float c = (pass == 2) ? bperm(cy, d * 16 + fr) : 0.f, cin = 0.f, Pt = 1.f;
#pragma unroll
        for (int kk = 0; kk < 4; ++kk) { const int k = d == 0 ? kk : 3 - kk; if (k == fq) cin = c; c = Pk[k] * c + Hk[k]; Pt *= Pk[k]; }
        if (pass == 1) { if (fq == 0) ((f32x2*)lsum)[(size_t)tile * 2048 + d * 1024 + chg] = (f32x2){Pt, c}; }
        else {
#pragma unroll
            for (int s = 0; s < 16; ++s) { const float hv = hl[s] + Pl[s] * cin; if (d == 0) y[s] = hv; else y[s] += hv; }
        }
    }
    if (pass == 2) {
#pragma unroll
        for (int s = 0; s < 16; ++s) yt[(16 * fq + s) * L_YT_STRIDE + ech] = y[s];
        __syncthreads();
        const int t = tid >> 3, c0 = (tid & 7) * 16;
        bf16_t* zr = F.Z() + (size_t)(lrow0 + t) * ZP + CRG + n * 128 + c0;
        const float gv[16] = {bf_lo(g0.x), bf_hi(g0.x), bf_lo(g0.y), bf_hi(g0.y), bf_lo(g0.z), bf_hi(g0.z), bf_lo(g0.w), bf_hi(g0.w), bf_lo(g1.x), bf_hi(g1.x), bf_lo(g1.y), bf_hi(g1.y), bf_lo(g1.z), bf_hi(g1.z), bf_lo(g1.w), bf_hi(g1.w)};
        float o[16];
#pragma unroll
        for (int i = 0; i < 4; ++i) { const f32x4 yv = *(const LAS f32x4*)(yt + t * L_YT_STRIDE + c0 + 4 * i); o[4 * i] = yv[0] * gv[4 * i]; o[4 * i + 1] = yv[1] * gv[4 * i + 1]; o[4 * i + 2] = yv[2] * gv[4 * i + 2]; o[4 * i + 3] = yv[3] * gv[4 * i + 3]; }
        u32x4 w0, w1; w0.x = cvt_pk_bf16(o[0], o[1]); w0.y = cvt_pk_bf16(o[2], o[3]); w0.z = cvt_pk_bf16(o[4], o[5]); w0.w = cvt_pk_bf16(o[6], o[7]);
        w1.x = cvt_pk_bf16(o[8], o[9]); w1.y = cvt_pk_bf16(o[10], o[11]); w1.z = cvt_pk_bf16(o[12], o[13]); w1.w = cvt_pk_bf16(o[14], o[15]);
        *(u32x4*)(zr + (CSC - CRG)) = w0; *(u32x4*)(zr + (CSC - CRG) + 8) = w1;
    }
}

__device__ __forceinline__ void lru_phase(CArgs a, const Frame& F, LAS unsigned char* lds, int pass) {
    const int tid = tid_opaque(F.wave_s), lane = tid & 63, wave = __builtin_amdgcn_readfirstlane(tid >> 6), fr = lane & 15;
    const int d = (lane >> 4) & 1; const bool cl = (pass == 2) && lane < 32;
    for (int w = bid_opaque(); w < 256; w += gridDim.x) {
        const int bl = w >> 6, n = (w >> 3) & 7, sg = w & 7;
        LruCtx C; lru_setup(a, F, n, C);
        { LAS float* cwl = (LAS float*)(lds + L_CW);
          for (int e = tid_opaque(F.wave_s); e < 640; e += NTHREADS) cwl[e] = e < 512 ? a->in[15][(size_t)F.l * 4 * DM + (e >> 7) * DM + n * 128 + (e & 127)] : a->in[16][(size_t)F.l * DM + n * 128 + (e - 512)];
          __syncthreads(); }
        XRows xc, xn; lru_load_rows(F, bl * 64 + sg * 8, n, xc);
        const int lane1 = tid_opaque(F.wave_s) & 63;
        const int d1 = (lane1 >> 4) & 1;
        const f32x2* sp = (const f32x2*)(F.ws + WS_LSUM) + (size_t)d1 * 1024 + n * 128 + wave * 16 + (lane1 & 15);
        const int cf = 256 + bl * 4, lf = bl * 64;
        float cb = 0.f;
        if (cl) {
#pragma unroll
            for (int q = 0; q < 4; ++q) { const f32x2 s = sp[(size_t)(d1 == 0 ? cf + q : cf + 3 - q) * 2048]; cb = s.x * cb + s.y; }
            const int cnt = d1 == 0 ? sg * 8 : 56 - sg * 8, start = d1 == 0 ? lf : lf + 63, step = d1 == 0 ? 1 : -1;
#pragma unroll 8
            for (int q = 0; q < cnt; ++q) { const f32x2 s = sp[(size_t)(start + q * step) * 2048]; cb = s.x * cb + s.y; }
        }
        float cys[8];
#pragma unroll
        for (int q = 0; q < 8; ++q) cys[q] = 0.f;
        if (cl) { f32x2 ss[8];
#pragma unroll
            for (int q = 0; q < 8; ++q) ss[q] = sp[(size_t)(lf + sg * 8 + q) * 2048];
            float c = cb;
#pragma unroll
            for (int q = 0; q < 8; ++q) { const int qq = d1 == 0 ? q : 7 - q; const f32x2 sv = d1 == 0 ? ss[q] : ss[7 - q];
                if (d1 == 0) { cys[q] = c; } else { cys[7 - q] = c; } c = sv.x * c + sv.y; (void)qq; } }
        for (int jj = 0; jj < 8; ++jj) {
            const int tl = sg * 8 + jj; float cy = cys[0];
#pragma unroll
            for (int q = 1; q < 8; ++q) cy = (jj == q) ? cys[q] : cy;
            const bool has_ctx = sg < 4 && (pass == 1 || F.l == 0);
            if (jj < 7) lru_load_rows(F, lf + tl + 1, n, xn); else if (has_ctx) lru_load_rows(F, cf + sg, n, xn);
            lru_item(a, F, lds, pass, lf + tl, n, C, cy, xc, jj & 1);
            xc = xn;
        }
        if (sg < 4 && (pass == 1 || F.l == 0)) {
            float cy = 0.f;
            const int lane2 = tid_opaque(F.wave_s) & 63;
            const f32x2* sp = (const f32x2*)(F.ws + WS_LSUM) + (size_t)((lane2 >> 4) & 1) * 1024 + n * 128 + wave * 16 + (lane2 & 15);
            if (cl) { if (d == 0) { for (int q = 0; q < sg; ++q) { const f32x2 s = sp[(size_t)(cf + q) * 2048]; cy = s.x * cy + s.y; } }
                      else { for (int q = 3; q > sg; --q) { const f32x2 s = sp[(size_t)(cf + q) * 2048]; cy = s.x * cy + s.y; } } }
            lru_item(a, F, lds, pass, cf + sg, n, C, cy, xc, 0);
        }
        __syncthreads();
    }
}

constexpr int SG_KC = 512, SG_PITCH = SG_KC * 2 + 16, SG_B_OFF = 64 * SG_PITCH;
__device__ __forceinline__ void sg_accum(LAS unsigned char* lds, const bf16_t* A, int lda, const bf16_t* Bt, int K, int tid, int wave, int lane, f32x4 (&acc)[2]) {
    const int fr = lane & 15, fq = lane >> 4, rt = wave & 3, ch = wave >> 2;
    u32x4 ra[8], rb[8];
#define SG_LOADS(k0_) do { _Pragma("unroll") for (int i_ = 0; i_ < 8; ++i_) { const int p_ = tid + 512 * i_, row_ = p_ >> 6, kc_ = (p_ & 63) * 8; \
        if ((k0_) + kc_ < K) { ra[i_] = *(const u32x4*)(A + (size_t)row_ * lda + (k0_) + kc_); rb[i_] = *(const u32x4*)(Bt + (size_t)row_ * K + (k0_) + kc_); } \
        else { ra[i_] = (u32x4){0u, 0u, 0u, 0u}; rb[i_] = (u32x4){0u, 0u, 0u, 0u}; } } } while (0)
    SG_LOADS(0);
    for (int k0 = 0; k0 < K; k0 += SG_KC) {
        __syncthreads();
#pragma unroll
        for (int i = 0; i < 8; ++i) { const int p = tid + 512 * i, row = p >> 6, kc = (p & 63) * 8;
            *(LAS u32x4*)(lds + row * SG_PITCH + kc * 2) = ra[i]; *(LAS u32x4*)(lds + SG_B_OFF + row * SG_PITCH + kc * 2) = rb[i]; }
        if (k0 + SG_KC < K) SG_LOADS(k0 + SG_KC);
        __syncthreads();
        const int nks = (K - k0) >= SG_KC ? 16 : (K - k0) / 32;
        const LAS unsigned char* ap = lds + (16 * rt + fr) * SG_PITCH + fq * 16;
        const LAS unsigned char* bp = lds + SG_B_OFF + (32 * ch + fr) * SG_PITCH + fq * 16;
#pragma unroll 4
        for (int ks = 0; ks < nks; ++ks) { const bf16x8 af = *(const LAS bf16x8*)(ap + ks * 64), b0 = *(const LAS bf16x8*)(bp + ks * 64), b1 = *(const LAS bf16x8*)(bp + 16 * SG_PITCH + ks * 64);
            acc[0] = __builtin_amdgcn_mfma_f32_16x16x32_bf16(af, b0, acc[0], 0, 0, 0); acc[1] = __builtin_amdgcn_mfma_f32_16x16x32_bf16(af, b1, acc[1], 0, 0, 0); }
    }
    __syncthreads();
#undef SG_LOADS
}
__device__ __forceinline__ void ctx_g2_block(const Frame& F, LAS unsigned char* lds, int id) {
    const int tid = tid_opaque(F.wave_s), lane = tid & 63, wave = __builtin_amdgcn_readfirstlane(tid >> 6), fr = lane & 15, fq = lane >> 4, rt = wave & 3, ch = wave >> 2;
    const int rb = id >> 4, cb = id & 15;
    bf16_t* zrow = F.Z() + (size_t)(CH_L + rb * 64) * ZP;
    f32x4 total[2] = {(f32x4){0.f, 0.f, 0.f, 0.f}, (f32x4){0.f, 0.f, 0.f, 0.f}};
#pragma unroll
    for (int seg = 0; seg < 3; ++seg) {
        f32x4 acc[2] = {(f32x4){0.f, 0.f, 0.f, 0.f}, (f32x4){0.f, 0.f, 0.f, 0.f}};
        const int colA = seg == 0 ? CSX : (seg == 1 ? CSB : CSC);
        bf16_t gq[2][4];
#pragma unroll
        for (int ct = 0; ct < 2; ++ct)
#pragma unroll
            for (int j = 0; j < 4; ++j) gq[ct][j] = zrow[(size_t)(16 * rt + 4 * fq + j) * ZP + CGT + seg * 1024 + cb * 64 + 32 * ch + 16 * ct + fr];
        sg_accum(lds, zrow + colA, ZP, F.W(seg == 0 ? W_AO : (seg == 1 ? W_SO : W_LO)) + (size_t)(cb * 64) * DM, DM, tid, wave, lane, acc);
#pragma unroll
        for (int ct = 0; ct < 2; ++ct)
#pragma unroll
            for (int j = 0; j < 4; ++j) total[ct][j] += bf1(gq[ct][j]) * acc[ct][j];
    }
#pragma unroll
    for (int ct = 0; ct < 2; ++ct)
#pragma unroll
        for (int j = 0; j < 4; ++j) zrow[(size_t)(16 * rt + 4 * fq + j) * ZP + CQ + cb * 64 + 32 * ch + 16 * ct + fr] = (bf16_t)(cvt_pk_bf16(total[ct][j], total[ct][j]) & 0xffffu);
}
__device__ __forceinline__ void ctx_res_block(const Frame& F, LAS unsigned char* lds, int id, int which) {
    const int tid = tid_opaque(F.wave_s), lane = tid & 63, wave = __builtin_amdgcn_readfirstlane(tid >> 6), fr = lane & 15, fq = lane >> 4, rt = wave & 3, ch = wave >> 2;
    const int rb = id >> 4, cb = id & 15;
    f32x4 acc[2] = {(f32x4){0.f, 0.f, 0.f, 0.f}, (f32x4){0.f, 0.f, 0.f, 0.f}};
    const size_t xrow0 = which == 0 ? (size_t)F.c * CH_C + rb * 64 : (size_t)rb * 64;
    const float* base = (which == 0 && F.l == 0) ? F.ctx : F.XC();
    const float* vec = F.MOD(8) + (which == 0 ? 2048 : 5120) + cb * 64 + 32 * ch + fr;
    float bq[2][4], gv[2];
#pragma unroll
    for (int ct = 0; ct < 2; ++ct) { gv[ct] = vec[16 * ct];
#pragma unroll
        for (int j = 0; j < 4; ++j) bq[ct][j] = base[(xrow0 + 16 * rt + 4 * fq + j) * DM + cb * 64 + 32 * ch + 16 * ct + fr]; }
    if (which == 0) sg_accum(lds, F.Z() + (size_t)(CH_L + rb * 64) * ZP + CQ, ZP, F.W(W_MO) + (size_t)(cb * 64) * DM, DM, tid, wave, lane, acc);
    else sg_accum(lds, F.Z() + (size_t)(LROWS + rb * 64) * FFW, FFW, F.W(W_F2) + (size_t)(cb * 64) * FFW, FFW, tid, wave, lane, acc);
#pragma unroll
    for (int ct = 0; ct < 2; ++ct)
#pragma unroll
        for (int j = 0; j < 4; ++j) F.XC()[(xrow0 + 16 * rt + 4 * fq + j) * DM + cb * 64 + 32 * ch + 16 * ct + fr] = bq[ct][j] + gv[ct] * acc[ct][j];
}

constexpr int N_PHASES = 30;
__device__ __forceinline__ void decode_phase(int ph, int& kind, int& l, int& c) {
    if (ph == 0) { kind = K_P0; l = 0; c = 0; return; }
    if (ph == N_PHASES - 1) { kind = K_FN; l = 1; c = 0; return; }
    const int q = ph - 1; l = q / 14; const int r = q % 14; c = 0;
    if (r == 0) { kind = K_N1; }
    else if (r <= 10) { c = (r - 1) / 5; const int s = (r - 1) % 5; kind = s == 0 ? K_G1 : s == 1 ? K_M1 : s == 2 ? K_A1 : s == 3 ? K_G2 : K_G3; }
    else { kind = r == 11 ? K_N2 : (r == 12 ? K_G4 : K_G5); }
}

__global__ void __launch_bounds__(NTHREADS, 2) mk_fwd(Args a_) {
    extern __shared__ __attribute__((aligned(16))) unsigned char lds_raw[];
    LAS unsigned char* lds = (LAS unsigned char*)lds_raw;
    cg::grid_group grid = cg::this_grid();
    const int ph_lo = a_.ph_lo, ph_hi = a_.ph_hi;
    const int wave_s = __builtin_amdgcn_readfirstlane(threadIdx.x >> 6);
    volatile LAS unsigned* MISC = (volatile LAS unsigned*)(lds + MISC_OFF);
    if (threadIdx.x < 4) MISC[threadIdx.x] = 0u;
    __syncthreads();
    (void)xcd_barrier_post((unsigned*)(a_.ws + WS_CTL), MISC);
    for (int ph = ph_lo; ph < ph_hi; ++ph) {
        CArgs a; { unsigned long long kp = (unsigned long long)__builtin_amdgcn_kernarg_segment_ptr(); asm volatile("" : "+s"(kp)); a = (CArgs)kp; }
        if (ph > ph_lo) {
            if (ph_hi < 0) grid.sync();
            else { XcdBarrier bar; bar.bar = (unsigned*)(a->ws + WS_CTL); bar.x = xb_xcc_id(); bar.st = (volatile LAS unsigned*)(lds + MISC_OFF); xcd_barrier(bar, tid_opaque(wave_s) == 0); } }
        Frame F;
        F.x = a->in[0]; F.cvec = a->in[1]; F.ctx = a->in[2]; F.cctx = a->in[3]; F.out = a->out; F.ws = a->ws;
        F.G = gridDim.x; { const int bx = bid_opaque(); F.vcu = (F.G % 8 == 0) ? (bx % 8) * (F.G / 8) + bx / 8 : bx; }
        int kind, l, c; decode_phase(ph, kind, l, c);
        F.kind = kind; F.l = l; F.c = c; F.wave_s = wave_s;
        if (kind == K_P0) { phase_p0(a, F, lds); }
        else if (kind == K_N1) { for (int rep = 0; rep < ((kind == REP_KIND) ? 2 : 1); ++rep) phase_norm(a, F, 0); }
        else if (kind == K_N2) { for (int rep = 0; rep < ((kind == REP_KIND) ? 2 : 1); ++rep) phase_norm(a, F, 1); }
        else if (kind == K_FN) { phase_final(a, F); }
        else if (kind == K_M1) {
            for (int rep = 0; rep < REP_LRU1; ++rep) lru_phase(a, F, lds, 1);
            phase_qknorm(a, F);
            phase_sconv(a, F);
        } else if (kind == K_A1) {
            for (int rep = 0; rep < REP_A1; ++rep) lru_phase(a, F, lds, 2);
            const int nlat = CHB * 8 * 16, ntot = nlat + ((l == 0) ? CHB * 8 : 0);
            for (int rep = 0; rep < REP_ATT; ++rep)
            for (int i = 0;; ++i) {
                int U;
                if (F.G == 256) { if (i < 2) U = (F.vcu >> 5) * 64 + i * 32 + (F.vcu & 31); else { const int v2 = F.vcu - 128; U = (i == 2 && v2 >= 0 && v2 < 32) ? nlat + v2 : ntot; } }
                else U = i * F.G + F.vcu;
                if (U >= ntot) break;
                if (U < nlat) {
                    const int bk = U >> 6, bl = bk >> 1, kvh = bk & 1, r = U & 63, h = kvh * 4 + (r >> 4), qb = r & 15;
                    bf16_t* q = F.Z() + (size_t)(bl * SEQ + qb * 256) * ZP + CQ + h * 128;
                    att::attn_dense_body(q, F.Kb() + (size_t)bl * KVLEN * 256 + kvh * 128, F.Vb() + (size_t)bl * KVLEN * 256 + kvh * 128, q + (CSX - CQ), KVLEN, (char*)lds_raw, F.wave_s, a->in[9] + l * 128, (const f32x2*)(F.ws + WS_ROPE), qb * 256);
                } else {
                    const int V = U - nlat, bl = V >> 3, h = V & 7, kvh = h >> 2;
                    bf16_t* q = F.Z() + (size_t)(CH_L + bl * CTXL) * ZP + CQ + h * 128;
                    att::attn_dense_body(q, F.Kb() + (size_t)bl * KVLEN * 256 + kvh * 128, F.Vb() + (size_t)bl * KVLEN * 256 + kvh * 128, q + (CSX - CQ), CTXL, (char*)lds_raw, F.wave_s, a->in[9] + l * 128, (const f32x2*)(F.ws + WS_ROPE), -1);
                }
            }
        } else {
            GSched S; S.F = F; GEpi E; E.F = F;
            const int K = (kind == K_G5) ? FFW : DM;
            const int lda = (kind == K_G1 || kind == K_G4) ? DM : (kind == K_G5 ? FFW : ZP);
            for (int rep = 0; rep < ((kind == REP_KIND) ? 2 : 1); ++rep)
            pg8::gemm_phase<GEpi, GSched>(lds, K, lda, S, E);
            if (l == 0) {
                if (kind == K_G2) { for (int id = F.vcu; id < 256; id += F.G) ctx_g2_block(F, lds, id); }
                else if (kind == K_G3) { for (int id = F.vcu; id < 256; id += F.G) ctx_res_block(F, lds, id, 0); }
                else if (kind == K_G5) { for (int id = F.vcu; id < 512; id += F.G) ctx_res_block(F, lds, id, 1); }
            }
        }
    }
}

extern "C" void kernel_launch(void* const* d_in, const int* in_sizes, int n_in, void* d_out, int out_size, void* d_ws, size_t ws_size, hipStream_t stream) {
    static int grid = 0;
    if (grid == 0) {
        if (n_in != 27 || out_size != LROWS * DM || ws_size < WS_END) { fprintf(stderr, "kernel_launch: bad shapes n_in %d out %d ws %zu (need %zu)\n", n_in, out_size, ws_size, (size_t)WS_END); grid = -1; return; }
        int dev = 0, cus = 0, per_cu = 0;
        hipGetDevice(&dev); hipDeviceGetAttribute(&cus, hipDeviceAttributeMultiprocessorCount, dev);
        if (hipFuncSetAttribute((const void*)mk_fwd, hipFuncAttributeMaxDynamicSharedMemorySize, LDS_BYTES) != hipSuccess) { fprintf(stderr, "kernel_launch: hipFuncSetAttribute failed\n"); grid = -1; return; }
        if (hipOccupancyMaxActiveBlocksPerMultiprocessor(&per_cu, (const void*)mk_fwd, NTHREADS, LDS_BYTES) != hipSuccess || per_cu < 1) { fprintf(stderr, "kernel_launch: occupancy query failed (%d)\n", per_cu); per_cu = 1; }
        (void)hipGetLastError();
        grid = cus * per_cu;
        fprintf(stderr, "kernel_launch: grid %d (cus %d x %d)\n", grid, cus, per_cu);
    }
    if (grid < 0) return;
    if (hipMemsetAsync((char*)d_ws + WS_CTL, 0, CTL_BYTES, stream) != hipSuccess) { fprintf(stderr, "kernel_launch: memset failed\n"); return; }
    Args a{};
    for (int i = 0; i < 27; ++i) a.in[i] = (const float*)d_in[i];
    a.out = (float*)d_out; a.ws = (unsigned char*)d_ws;
#if MK_PER_PHASE
    for (int ph = 0; ph < N_PHASES; ++ph) {
        a.ph_lo = ph; a.ph_hi = ph + 1;
        void* args[] = {&a};
        hipError_t e = hipLaunchCooperativeKernel((const void*)mk_fwd, dim3(grid), dim3(NTHREADS), args, LDS_BYTES, stream);
        if (e != hipSuccess) { fprintf(stderr, "launch %d failed: %s\n", ph, hipGetErrorString(e)); break; }
    }
#else
    a.ph_lo = 0; a.ph_hi = N_PHASES;
    void* args[] = {&a};
    hipError_t e = hipLaunchCooperativeKernel((const void*)mk_fwd, dim3(grid), dim3(NTHREADS), args, LDS_BYTES, stream);
    if (e != hipSuccess) fprintf(stderr, "cooperative launch failed: %s (grid %d)\n", hipGetErrorString(e), grid);
#endif
}
```
